# Optimizing an MI355X kernel written in HIP

```python
import math
import jax, jax.numpy as jnp
from jax import lax
import numpy as np


D_MODEL = 2048
BATCH = 4
SEQ = 8192
DEPTH = 4

GDN_HEADS = D_MODEL // 256
GDN_HEAD_DIM = 128
GDN_WIDTH = GDN_HEADS * GDN_HEAD_DIM
CONV_WIDTH = 4
CHUNK = 64
DSA_HEADS = D_MODEL // 256
DSA_HEAD_DIM = 128
DSA_WIDTH = DSA_HEADS * DSA_HEAD_DIM
IDX_HEADS = D_MODEL // 256
IDX_HEAD_DIM = 64
TOPK_MAX = 256
Q_BLOCK = 128
REL_BUCKETS = 32
REL_MAX_DIST = 128
D_FF = -(-8 * D_MODEL // (3 * 256)) * 256
DEEPNORM_ALPHA = (2 * DEPTH) ** 0.25
DEEPNORM_BETA = (8 * DEPTH) ** -0.25
LN_EPS = 1e-5
RMS_EPS = 1e-6

SPLIT_SIZES = (
    3 * GDN_WIDTH,
    GDN_HEADS,
    GDN_HEADS,
    GDN_WIDTH,
    DSA_WIDTH, DSA_WIDTH, DSA_WIDTH,
    IDX_HEADS * IDX_HEAD_DIM,
    IDX_HEAD_DIM,
    IDX_HEADS,
    D_MODEL,
    D_MODEL,
)
D_IN = sum(SPLIT_SIZES)

kernel_name = 'hybrid_gdn_dsa_deepnorm_block'


def layer_norm(x, g, b):
    xf = x.astype(jnp.float32)
    mu = jnp.mean(xf, axis=-1, keepdims=True)
    var = jnp.mean(jnp.square(xf - mu), axis=-1, keepdims=True)
    return ((xf - mu) * lax.rsqrt(var + LN_EPS) * g.astype(jnp.float32) + b.astype(jnp.float32)).astype(x.dtype)


def l2_normalize(x):
    return x * lax.rsqrt(jnp.sum(jnp.square(x), axis=-1, keepdims=True) + RMS_EPS)


def causal_short_conv(x, w):
    S = x.shape[1]
    K = w.shape[0]
    xp = jnp.pad(x, ((0, 0), (K - 1, 0), (0, 0)))
    y = sum(xp[:, j:j + S] * w[j] for j in range(K))
    return jax.nn.silu(y)


def gated_delta_rule_chunked(q, k, v, g, beta):
    B, S, H, Dk = q.shape
    Dv = v.shape[-1]
    N = S // CHUNK
    f32 = jnp.float32
    q = l2_normalize(q.astype(f32)) * (Dk ** -0.5)
    k = l2_normalize(k.astype(f32))

    def chunks(a):
        return jnp.moveaxis(a.reshape(B, N, CHUNK, H, *a.shape[3:]), 3, 1)

    q, k, v = chunks(q), chunks(k), chunks(v.astype(f32))
    g, beta = chunks(g.astype(f32)), chunks(beta.astype(f32))
    gc = jnp.cumsum(g, axis=-1)
    causal = jnp.tril(jnp.ones((CHUNK, CHUNK), dtype=bool))
    strict = jnp.tril(jnp.ones((CHUNK, CHUNK), dtype=bool), k=-1)
    decay = jnp.exp(jnp.where(causal, gc[..., :, None] - gc[..., None, :], -jnp.inf))
    k_beta = k * beta[..., None]
    v_beta = v * beta[..., None]
    m = jnp.where(strict, jnp.einsum('bhnid,bhnjd->bhnij', k_beta, k) * decay, 0.0)
    a = m + jnp.eye(CHUNK, dtype=f32)
    u = lax.linalg.triangular_solve(a, v_beta, left_side=True, lower=True, unit_diagonal=True)
    w = lax.linalg.triangular_solve(a, k_beta * jnp.exp(gc)[..., None], left_side=True, lower=True, unit_diagonal=True)
    intra = jnp.einsum('bhnid,bhnjd->bhnij', q, k) * decay
    q_dec = q * jnp.exp(gc)[..., None]
    k_dec = k * jnp.exp(gc[..., -1:] - gc)[..., None]
    g_tot = jnp.exp(gc[..., -1])

    def step(state, inp):
        q_n, k_n, u_n, w_n, a_n, gt = inp
        v_new = u_n - jnp.einsum('bhcd,bhde->bhce', w_n, state)
        o = jnp.einsum('bhcd,bhde->bhce', q_n, state) + jnp.einsum('bhij,bhje->bhie', a_n, v_new)
        state = state * gt[..., None, None] + jnp.einsum('bhcd,bhce->bhde', k_n, v_new)
        return state, o

    xs = tuple(jnp.moveaxis(t, 2, 0) for t in (q_dec, k_dec, u, w, intra, g_tot))
    state0 = jnp.zeros((B, H, Dk, Dv), f32)
    _, o = lax.scan(step, state0, xs)
    return jnp.transpose(o, (1, 0, 3, 2, 4)).reshape(B, S, H, Dv)


def t5_bucket(dist):
    n = jnp.maximum(dist, 0)
    max_exact = REL_BUCKETS // 2
    log_ratio = jnp.log(jnp.maximum(n, 1).astype(jnp.float32) / max_exact) / math.log(REL_MAX_DIST / max_exact)
    large = max_exact + (log_ratio * (REL_BUCKETS - max_exact)).astype(jnp.int32)
    large = jnp.minimum(large, REL_BUCKETS - 1)
    return jnp.where(n < max_exact, n, large)


def dsa_sparse_attention(q, k, v, q_idx, k_idx, w_idx, rel_bias):
    B, S, H, D = q.shape
    topk = min(TOPK_MAX, S // 4)
    nb = S // Q_BLOCK
    f32 = jnp.float32
    k_idx = k_idx.astype(f32)
    key_pos = jnp.arange(S)
    gather = jax.vmap(lambda src, ids: src[ids])

    def blocks(a):
        return jnp.moveaxis(a.reshape(B, nb, Q_BLOCK, *a.shape[2:]), 1, 0)

    def attend_block(inp):
        q_b, qi_b, wi_b, t0 = inp
        q_pos = t0 + jnp.arange(Q_BLOCK)
        rel = jax.nn.relu(jnp.einsum('bqhd,bsd->bqhs', qi_b.astype(f32), k_idx))
        score = jnp.einsum('bqh,bqhs->bqs', wi_b.astype(f32), rel)
        score = jnp.where(key_pos[None, None, :] <= q_pos[None, :, None], score, -jnp.inf)
        _, idx = lax.top_k(score, topk)
        k_sel = gather(k, idx)
        v_sel = gather(v, idx)
        dist = q_pos[None, :, None] - idx
        bias = rel_bias[t5_bucket(dist)].astype(f32)
        logits = jnp.einsum('bqhd,bqkhd->bqhk', q_b, k_sel).astype(f32) * (D ** -0.5) + jnp.moveaxis(bias, 3, 2)
        logits = jnp.where((dist >= 0)[:, :, None, :], logits, -jnp.inf)
        p = jax.nn.softmax(logits, axis=-1).astype(v.dtype)
        return jnp.einsum('bqhk,bqkhd->bqhd', p, v_sel)

    out = lax.map(attend_block, (blocks(q), blocks(q_idx), blocks(w_idx), jnp.arange(nb) * Q_BLOCK))
    return jnp.moveaxis(out, 0, 1).reshape(B, S, H * D)


def setup_inputs(seed: int = 0) -> dict:
    key = jax.random.key(seed)
    ks = jax.random.split(key, 16)
    f32 = jnp.float32

    def nrm(k, shape, scale):
        return jax.random.normal(k, shape, f32) * scale

    x = nrm(ks[0], (BATCH, SEQ, D_MODEL), 1.0)
    rel_bias = nrm(ks[1], (REL_BUCKETS, DSA_HEADS), 0.5)
    w_in = nrm(ks[2], (DEPTH, D_MODEL, D_IN), D_MODEL ** -0.5)
    conv_w = nrm(ks[3], (DEPTH, CONV_WIDTH, 3 * GDN_WIDTH), CONV_WIDTH ** -0.5)
    a_log = jnp.log(jax.random.uniform(ks[4], (DEPTH, GDN_HEADS), f32, 1.0, 16.0))
    dt = jnp.exp(jax.random.uniform(ks[5], (DEPTH, GDN_HEADS), f32, math.log(1e-3), math.log(1e-1)))
    dt_bias = dt + jnp.log(-jnp.expm1(-dt))
    gdn_norm_w = 1.0 + nrm(ks[6], (DEPTH, GDN_HEAD_DIM), 0.02)
    w_branch_a = nrm(ks[7], (DEPTH, GDN_WIDTH, D_MODEL), GDN_WIDTH ** -0.5)
    w_branch_b = nrm(ks[8], (DEPTH, DSA_WIDTH, D_MODEL), DSA_WIDTH ** -0.5)
    w_out = nrm(ks[9], (DEPTH, D_MODEL, D_MODEL), DEEPNORM_BETA * D_MODEL ** -0.5)
    ln1_g = 1.0 + nrm(ks[10], (DEPTH, D_MODEL), 0.02)
    ln1_b = nrm(ks[11], (DEPTH, D_MODEL), 0.02)
    w_ffn_in = nrm(ks[12], (DEPTH, D_MODEL, 2 * D_FF), D_MODEL ** -0.5)
    w_ffn_out = nrm(ks[13], (DEPTH, D_FF, D_MODEL), DEEPNORM_BETA * D_FF ** -0.5)
    ln2_g = 1.0 + nrm(ks[14], (DEPTH, D_MODEL), 0.02)
    ln2_b = nrm(ks[15], (DEPTH, D_MODEL), 0.02)
    return {'x': x, 'rel_bias': rel_bias, 'w_in': w_in, 'conv_w': conv_w, 'a_log': a_log,
            'dt_bias': dt_bias, 'gdn_norm_w': gdn_norm_w, 'w_branch_a': w_branch_a,
            'w_branch_b': w_branch_b, 'w_out': w_out, 'ln1_g': ln1_g, 'ln1_b': ln1_b,
            'w_ffn_in': w_ffn_in, 'w_ffn_out': w_ffn_out, 'ln2_g': ln2_g, 'ln2_b': ln2_b}


def reference(x, rel_bias, w_in, conv_w, a_log, dt_bias, gdn_norm_w, w_branch_a, w_branch_b,
              w_out, ln1_g, ln1_b, w_ffn_in, w_ffn_out, ln2_g, ln2_b):
    B, S, _ = x.shape
    offsets = [int(o) for o in np.cumsum(SPLIT_SIZES)[:-1]]

    def heads(t, n):
        return t.reshape(B, S, n, -1)

    for l in range(DEPTH):
        proj = x @ w_in[l]
        (qkv_a, a_in, b_in, z, q_b, k_b, v_b, q_i, k_i, w_i, gate_a, gate_b) = jnp.split(proj, offsets, axis=-1)

        qkv_a = causal_short_conv(qkv_a, conv_w[l])
        q_a, k_a, v_a = jnp.split(qkv_a, 3, axis=-1)
        log_decay = -jnp.exp(a_log[l]) * jax.nn.softplus(a_in + dt_bias[l])
        beta = jax.nn.sigmoid(b_in)
        o_a = gated_delta_rule_chunked(heads(q_a, GDN_HEADS), heads(k_a, GDN_HEADS),
                                       heads(v_a, GDN_HEADS), log_decay, beta)
        o_a = (o_a * lax.rsqrt(jnp.mean(jnp.square(o_a), axis=-1, keepdims=True) + RMS_EPS)
               * gdn_norm_w[l].astype(jnp.float32)
               * jax.nn.silu(heads(z, GDN_HEADS).astype(jnp.float32)))
        o_a = o_a.reshape(B, S, GDN_WIDTH).astype(x.dtype)

        o_b = dsa_sparse_attention(heads(q_b, DSA_HEADS), heads(k_b, DSA_HEADS), heads(v_b, DSA_HEADS),
                                   heads(q_i, IDX_HEADS), k_i, w_i, rel_bias)

        merged = jax.nn.sigmoid(gate_a) * (o_a @ w_branch_a[l]) + jax.nn.sigmoid(gate_b) * (o_b @ w_branch_b[l])
        x = layer_norm(DEEPNORM_ALPHA * x + merged @ w_out[l], ln1_g[l], ln1_b[l])

        h_gate, h_up = jnp.split(x @ w_ffn_in[l], 2, axis=-1)
        x = layer_norm(DEEPNORM_ALPHA * x + (jax.nn.silu(h_gate) * h_up) @ w_ffn_out[l], ln2_g[l], ln2_b[l])
    return x
```

```cpp
#include <hip/hip_runtime.h>
#include <cstdio>
#include <cstdint>

#define GAS __attribute__((address_space(1)))
#define LAS __attribute__((address_space(3)))
typedef unsigned short bf16;
typedef GAS unsigned gu32;
typedef short bf16x8 __attribute__((ext_vector_type(8)));
typedef short s16x4 __attribute__((ext_vector_type(4)));
typedef _Float16 f16x8 __attribute__((ext_vector_type(8)));
typedef float f32x2 __attribute__((ext_vector_type(2)));
typedef float f32x4 __attribute__((ext_vector_type(4)));
typedef float f32x16 __attribute__((ext_vector_type(16)));
typedef unsigned u32x2 __attribute__((ext_vector_type(2)));
typedef unsigned u32x4 __attribute__((ext_vector_type(4)));

constexpr int NB = 4, SEQ = 8192, DM = 2048, DEPTH = 4;
constexpr int M = NB * SEQ;
constexpr int NH = 8, HD = 128, CH = 64, NCH = SEQ / CH;
constexpr int DIN = 11864, DFF = 5632;
constexpr int NP1 = 7936;
constexpr int NGT = 4096;
constexpr int SMW = 768;
constexpr float ALPHA = 1.681792830507429f;
constexpr float LN_EPS = 1e-5f, RMS_EPS = 1e-6f;
constexpr int NWAVES = 8, NTHR = 512;

constexpr int C_QKVA = 0, C_A = 3072, C_B = 3080, C_Z = 3088, C_QB = 4112, C_QI = 7184, C_KI = 7696, C_WI = 7760, C_GA = 7768;

constexpr size_t MiB = 1u << 20;
constexpr size_t WS_CTL = 0;
constexpr size_t CTL_BYTES = 1 * MiB;
constexpr size_t WS_WIN = 1 * MiB;
constexpr size_t WS_WG  = WS_WIN + (size_t)NP1 * DM * 2;
constexpr size_t WS_WA  = WS_WG + (size_t)NGT * DM * 2;
constexpr size_t WS_WB  = WS_WA + (size_t)DM * 1024 * 2;
constexpr size_t WS_WO  = WS_WB + (size_t)DM * 1024 * 2;
constexpr size_t WS_W1  = WS_WO + (size_t)DM * DM * 2;
constexpr size_t WS_W2  = WS_W1 + (size_t)2 * DFF * DM * 2;
constexpr size_t WS_WEND = WS_W2 + (size_t)DM * DFF * 2;
constexpr size_t WS_XB  = 131 * MiB;
constexpr size_t WS_GQKV = WS_XB + 128 * MiB;
constexpr size_t WS_ZB  = WS_GQKV + 192 * MiB;
constexpr size_t WS_QB  = WS_ZB + 64 * MiB;
constexpr size_t WS_KB  = WS_QB + 64 * MiB;
constexpr size_t WS_VB  = WS_KB + 64 * MiB;
constexpr size_t WS_SM  = WS_VB + 64 * MiB;
constexpr size_t WS_QN  = WS_SM + 96 * MiB;
constexpr size_t WS_KN  = WS_QN + 64 * MiB;
constexpr size_t WS_VN  = WS_KN + 64 * MiB;
constexpr size_t WS_TT  = WS_VN + 64 * MiB;
constexpr size_t WS_AA  = WS_TT + 32 * MiB;
constexpr size_t WS_GCB = WS_AA + 32 * MiB;
constexpr size_t WS_QI  = WS_GCB + 2 * MiB;
constexpr size_t WS_KI  = WS_QI + 32 * MiB;
constexpr size_t WS_MASK = WS_KI + 4 * MiB;
constexpr size_t WS_OA  = WS_MASK + 32 * MiB;
constexpr size_t WS_BLUT = WS_OA + 64 * MiB;
constexpr size_t WS_OB = WS_BLUT + 1 * MiB;
constexpr size_t WS_STATS = WS_OB + 64 * MiB;
constexpr size_t WS_WSET2 = WS_STATS + 1 * MiB;
constexpr size_t WSET_STRIDE = WS_WSET2 - WS_WIN;
constexpr size_t WS_END = WS_WSET2 + (WS_WEND - WS_WIN);
constexpr size_t WS_YB = WS_QN;
constexpr size_t WS_GATES = WS_GQKV;
constexpr size_t WS_MERGED = WS_KB;
constexpr size_t WS_HID = WS_GQKV;
static_assert(WS_WEND <= WS_XB, "weights fit");
static_assert((size_t)M * DFF * 2 <= 384 * MiB, "hid overlay");

constexpr int LDS_BYTES = 144 * 1024;
constexpr int LDS_MISC = 143 * 1024;

struct Params {
    const float* x; const float* rel_bias; const float* w_in; const float* conv_w; const float* a_log; const float* dt_bias;
    const float* gdn_norm_w; const float* w_a; const float* w_b; const float* w_out; const float* ln1_g; const float* ln1_b;
    const float* w_ffn_in; const float* w_ffn_out; const float* ln2_g; const float* ln2_b;
    float* out; unsigned char* ws;
    int layer, ph_lo, ph_hi, pad;
};

__device__ __forceinline__ unsigned f2bf(float f) { return (unsigned)__builtin_bit_cast(unsigned short, (__bf16)f); }
typedef __bf16 bf16v2_t __attribute__((ext_vector_type(2)));
__device__ __forceinline__ unsigned pk2(float lo, float hi) { const f32x2 v = {lo, hi}; return __builtin_bit_cast(unsigned, __builtin_convertvector(v, bf16v2_t)); }
__device__ __forceinline__ float bf2f(unsigned short h) { return __builtin_bit_cast(float, (unsigned)h << 16); }
__device__ __forceinline__ float bflo(unsigned w) { return __builtin_bit_cast(float, w << 16); }
__device__ __forceinline__ float bfhi(unsigned w) { return __builtin_bit_cast(float, w & 0xffff0000u); }
__device__ __forceinline__ float fast_exp(float x) { return __builtin_amdgcn_exp2f(x * 1.4426950408889634f); }
__device__ __forceinline__ float sigmoidf_(float x) { return __builtin_amdgcn_rcpf(1.0f + fast_exp(-x)); }
__device__ __forceinline__ float siluf_(float x) { return x * sigmoidf_(x); }
__device__ __forceinline__ u32x4 zero4_() { unsigned z; asm volatile("v_mov_b32 %0, 0" : "=v"(z)); return (u32x4){z, z, z, z}; }
constexpr int LDS_WTAB = 143 * 1024 + 256;
__device__ __forceinline__ int ltid() {
    extern __shared__ __attribute__((aligned(16))) unsigned char smem_base_[];
    const unsigned slot = (unsigned)__builtin_amdgcn_s_getreg(63492) & 63u;
    const int w = ((volatile LAS int*)((LAS unsigned char*)smem_base_ + LDS_WTAB))[slot];
    int lane; asm volatile("v_mbcnt_lo_u32_b32 %0, -1, 0\n\tv_mbcnt_hi_u32_b32 %0, -1, %0" : "=v"(lane));
    return __builtin_amdgcn_readfirstlane(w) * 64 + lane;
}
#define LDS_WAIT() asm volatile("s_waitcnt lgkmcnt(0)" ::: "memory")
#define VM_WAIT() asm volatile("s_waitcnt vmcnt(0)" ::: "memory")

__device__ const unsigned char T5_LUT[132] = {0, 1, 2, 3, 4, 5, 6, 7, 8, 9, 10, 11, 12, 13, 14, 15, 16, 16, 16, 17, 17, 18, 18, 18, 19, 19, 19, 20, 20, 20, 20, 21, 21, 21, 21, 22, 22, 22, 22, 22,
    23, 23, 23, 23, 23, 23, 24, 24, 24, 24, 24, 24, 25, 25, 25, 25, 25, 25, 25, 26, 26, 26, 26, 26, 26, 26, 26, 27, 27, 27, 27, 27, 27, 27, 27, 27, 27, 28, 28, 28, 28, 28, 28, 28, 28, 28, 28,
    29, 29, 29, 29, 29, 29, 29, 29, 29, 29, 29, 29, 30, 30, 30, 30, 30, 30, 30, 30, 30, 30, 30, 30, 30, 30, 31, 31, 31, 31, 31, 31, 31, 31, 31, 31, 31, 31, 31, 31, 31, 31, 31, 31, 31};

namespace pg8 {
#define PG8_LAS __attribute__((address_space(3)))
typedef unsigned short bf16_t;
typedef short bf16x8 __attribute__((ext_vector_type(8)));
typedef float f32x4 __attribute__((ext_vector_type(4)));
typedef unsigned u32x4 __attribute__((ext_vector_type(4)));
constexpr int BM = 256, BK = 64, HALF = 128, HTB = HALF * BK * 2  , STAGE_BYTES = 8 * HTB, NXCD = 8, WGM = 4;

__host__ __device__ __forceinline__ int lds_byte(int r, int c) { const int st = (r >> 4) * 2 + (c >> 5), rr = r & 15, cc = c & 31, ob = rr * 64 + cc * 2; return st * 1024 + (ob ^ (((ob >> 9) & 1) << 5)); }
__host__ __device__ __forceinline__ void stage_rc(int b, int& R, int& C) { const int st = b / 1024, sb = b % 1024, swz = sb ^ (((sb >> 9) & 1) << 5); R = (st >> 1) * 16 + swz / 64; C = (st & 1) * 32 + (swz % 64) / 2; }
__host__ __device__ __forceinline__ int perm32(int rho) { const int n = rho >> 4, i = rho & 15; return 8 * (i >> 2) + 4 * n + (i & 3); }

struct Unit { int pm, pn; };
struct Gemm { const bf16_t* A; const bf16_t* Bt; int M, N, K; };

struct StaticOrder {
    int nM, nN, nwg, G, c;
    __host__ __device__ void init(int M, int N, int G_, int c_) { nM = M / BM; nN = N / BM; nwg = nM * nN; G = G_; c = c_; }
    __host__ __device__ bool next(int i, Unit& u) const {
        const long L = (long)i * G + c; if (L >= nwg) return false;
        int wgid = (int)L; { const int q = nwg / NXCD, r = nwg % NXCD, xcd = wgid % NXCD, off = wgid / NXCD; wgid = (xcd < r ? xcd * (q + 1) : r * (q + 1) + (xcd - r) * q) + off; }
        const int nig = WGM * nN, gid = wgid / nig, fm = gid * WGM, gsz = (nM - fm) < WGM ? (nM - fm) : WGM;
        u.pm = fm + ((wgid % nig) % gsz); u.pn = (wgid % nig) / gsz; return true;
    }
    __device__ __forceinline__ void a_ready(const Unit&) const {}
    __device__ __forceinline__ void done(const Unit&) const {}
};
template <class Epi, class Sched, bool ALIGN_EPI = false, bool SP2 = false>
__device__ __forceinline__ void gemm_phase(PG8_LAS unsigned char* lds, const Gemm g, const Sched& S, const Epi& E) {
    const int tid = ltid(), wid = __builtin_amdgcn_readfirstlane(tid >> 6), lane = tid & 63, wr = wid >> 2, wc = wid & 3, fr = lane & 15, fq = lane >> 4;
    const int K = g.K, nt = K / BK;
    unsigned voffA[2], voffB[2];
#pragma unroll
    for (int i = 0; i < 2; ++i) { int R, C; stage_rc(tid * 16 + i * 8192, R, C); const int Rb = Epi::PERM ? ((R & ~31) + perm32(R & 31)) : R;
        voffA[i] = (unsigned)(R * K + C) * 2u; voffB[i] = (unsigned)(Rb * K + C) * 2u; }
    const size_t kstep = (size_t)(BK * 2);
    const size_t hstep = (size_t)HALF * K * 2;
    const size_t tstep = 2 * hstep;
    const unsigned ldsw = (unsigned)wid * 1024u;
    const int aoff = lds_byte(wr * 64 + fr, fq * 8), boff = lds_byte(wc * 32 + fr, fq * 8);
#define PG8_SA(b, h) (((b) * 2 + (h)) * HTB)
#define PG8_SB(b, h) ((4 + (b) * 2 + (h)) * HTB)
#define PG8_STAGE(bufoff, gbase, voff) do { _Pragma("unroll") for (int _i = 0; _i < 2; ++_i) \
        __builtin_amdgcn_global_load_lds((const unsigned*)((const char*)(gbase) + (voff)[_i]), (PG8_LAS unsigned*)(lds + (bufoff) + ldsw + _i * 8192), 16, 0, 0); } while (0)
#define PG8_LDA(dst, b, h) do { _Pragma("unroll") for (int m = 0; m < 4; ++m) _Pragma("unroll") for (int k = 0; k < 2; ++k) dst[m][k] = *(const PG8_LAS bf16x8*)(lds + PG8_SA(b, h) + aoff + m * 2048 + k * 1024); } while (0)
#define PG8_LDB(dst, b, h) do { _Pragma("unroll") for (int n = 0; n < 2; ++n) _Pragma("unroll") for (int k = 0; k < 2; ++k) dst[n][k] = *(const PG8_LAS bf16x8*)(lds + PG8_SB(b, h) + boff + n * 2048 + k * 1024); } while (0)
#define PG8_MMA(ai, bj, At, Bt) do { __builtin_amdgcn_s_setprio(1); _Pragma("unroll") for (int m = 0; m < 4; ++m) _Pragma("unroll") for (int n = 0; n < 2; ++n) _Pragma("unroll") for (int k = 0; k < 2; ++k) \
        acc[ai][bj][m][n] = __builtin_amdgcn_mfma_f32_16x16x32_bf16(Bt[n][k], At[m][k], acc[ai][bj][m][n], 0, 0, 0); __builtin_amdgcn_s_setprio(0); } while (0)
#define PG8_WAIT_V(n) asm volatile("s_waitcnt vmcnt(" #n ")" ::: "memory")
#define PG8_WAIT_L(n) asm volatile("s_waitcnt lgkmcnt(" #n ")" ::: "memory")
#define PG8_BAR __builtin_amdgcn_s_barrier()
#define PG8_SCHED __builtin_amdgcn_sched_barrier(0)
    Unit cur, nxt; int ui = 0;
    if (!S.next(0, cur)) return;
    f32x4 acc[2][2][4][2];
#pragma unroll
    for (int a = 0; a < 2; ++a)
#pragma unroll
        for (int b = 0; b < 2; ++b)
#pragma unroll
            for (int m = 0; m < 4; ++m)
#pragma unroll
                for (int n = 0; n < 2; ++n) acc[a][b][m][n] = (f32x4){0.f, 0.f, 0.f, 0.f};
    bf16x8 At[4][2], B0[2][2], B1[2][2];
    const char* cA = (const char*)g.A + (size_t)cur.pm * tstep; const char* cB = (const char*)g.Bt + (size_t)cur.pn * tstep;
    S.a_ready(cur);
    if constexpr (SP2) {
        PG8_STAGE(PG8_SB(0, 0), cB, voffB); PG8_STAGE(PG8_SB(0, 1), cB + hstep, voffB); PG8_STAGE(PG8_SA(0, 0), cA, voffA); PG8_STAGE(PG8_SA(0, 1), cA + hstep, voffA);
        if (wr == 1) PG8_BAR;
        PG8_WAIT_V(2); PG8_BAR;
        PG8_STAGE(PG8_SB(1, 0), cB + kstep, voffB); PG8_STAGE(PG8_SA(1, 0), cA + kstep, voffA); PG8_STAGE(PG8_SB(1, 1), cB + hstep + kstep, voffB);
        PG8_WAIT_V(6); PG8_BAR;
    } else {
        PG8_STAGE(PG8_SB(0, 0), cB, voffB); PG8_STAGE(PG8_SA(0, 0), cA, voffA); PG8_STAGE(PG8_SB(0, 1), cB + hstep, voffB); PG8_STAGE(PG8_SA(0, 1), cA + hstep, voffA);
        if (wr == 1) PG8_BAR;
        PG8_WAIT_V(4); PG8_BAR;
        PG8_STAGE(PG8_SB(1, 0), cB + kstep, voffB); PG8_STAGE(PG8_SA(1, 0), cA + kstep, voffA); PG8_STAGE(PG8_SB(1, 1), cB + hstep + kstep, voffB);
        PG8_WAIT_V(6); PG8_BAR;
    }
    for (;;) {
        const bool has_next = S.next(ui + 1, nxt);
        const char* nA = has_next ? (const char*)g.A + (size_t)nxt.pm * tstep : cA; const char* nB = has_next ? (const char*)g.Bt + (size_t)nxt.pn * tstep : cB;
        for (int t = 0; t < nt; t += 2) {
            const bool last = (t == nt - 2);
            const char* a1 = cA + (size_t)(t + 1) * kstep;
            const char* a2 = last ? nA : cA + (size_t)(t + 2) * kstep; const char* b2 = last ? nB : cB + (size_t)(t + 2) * kstep;
            const char* a3 = a2 + kstep; const char* b3 = b2 + kstep;
            if (last && has_next) S.a_ready(nxt);
            if constexpr (SP2) {
            PG8_LDB(B0, 0, 0); PG8_LDB(B1, 0, 1); PG8_SCHED; PG8_LDA(At, 0, 0); PG8_STAGE(PG8_SA(1, 1), a1 + hstep, voffA);
            PG8_WAIT_V(8); PG8_WAIT_L(0); PG8_BAR; PG8_MMA(0, 0, At, B0); PG8_MMA(0, 1, At, B1); PG8_BAR; PG8_SCHED;
            PG8_LDA(At, 0, 1); PG8_STAGE(PG8_SB(0, 0), b2, voffB); PG8_STAGE(PG8_SB(0, 1), b2 + hstep, voffB); PG8_STAGE(PG8_SA(0, 0), a2, voffA);
            PG8_WAIT_V(8); PG8_WAIT_L(0); PG8_BAR; PG8_MMA(1, 0, At, B0); PG8_MMA(1, 1, At, B1); PG8_BAR; PG8_SCHED;
            PG8_LDB(B0, 1, 0); PG8_LDB(B1, 1, 1); PG8_SCHED; PG8_LDA(At, 1, 0); PG8_STAGE(PG8_SA(0, 1), a2 + hstep, voffA);
            PG8_WAIT_V(8); PG8_WAIT_L(0); PG8_BAR; PG8_MMA(0, 0, At, B0); PG8_MMA(0, 1, At, B1); PG8_BAR; PG8_SCHED;
            PG8_LDA(At, 1, 1); PG8_STAGE(PG8_SB(1, 0), b3, voffB); PG8_STAGE(PG8_SB(1, 1), b3 + hstep, voffB); PG8_STAGE(PG8_SA(1, 0), a3, voffA);
            PG8_WAIT_V(8); PG8_WAIT_L(0); PG8_BAR; PG8_MMA(1, 0, At, B0); PG8_MMA(1, 1, At, B1); PG8_BAR; PG8_SCHED;
            } else {
            PG8_LDB(B0, 0, 0); PG8_SCHED; PG8_LDA(At, 0, 0); PG8_STAGE(PG8_SA(1, 1), a1 + hstep, voffA);
            PG8_WAIT_L(8); PG8_BAR; PG8_WAIT_L(0); PG8_MMA(0, 0, At, B0); PG8_BAR; PG8_SCHED;
            PG8_LDB(B1, 0, 1); PG8_STAGE(PG8_SB(0, 0), b2, voffB);
            PG8_BAR; PG8_WAIT_L(0); PG8_MMA(0, 1, At, B1); PG8_BAR;
            PG8_LDA(At, 0, 1); PG8_STAGE(PG8_SA(0, 0), a2, voffA);
            PG8_BAR; PG8_WAIT_L(0); PG8_MMA(1, 0, At, B0); PG8_BAR; PG8_SCHED;
            PG8_STAGE(PG8_SB(0, 1), b2 + hstep, voffB);
            PG8_WAIT_V(6); PG8_BAR; PG8_MMA(1, 1, At, B1); PG8_BAR;
            PG8_LDB(B0, 1, 0); PG8_SCHED; PG8_LDA(At, 1, 0); PG8_STAGE(PG8_SA(0, 1), a2 + hstep, voffA);
            PG8_WAIT_L(8); PG8_BAR; PG8_WAIT_L(0); PG8_MMA(0, 0, At, B0); PG8_BAR; PG8_SCHED;
            PG8_LDB(B1, 1, 1); PG8_STAGE(PG8_SB(1, 0), b3, voffB);
            PG8_BAR; PG8_WAIT_L(0); PG8_MMA(0, 1, At, B1); PG8_BAR;
            PG8_LDA(At, 1, 1); PG8_STAGE(PG8_SA(1, 0), a3, voffA);
            PG8_BAR; PG8_WAIT_L(0); PG8_MMA(1, 0, At, B0); PG8_BAR; PG8_SCHED;
            PG8_STAGE(PG8_SB(1, 1), b3 + hstep, voffB);
            PG8_WAIT_V(6); PG8_BAR; PG8_MMA(1, 1, At, B1); PG8_BAR;
            }
        }
        if constexpr (ALIGN_EPI) { if (wr == 0) PG8_BAR; }
        if constexpr (!Epi::AFTER_DRAIN) { E(acc, cur, wr, wc, fr, fq); S.done(cur); }
        if (!has_next) break;
#pragma unroll
        for (int a = 0; a < 2; ++a)
#pragma unroll
            for (int b = 0; b < 2; ++b)
#pragma unroll
                for (int m = 0; m < 4; ++m)
#pragma unroll
                    for (int n = 0; n < 2; ++n) acc[a][b][m][n] = (f32x4){0.f, 0.f, 0.f, 0.f};
        cur = nxt; cA = nA; cB = nB; ++ui;
        if constexpr (ALIGN_EPI) { if (wr == 1) PG8_BAR; }
    }
    PG8_WAIT_V(0);
    if constexpr (!ALIGN_EPI) { if (wr == 0) PG8_BAR; }
    PG8_BAR;
    if constexpr (Epi::AFTER_DRAIN) { E.fused(acc, cur, wr, wc, fr, fq, lds, wid, lane); S.done(cur); }
#undef PG8_SA
#undef PG8_SB
#undef PG8_STAGE
#undef PG8_LDA
#undef PG8_LDB
#undef PG8_MMA
#undef PG8_WAIT_V
#undef PG8_WAIT_L
#undef PG8_BAR
#undef PG8_SCHED
}
}

__device__ __forceinline__ int map_win(int n) {
    if (n < 3072) return n;
    if (n < 4096) return C_Z + (n - 3072);
    if (n < 7168) return C_QB + (n - 4096);
    const int s = n - 7168;
    if (s < 512) return C_QI + s;
    if (s < 576) return C_KI + (s - 512);
    if (s < 584) return C_WI + (s - 576);
    if (s < 592) return C_A + (s - 584);
    if (s < 600) return C_B + (s - 592);
    return -1;
}
struct CvItem { const GAS float* src; GAS bf16* dst; int ldw8, K8, ok; };
template <int MODE>
__device__ __forceinline__ CvItem cv_make(const GAS float* W, int ldw, int K, GAS bf16* WT, int coff, int item, int lane) {
    const int nkh = K / 128, g = item >> 3, w8 = item & 7, nb = 4 * (g / nkh) + (w8 & 3), kb = 2 * (g % nkh) + (w8 >> 2), k0 = 64 * kb, n0 = 32 * nb;
    const int n = n0 + (lane & 7) * 4;
    int sc;
    if (MODE == 0) sc = map_win(n);
    else if (MODE == 1) sc = coff + n;
    else { const int t = n >> 8, r = n & 255; sc = (r < 128) ? (128 * t + r) : (DFF + 128 * t + (r - 128)); }
    CvItem c; c.ok = sc >= 0; c.src = W + (size_t)(k0 + (lane >> 3)) * ldw + (sc >= 0 ? sc : 0); c.dst = WT + (size_t)(n0 + (lane >> 3)) * K + k0 + 8 * (lane & 7);
    c.ldw8 = 8 * ldw; c.K8 = 8 * K; return c;
}
constexpr int CV_NIT = (DM / 64) * (NP1 / 32) + (DM / 64) * (NGT / 32) + 2 * (1024 / 64) * (DM / 32) + (DM / 64) * (DM / 32) + (DM / 64) * (2 * DFF / 32) + (DFF / 64) * (DM / 32);
__device__ __forceinline__ CvItem cv_decode(const Params& p, int l, int it, int lane) {
    GAS unsigned char* ws = (GAS unsigned char*)p.ws + (size_t)(l & 1) * WSET_STRIDE;
    const GAS float* w_in = (const GAS float*)p.w_in + (size_t)l * DM * DIN;
    constexpr int I0 = (DM / 64) * (NP1 / 32), I1 = (DM / 64) * (NGT / 32), I2 = (1024 / 64) * (DM / 32), I3 = I2, I4 = (DM / 64) * (DM / 32), I5 = (DM / 64) * (2 * DFF / 32);
    int r = it;
    if (r < I0) return cv_make<0>(w_in, DIN, DM, (GAS bf16*)(ws + WS_WIN), 0, r, lane); r -= I0;
    if (r < I1) return cv_make<1>(w_in, DIN, DM, (GAS bf16*)(ws + WS_WG), C_GA, r, lane); r -= I1;
    if (r < I2) return cv_make<1>((const GAS float*)p.w_a + (size_t)l * 1024 * DM, DM, 1024, (GAS bf16*)(ws + WS_WA), 0, r, lane); r -= I2;
    if (r < I3) return cv_make<1>((const GAS float*)p.w_b + (size_t)l * 1024 * DM, DM, 1024, (GAS bf16*)(ws + WS_WB), 0, r, lane); r -= I3;
    if (r < I4) return cv_make<1>((const GAS float*)p.w_out + (size_t)l * DM * DM, DM, DM, (GAS bf16*)(ws + WS_WO), 0, r, lane); r -= I4;
    if (r < I5) return cv_make<2>((const GAS float*)p.w_ffn_in + (size_t)l * DM * 2 * DFF, 2 * DFF, DM, (GAS bf16*)(ws + WS_W1), 0, r, lane); r -= I5;
    return cv_make<1>((const GAS float*)p.w_ffn_out + (size_t)l * DFF * DM, DM, DFF, (GAS bf16*)(ws + WS_W2), 0, r, lane);
}
__device__ __forceinline__ void cv_load(const CvItem& c, f32x4 (&wv)[8]) {
#pragma unroll
    for (int i = 0; i < 8; ++i) wv[i] = c.ok ? *(const GAS f32x4*)(c.src + (size_t)i * c.ldw8) : (f32x4){0.f, 0.f, 0.f, 0.f};
}
__device__ __forceinline__ void cv_store(const CvItem& c, const f32x4 (&wv)[8], LAS float* scr, int lane) {
#pragma unroll
    for (int i = 0; i < 8; ++i) { const int kk = 8 * i + (lane >> 3); LAS float* d = scr + kk * 33 + (lane & 7) * 4; d[0] = wv[i].x; d[1] = wv[i].y; d[2] = wv[i].z; d[3] = wv[i].w; }
    LDS_WAIT(); asm volatile("" ::: "memory");
    const int cc = lane & 7;
#pragma unroll
    for (int j = 0; j < 4; ++j) { const int nn = (lane >> 3) + 8 * j; const LAS float* s = scr + (8 * cc) * 33 + nn;
        u32x4 o; o.x = pk2(s[0 * 33], s[1 * 33]); o.y = pk2(s[2 * 33], s[3 * 33]); o.z = pk2(s[4 * 33], s[5 * 33]); o.w = pk2(s[6 * 33], s[7 * 33]);
        *(GAS u32x4*)(c.dst + (size_t)j * c.K8) = o; }
    LDS_WAIT(); asm volatile("" ::: "memory");
}
__device__ __forceinline__ void convert_weights(const Params& p, LAS unsigned char* lds, int l, int cw, int ncw) {
    const int tid = ltid(), lane = tid & 63, wave = tid >> 6;
    LAS float* scr = (LAS float*)(lds + wave * 16384);
    if (cw < CV_NIT) {
        f32x4 wa[8], wb[8];
        CvItem ca = cv_decode(p, l, cw, lane), cb = ca;
        cv_load(ca, wa);
        for (int it = cw;;) {
            const int i1 = it + ncw; const bool h1 = i1 < CV_NIT;
            if (h1) { cb = cv_decode(p, l, i1, lane); cv_load(cb, wb); }
            cv_store(ca, wa, scr, lane);
            if (!h1) break;
            const int i2 = i1 + ncw; const bool h2 = i2 < CV_NIT;
            if (h2) { ca = cv_decode(p, l, i2, lane); cv_load(ca, wa); }
            cv_store(cb, wb, scr, lane);
            if (!h2) break;
            it = i2;
        }
    }
}

__device__ __forceinline__ void phase_convert(const Params& p, LAS unsigned char* lds) {
    const int tid = ltid(), wave = tid >> 6;
    const int l = p.layer;
    GAS unsigned char* ws = (GAS unsigned char*)p.ws;
    convert_weights(p, lds, 0, (int)blockIdx.x * NWAVES + wave, (int)gridDim.x * NWAVES);
    if (l == 0) {
        const GAS f32x4* xs = (const GAS f32x4*)p.x; GAS u32x2* xd = (GAS u32x2*)(ws + WS_XB);
        const unsigned n4 = (unsigned)((size_t)M * DM / 4), st_ = gridDim.x * NTHR;
        for (unsigned i = blockIdx.x * NTHR + tid; i < n4; i += 4 * st_) { f32x4 v[4];
#pragma unroll
            for (int q = 0; q < 4; ++q) v[q] = xs[i + q * st_];
#pragma unroll
            for (int q = 0; q < 4; ++q) { u32x2 o; o.x = pk2(v[q].x, v[q].y); o.y = pk2(v[q].z, v[q].w); xd[i + q * st_] = o; } }
        if (blockIdx.x == 0) {
            GAS float* bl = (GAS float*)(ws + WS_BLUT);
            for (int i = tid; i < 8 * 132; i += NTHR) { const int h = i / 132, d = i % 132; const int dd = d > 128 ? 128 : d;
                bl[i] = ((const GAS float*)p.rel_bias)[(int)T5_LUT[dd] * 8 + h] * 11.313708498984761f; }
        }
    }
}

__device__ __forceinline__ float wave_sum(float v) {
#pragma unroll
    for (int o = 1; o < 64; o <<= 1) v += __shfl_xor(v, o);
    return v;
}
__device__ __forceinline__ float wave_sum_dpp(float v) {
    v += __builtin_bit_cast(float, __builtin_amdgcn_update_dpp(0, __builtin_bit_cast(int, v), 0x111, 0xf, 0xf, false));
    v += __builtin_bit_cast(float, __builtin_amdgcn_update_dpp(0, __builtin_bit_cast(int, v), 0x112, 0xf, 0xf, false));
    v += __builtin_bit_cast(float, __builtin_amdgcn_update_dpp(0, __builtin_bit_cast(int, v), 0x114, 0xf, 0xf, false));
    v += __builtin_bit_cast(float, __builtin_amdgcn_update_dpp(0, __builtin_bit_cast(int, v), 0x118, 0xf, 0xf, false));
    v += __builtin_bit_cast(float, __builtin_amdgcn_update_dpp(0, __builtin_bit_cast(int, v), 0x142, 0xa, 0xf, false));
    v += __builtin_bit_cast(float, __builtin_amdgcn_update_dpp(0, __builtin_bit_cast(int, v), 0x143, 0xc, 0xf, false));
    return __builtin_bit_cast(float, __builtin_amdgcn_readlane(__builtin_bit_cast(int, v), 63));
}
constexpr int LNR = 4;
__device__ __forceinline__ void phase_ln(const Params& p, const float* gptr, const float* bptr, bool final_out) {
    const int tid = ltid(), lane = tid & 63, wave = tid >> 6;
    const int gw = blockIdx.x * NWAVES + wave, NGW = gridDim.x * NWAVES;
    const GAS f32x4* g4 = (const GAS f32x4*)(gptr + (size_t)p.layer * DM) + lane;
    const GAS f32x4* b4 = (const GAS f32x4*)(bptr + (size_t)p.layer * DM) + lane;
    GAS unsigned char* ws = (GAS unsigned char*)p.ws;
    for (int m0 = LNR * gw; m0 < M; m0 += LNR * NGW) {
        f32x4 v[LNR][8]; float s[LNR];
#pragma unroll
        for (int r = 0; r < LNR; ++r) { const GAS f32x4* xr = (const GAS f32x4*)(p.out + (size_t)(m0 + r) * DM) + lane; s[r] = 0.f;
#pragma unroll
            for (int j = 0; j < 8; ++j) { v[r][j] = xr[64 * j]; s[r] += (v[r][j].x + v[r][j].y) + (v[r][j].z + v[r][j].w); } }
        float mean[LNR], rstd[LNR];
#pragma unroll
        for (int r = 0; r < LNR; ++r) mean[r] = wave_sum_dpp(s[r]) * (1.f / DM);
#pragma unroll
        for (int r = 0; r < LNR; ++r) { float s2 = 0.f;
#pragma unroll
            for (int j = 0; j < 8; ++j) { v[r][j] = v[r][j] - mean[r]; s2 += (v[r][j].x * v[r][j].x + v[r][j].y * v[r][j].y) + (v[r][j].z * v[r][j].z + v[r][j].w * v[r][j].w); }
            s[r] = s2; }
#pragma unroll
        for (int r = 0; r < LNR; ++r) rstd[r] = 1.0f / sqrtf(wave_sum_dpp(s[r]) * (1.f / DM) + LN_EPS);
#pragma unroll
        for (int r = 0; r < LNR; ++r) if (lane == r) ((GAS f32x2*)(ws + WS_STATS))[m0 + r] = (f32x2){mean[r], rstd[r]};
#pragma unroll
        for (int j = 0; j < 8; ++j) { const f32x4 g = g4[64 * j], b = b4[64 * j];
#pragma unroll
            for (int r = 0; r < LNR; ++r) { const f32x4 y = v[r][j] * rstd[r] * g + b;
                if (final_out) ((GAS f32x4*)(p.out + (size_t)(m0 + r) * DM) + lane)[64 * j] = y;
                if (!final_out) { u32x2 o; o.x = pk2(y.x, y.y); o.y = pk2(y.z, y.w); ((GAS u32x2*)(ws + WS_XB + (size_t)(m0 + r) * DM * 2) + lane)[64 * j] = o; } } }
    }
}

__device__ __forceinline__ void phase_ln_b(const Params& p, const float* gptr, const float* bptr, bool final_out) {
    const int tid = ltid(), lane = tid & 63, wave = tid >> 6;
    const int gw = blockIdx.x * NWAVES + wave, NGW = gridDim.x * NWAVES;
    const GAS float* gp = (const GAS float*)(gptr + (size_t)p.layer * DM) + lane * 8;
    const GAS float* bp = (const GAS float*)(bptr + (size_t)p.layer * DM) + lane * 8;
    GAS unsigned char* ws = (GAS unsigned char*)p.ws;
    for (int m0 = LNR * gw; m0 < M; m0 += LNR * NGW) {
        float v[LNR][4][8]; float s[LNR];
#pragma unroll
        for (int r = 0; r < LNR; ++r) { const GAS u32x4* yr = (const GAS u32x4*)(ws + WS_YB + (size_t)(m0 + r) * DM * 2) + lane; s[r] = 0.f;
            u32x4 t[4];
#pragma unroll
            for (int j = 0; j < 4; ++j) t[j] = yr[64 * j];
#pragma unroll
            for (int j = 0; j < 4; ++j) { v[r][j][0] = bflo(t[j].x); v[r][j][1] = bfhi(t[j].x); v[r][j][2] = bflo(t[j].y); v[r][j][3] = bfhi(t[j].y);
                v[r][j][4] = bflo(t[j].z); v[r][j][5] = bfhi(t[j].z); v[r][j][6] = bflo(t[j].w); v[r][j][7] = bfhi(t[j].w);
                s[r] += ((v[r][j][0] + v[r][j][1]) + (v[r][j][2] + v[r][j][3])) + ((v[r][j][4] + v[r][j][5]) + (v[r][j][6] + v[r][j][7])); } }
        float mean[LNR], rstd[LNR];
#pragma unroll
        for (int r = 0; r < LNR; ++r) mean[r] = wave_sum_dpp(s[r]) * (1.f / DM);
#pragma unroll
        for (int r = 0; r < LNR; ++r) { float s2 = 0.f;
#pragma unroll
            for (int j = 0; j < 4; ++j)
#pragma unroll
                for (int e = 0; e < 8; ++e) { v[r][j][e] -= mean[r]; s2 += v[r][j][e] * v[r][j][e]; }
            s[r] = s2; }
#pragma unroll
        for (int r = 0; r < LNR; ++r) rstd[r] = 1.0f / sqrtf(wave_sum_dpp(s[r]) * (1.f / DM) + LN_EPS);
#pragma unroll
        for (int r = 0; r < LNR; ++r) if (lane == r) ((GAS f32x2*)(ws + WS_STATS))[m0 + r] = (f32x2){mean[r], rstd[r]};
#pragma unroll
        for (int j = 0; j < 4; ++j) { const f32x4 g0 = *(const GAS f32x4*)(gp + 512 * j), g1 = *(const GAS f32x4*)(gp + 512 * j + 4), b0 = *(const GAS f32x4*)(bp + 512 * j), b1 = *(const GAS f32x4*)(bp + 512 * j + 4);
            const float gg[8] = {g0.x, g0.y, g0.z, g0.w, g1.x, g1.y, g1.z, g1.w}, bb[8] = {b0.x, b0.y, b0.z, b0.w, b1.x, b1.y, b1.z, b1.w};
#pragma unroll
            for (int r = 0; r < LNR; ++r) { float y[8];
#pragma unroll
                for (int e = 0; e < 8; ++e) y[e] = v[r][j][e] * rstd[r] * gg[e] + bb[e];
                if (final_out) { GAS f32x4* op = (GAS f32x4*)(p.out + (size_t)(m0 + r) * DM + 512 * j + lane * 8); op[0] = (f32x4){y[0], y[1], y[2], y[3]}; op[1] = (f32x4){y[4], y[5], y[6], y[7]}; }
                u32x4 o; o.x = pk2(y[0], y[1]); o.y = pk2(y[2], y[3]); o.z = pk2(y[4], y[5]); o.w = pk2(y[6], y[7]);
                ((GAS u32x4*)(ws + WS_XB + (size_t)(m0 + r) * DM * 2) + lane)[64 * j] = o; } }
    }
}

struct EpiProj {
    static constexpr bool PERM = true, AFTER_DRAIN = false;
    unsigned char* ws;
    __device__ __forceinline__ void operator()(const pg8::f32x4 (&acc)[2][2][4][2], const pg8::Unit& u, int wr, int wc, int fr, int fq) const {
        GAS unsigned char* w = (GAS unsigned char*)ws;
        const int row0 = u.pm * 256 + wr * 64 + fr, cin = wc * 32 + 8 * fq, pn = u.pn;
        if (pn < 28) {
            GAS bf16* base; int ld, colt; bool act = false;
            if (pn < 12) { base = (GAS bf16*)(w + WS_GQKV); ld = 3072; colt = pn * 256; }
            else if (pn < 16) { base = (GAS bf16*)(w + WS_ZB); ld = 1024; colt = (pn - 12) * 256; act = true; }
            else { const int t = (pn - 16) >> 2; base = (GAS bf16*)(w + WS_QB + (size_t)t * 64 * MiB); ld = 1024; colt = ((pn - 16) & 3) * 256; }
#pragma unroll
            for (int ai = 0; ai < 2; ++ai)
#pragma unroll
                for (int m = 0; m < 4; ++m) { GAS bf16* rowp = base + (size_t)(row0 + ai * 128 + m * 16) * ld + colt + cin;
#pragma unroll
                    for (int bj = 0; bj < 2; ++bj) { pg8::f32x4 v0 = acc[ai][bj][m][0], v1 = acc[ai][bj][m][1];
                        if (act) {
#pragma unroll
                            for (int j = 0; j < 4; ++j) { v0[j] = siluf_(v0[j]); v1[j] = siluf_(v1[j]); } }
                        u32x4 o; o.x = pk2(v0[0], v0[1]); o.y = pk2(v0[2], v0[3]); o.z = pk2(v1[0], v1[1]); o.w = pk2(v1[2], v1[3]);
                        *(GAS u32x4*)(rowp + bj * 128) = o; } }
        } else {
            typedef _Float16 h8_t __attribute__((ext_vector_type(8)));
#pragma unroll
            for (int ai = 0; ai < 2; ++ai)
#pragma unroll
                for (int m = 0; m < 4; ++m) { const size_t row = (size_t)(row0 + ai * 128 + m * 16);
#pragma unroll
                    for (int bj = 0; bj < 2; ++bj) { const pg8::f32x4 v0 = acc[ai][bj][m][0], v1 = acc[ai][bj][m][1];
                        const int c = (pn - 28) * 256 + bj * 128 + cin;
                        if (c < 576) { const h8_t o = {(_Float16)v0[0], (_Float16)v0[1], (_Float16)v0[2], (_Float16)v0[3], (_Float16)v1[0], (_Float16)v1[1], (_Float16)v1[2], (_Float16)v1[3]};
                            if (c < 512) *(GAS h8_t*)((GAS _Float16*)(w + WS_QI) + row * 512 + c) = o; else *(GAS h8_t*)((GAS _Float16*)(w + WS_KI) + row * 64 + (c - 512)) = o; }
                        else if (c < 600) { GAS float* d = (GAS float*)(w + WS_SM) + row * 32 + (c - 576); *(GAS pg8::f32x4*)d = v0; *(GAS pg8::f32x4*)(d + 4) = v1; } } }
        }
    }
};
struct EpiGate {
    static constexpr bool PERM = true, AFTER_DRAIN = false;
    unsigned char* ws;
    __device__ __forceinline__ void operator()(const pg8::f32x4 (&acc)[2][2][4][2], const pg8::Unit& u, int wr, int wc, int fr, int fq) const {
        GAS bf16* base = (GAS bf16*)((GAS unsigned char*)ws + WS_GATES);
        const int row0 = u.pm * 256 + wr * 64 + fr, col0 = u.pn * 256 + wc * 32 + 8 * fq;
#pragma unroll
        for (int ai = 0; ai < 2; ++ai)
#pragma unroll
            for (int m = 0; m < 4; ++m) { GAS bf16* rowp = base + (size_t)(row0 + ai * 128 + m * 16) * NGT + col0;
#pragma unroll
                for (int bj = 0; bj < 2; ++bj) { pg8::f32x4 v0 = acc[ai][bj][m][0], v1 = acc[ai][bj][m][1];
#pragma unroll
                    for (int j = 0; j < 4; ++j) { v0[j] = sigmoidf_(v0[j]); v1[j] = sigmoidf_(v1[j]); }
                    u32x4 o; o.x = pk2(v0[0], v0[1]); o.y = pk2(v0[2], v0[3]); o.z = pk2(v1[0], v1[1]); o.w = pk2(v1[2], v1[3]);
                    *(GAS u32x4*)(rowp + bj * 128) = o; } }
    }
};
template <int SECOND> struct EpiBranch {
    static constexpr bool PERM = true, AFTER_DRAIN = false;
    unsigned char* ws;
    __device__ __forceinline__ void operator()(const pg8::f32x4 (&acc)[2][2][4][2], const pg8::Unit& u, int wr, int wc, int fr, int fq) const {
        const GAS unsigned char* gates = (const GAS unsigned char*)ws + WS_GATES + (SECOND ? 2048 * 2 : 0);
        GAS unsigned char* mg = (GAS unsigned char*)ws + WS_MERGED;
        const int row0 = u.pm * 256 + wr * 64 + fr, col0 = u.pn * 256 + wc * 32 + 8 * fq;
#pragma unroll
        for (int ai = 0; ai < 2; ++ai) {
            u32x4 gv[4][2];
#pragma unroll
            for (int m = 0; m < 4; ++m)
#pragma unroll
                for (int bj = 0; bj < 2; ++bj) gv[m][bj] = *(const GAS u32x4*)(gates + ((size_t)(row0 + ai * 128 + m * 16) * NGT + col0 + bj * 128) * 2);
#pragma unroll
            for (int m = 0; m < 4; ++m)
#pragma unroll
                for (int bj = 0; bj < 2; ++bj) { const pg8::f32x4 v0 = acc[ai][bj][m][0], v1 = acc[ai][bj][m][1]; const u32x4 g = gv[m][bj];
                    float r[8] = {bflo(g.x) * v0[0], bfhi(g.x) * v0[1], bflo(g.y) * v0[2], bfhi(g.y) * v0[3], bflo(g.z) * v1[0], bfhi(g.z) * v1[1], bflo(g.w) * v1[2], bfhi(g.w) * v1[3]};
                    if (SECOND) { const u32x4 t = *(const GAS u32x4*)(mg + ((size_t)(row0 + ai * 128 + m * 16) * DM + col0 + bj * 128) * 2); r[0] += bflo(t.x); r[1] += bfhi(t.x); r[2] += bflo(t.y); r[3] += bfhi(t.y); r[4] += bflo(t.z); r[5] += bfhi(t.z); r[6] += bflo(t.w); r[7] += bfhi(t.w); }
                    u32x4 o; o.x = pk2(r[0], r[1]); o.y = pk2(r[2], r[3]); o.z = pk2(r[4], r[5]); o.w = pk2(r[6], r[7]);
                    *(GAS u32x4*)(mg + ((size_t)(row0 + ai * 128 + m * 16) * DM + col0 + bj * 128) * 2) = o; }
        }
    }
};
struct EpiResid {
    static constexpr bool PERM = false, AFTER_DRAIN = false;
    const float* yprev; float* out; const float* stats; const float* g; const float* b;
    __device__ __forceinline__ void operator()(const pg8::f32x4 (&acc)[2][2][4][2], const pg8::Unit& u, int wr, int wc, int fr, int fq) const {
        const int row0 = u.pm * 256 + wr * 64 + fr, col0 = u.pn * 256 + wc * 32 + 4 * fq;
        f32x4 gv[2][2], bv[2][2];
        if (g) {
#pragma unroll
            for (int bj = 0; bj < 2; ++bj)
#pragma unroll
                for (int n = 0; n < 2; ++n) { gv[bj][n] = *(const GAS f32x4*)(g + col0 + bj * 128 + n * 16); bv[bj][n] = *(const GAS f32x4*)(b + col0 + bj * 128 + n * 16); }
        }
#pragma unroll
        for (int ai = 0; ai < 2; ++ai)
#pragma unroll
            for (int mp = 0; mp < 2; ++mp) {
                f32x4 rr[2][2][2]; f32x2 ms[2];
#pragma unroll
                for (int mm = 0; mm < 2; ++mm) { const int row = row0 + ai * 128 + (2 * mp + mm) * 16; const size_t off = (size_t)row * DM + col0;
                    if (g) ms[mm] = ((const GAS f32x2*)stats)[row]; else { ms[mm].x = 0.f; ms[mm].y = 0.f; }
#pragma unroll
                    for (int bj = 0; bj < 2; ++bj)
#pragma unroll
                        for (int n = 0; n < 2; ++n) rr[mm][bj][n] = *(const GAS f32x4*)(yprev + off + bj * 128 + n * 16); }
#pragma unroll
                for (int mm = 0; mm < 2; ++mm) { const int m = 2 * mp + mm; const size_t off = (size_t)(row0 + ai * 128 + m * 16) * DM + col0;
#pragma unroll
                    for (int bj = 0; bj < 2; ++bj)
#pragma unroll
                        for (int n = 0; n < 2; ++n) { f32x4 r = rr[mm][bj][n];
                            if (g) r = (r - ms[mm].x) * ms[mm].y * gv[bj][n] + bv[bj][n];
                            *(GAS f32x4*)(out + off + bj * 128 + n * 16) = r * ALPHA + acc[ai][bj][m][n]; } }
            }
    }
};
struct EpiResidB {
    static constexpr bool PERM = true, AFTER_DRAIN = false;
    unsigned char* ws; const float* xf;
    __device__ __forceinline__ void operator()(const pg8::f32x4 (&acc)[2][2][4][2], const pg8::Unit& u, int wr, int wc, int fr, int fq) const {
        const int row0 = u.pm * 256 + wr * 64 + fr, col0 = u.pn * 256 + wc * 32 + 8 * fq;
        GAS unsigned char* yb = (GAS unsigned char*)ws + WS_YB;
#pragma unroll
        for (int ai = 0; ai < 2; ++ai) {
            float x[4][2][8];
            if (xf) {
                f32x4 t[4][2][2];
#pragma unroll
                for (int m = 0; m < 4; ++m)
#pragma unroll
                    for (int bj = 0; bj < 2; ++bj) { const GAS float* xp = (const GAS float*)xf + (size_t)(row0 + ai * 128 + m * 16) * DM + col0 + bj * 128; t[m][bj][0] = *(const GAS f32x4*)xp; t[m][bj][1] = *(const GAS f32x4*)(xp + 4); }
#pragma unroll
                for (int m = 0; m < 4; ++m)
#pragma unroll
                    for (int bj = 0; bj < 2; ++bj)
#pragma unroll
                        for (int e = 0; e < 4; ++e) { x[m][bj][e] = t[m][bj][0][e]; x[m][bj][4 + e] = t[m][bj][1][e]; }
            } else {
                u32x4 t[4][2];
#pragma unroll
                for (int m = 0; m < 4; ++m)
#pragma unroll
                    for (int bj = 0; bj < 2; ++bj) t[m][bj] = *(const GAS u32x4*)((const GAS unsigned char*)ws + WS_XB + ((size_t)(row0 + ai * 128 + m * 16) * DM + col0 + bj * 128) * 2);
#pragma unroll
                for (int m = 0; m < 4; ++m)
#pragma unroll
                    for (int bj = 0; bj < 2; ++bj) { const u32x4 q = t[m][bj]; x[m][bj][0] = bflo(q.x); x[m][bj][1] = bfhi(q.x); x[m][bj][2] = bflo(q.y); x[m][bj][3] = bfhi(q.y);
                        x[m][bj][4] = bflo(q.z); x[m][bj][5] = bfhi(q.z); x[m][bj][6] = bflo(q.w); x[m][bj][7] = bfhi(q.w); }
            }
#pragma unroll
            for (int m = 0; m < 4; ++m)
#pragma unroll
                for (int bj = 0; bj < 2; ++bj) { const pg8::f32x4 v0 = acc[ai][bj][m][0], v1 = acc[ai][bj][m][1];
                    float r[8];
#pragma unroll
                    for (int e = 0; e < 4; ++e) { r[e] = x[m][bj][e] * ALPHA + v0[e]; r[4 + e] = x[m][bj][4 + e] * ALPHA + v1[e]; }
                    u32x4 o; o.x = pk2(r[0], r[1]); o.y = pk2(r[2], r[3]); o.z = pk2(r[4], r[5]); o.w = pk2(r[6], r[7]);
                    *(GAS u32x4*)(yb + ((size_t)(row0 + ai * 128 + m * 16) * DM + col0 + bj * 128) * 2) = o; }
        }
    }
};
struct EpiResidC {
    static constexpr bool PERM = true, AFTER_DRAIN = false;
    unsigned char* ws; const float* xf; const float* g; const float* b; float* yf;
    __device__ __forceinline__ void operator()(const pg8::f32x4 (&acc)[2][2][4][2], const pg8::Unit& u, int wr, int wc, int fr, int fq) const {
        const int row0 = u.pm * 256 + wr * 64 + fr, col0 = u.pn * 256 + wc * 32 + 8 * fq;
        GAS unsigned char* yb = (GAS unsigned char*)ws + WS_YB;
        if (xf) {
#pragma unroll
            for (int ai = 0; ai < 2; ++ai)
#pragma unroll
                for (int mp = 0; mp < 2; ++mp) { f32x4 t[2][2][2];
#pragma unroll
                    for (int mm = 0; mm < 2; ++mm)
#pragma unroll
                        for (int bj = 0; bj < 2; ++bj) { const GAS float* xp = (const GAS float*)xf + (size_t)(row0 + ai * 128 + (2 * mp + mm) * 16) * DM + col0 + bj * 128; t[mm][bj][0] = *(const GAS f32x4*)xp; t[mm][bj][1] = *(const GAS f32x4*)(xp + 4); }
#pragma unroll
                    for (int mm = 0; mm < 2; ++mm)
#pragma unroll
                        for (int bj = 0; bj < 2; ++bj) { const int m = 2 * mp + mm; const pg8::f32x4 r0 = t[mm][bj][0] * ALPHA + acc[ai][bj][m][0], r1 = t[mm][bj][1] * ALPHA + acc[ai][bj][m][1];
                            u32x4 o; o.x = pk2(r0[0], r0[1]); o.y = pk2(r0[2], r0[3]); o.z = pk2(r1[0], r1[1]); o.w = pk2(r1[2], r1[3]);
                            *(GAS u32x4*)(yb + ((size_t)(row0 + ai * 128 + m * 16) * DM + col0 + bj * 128) * 2) = o; } }
            return;
        }
        f32x4 gv[2][2], bv[2][2];
#pragma unroll
        for (int bj = 0; bj < 2; ++bj)
#pragma unroll
            for (int n = 0; n < 2; ++n) { gv[bj][n] = *(const GAS f32x4*)((const GAS float*)g + col0 + bj * 128 + n * 4); bv[bj][n] = *(const GAS f32x4*)((const GAS float*)b + col0 + bj * 128 + n * 4); }
#pragma unroll
        for (int ai = 0; ai < 2; ++ai)
#pragma unroll
            for (int mp = 0; mp < 2; ++mp) {
                u32x4 t[2][2]; f32x2 ms[2];
#pragma unroll
                for (int mm = 0; mm < 2; ++mm) { const int row = row0 + ai * 128 + (2 * mp + mm) * 16; ms[mm] = ((const GAS f32x2*)((const GAS unsigned char*)ws + WS_STATS))[row];
#pragma unroll
                    for (int bj = 0; bj < 2; ++bj) t[mm][bj] = *(const GAS u32x4*)(yb + ((size_t)row * DM + col0 + bj * 128) * 2); }
#pragma unroll
                for (int mm = 0; mm < 2; ++mm)
#pragma unroll
                    for (int bj = 0; bj < 2; ++bj) { const int m = 2 * mp + mm; const u32x4 q = t[mm][bj];
                        pg8::f32x4 y0 = {bflo(q.x), bfhi(q.x), bflo(q.y), bfhi(q.y)}, y1 = {bflo(q.z), bfhi(q.z), bflo(q.w), bfhi(q.w)};
                        y0 = (y0 - ms[mm].x) * ms[mm].y * gv[bj][0] + bv[bj][0]; y1 = (y1 - ms[mm].x) * ms[mm].y * gv[bj][1] + bv[bj][1];
                        const pg8::f32x4 r0 = y0 * ALPHA + acc[ai][bj][m][0], r1 = y1 * ALPHA + acc[ai][bj][m][1];
                        if (yf) { GAS pg8::f32x4* op = (GAS pg8::f32x4*)((GAS float*)yf + (size_t)(row0 + ai * 128 + m * 16) * DM + col0 + bj * 128); op[0] = r0; op[1] = r1; }
                        else { u32x4 o; o.x = pk2(r0[0], r0[1]); o.y = pk2(r0[2], r0[3]); o.z = pk2(r1[0], r1[1]); o.w = pk2(r1[2], r1[3]);
                            *(GAS u32x4*)(yb + ((size_t)(row0 + ai * 128 + m * 16) * DM + col0 + bj * 128) * 2) = o; } }
            }
    }
};
struct EpiSwiGLU {
    static constexpr bool PERM = true, AFTER_DRAIN = false;
    unsigned char* ws;
    __device__ __forceinline__ void operator()(const pg8::f32x4 (&acc)[2][2][4][2], const pg8::Unit& u, int wr, int wc, int fr, int fq) const {
        GAS bf16* base = (GAS bf16*)((GAS unsigned char*)ws + WS_HID);
        const int row0 = u.pm * 256 + wr * 64 + fr, col0 = u.pn * 128 + wc * 32 + 8 * fq;
#pragma unroll
        for (int ai = 0; ai < 2; ++ai)
#pragma unroll
            for (int m = 0; m < 4; ++m) { GAS bf16* rowp = base + (size_t)(row0 + ai * 128 + m * 16) * DFF + col0;
                float r[8];
#pragma unroll
                for (int n = 0; n < 2; ++n)
#pragma unroll
                    for (int j = 0; j < 4; ++j) r[4 * n + j] = siluf_(acc[ai][0][m][n][j]) * acc[ai][1][m][n][j];
                u32x4 o; o.x = pk2(r[0], r[1]); o.y = pk2(r[2], r[3]); o.z = pk2(r[4], r[5]); o.w = pk2(r[6], r[7]);
                *(GAS u32x4*)rowp = o; }
    }
};

__device__ __forceinline__ float softplusf_(float x) { return fmaxf(x, 0.f) + __logf(1.0f + __expf(-fabsf(x))); }
__device__ __forceinline__ f32x4 mfma16(bf16x8 a, bf16x8 b, f32x4 c) { return __builtin_amdgcn_mfma_f32_16x16x32_bf16(a, b, c, 0, 0, 0); }

__device__ __forceinline__ void conv_ld_w(const GAS float* cw, f32x4 (&w)[4][2]) {
#pragma unroll
    for (int j = 0; j < 4; ++j) { w[j][0] = *(const GAS f32x4*)(cw + (size_t)j * 3072); w[j][1] = *(const GAS f32x4*)(cw + (size_t)j * 3072 + 4); }
}
__device__ __forceinline__ bf16x8 pack8s(const float (&y)[8], float sc) {
    u32x4 w; w.x = pk2(y[0] * sc, y[1] * sc); w.y = pk2(y[2] * sc, y[3] * sc); w.z = pk2(y[4] * sc, y[5] * sc); w.w = pk2(y[6] * sc, y[7] * sc);
    return __builtin_bit_cast(bf16x8, w);
}

__device__ __forceinline__ float row16_sum(float v) {
    v += __builtin_bit_cast(float, __builtin_amdgcn_update_dpp(0, __builtin_bit_cast(int, v), 0xB1, 0xF, 0xF, true));
    v += __builtin_bit_cast(float, __builtin_amdgcn_update_dpp(0, __builtin_bit_cast(int, v), 0x4E, 0xF, 0xF, true));
    v += __builtin_bit_cast(float, __builtin_amdgcn_update_dpp(0, __builtin_bit_cast(int, v), 0x141, 0xF, 0xF, true));
    v += __builtin_bit_cast(float, __builtin_amdgcn_update_dpp(0, __builtin_bit_cast(int, v), 0x140, 0xF, 0xF, true));
    return v;
}
__device__ __forceinline__ void phase_gdn_local(const Params& p, LAS unsigned char* lds) {
    const int tid = ltid(), lane0 = tid & 63, wave = __builtin_amdgcn_readfirstlane(tid >> 6);
    const int gw = blockIdx.x * NWAVES + wave, NGW = gridDim.x * NWAVES;
    GAS unsigned char* ws = (GAS unsigned char*)p.ws;
    const int l = p.layer;
    LAS float* Mw = (LAS float*)(lds + wave * 16384);
    const GAS float* cwl = (const GAS float*)p.conv_w + (size_t)l * 4 * 3072;
    for (int u = gw; u < NB * NCH * NH; u += NGW) {
        int lane = lane0; asm volatile("" : "+v"(lane));
        const int rb = lane >> 4, cc = lane & 15;
        const int b = u >> 10, n = (u >> 3) & 127, h = u & 7;
        const int t0 = n * CH; const size_t row0 = (size_t)b * SEQ + t0;
        const size_t hm0 = ((size_t)(b * NH + h) * SEQ + t0) * HD;
        const GAS unsigned char* gqb = ws + WS_GQKV + (row0 * 3072) * 2 - 3 * 6144;
#pragma unroll 1
        for (int tq = 0; tq < 3; ++tq) {
            const int gcol = (tq == 0 ? 2048 : (tq == 1 ? 1024 : 0)) + h * 128 + 8 * cc;
            f32x4 cw[4][2]; conv_ld_w(cwl + gcol, cw);
            u32x4 xr[19];
#pragma unroll
            for (int i = 0; i < 19; ++i) { const int tr = 16 * rb - 3 + i; const bool ok = (t0 + tr) >= 0;
                xr[i] = *(const GAS u32x4*)(gqb + (unsigned)((ok ? tr + 3 : 3) * 6144 + gcol * 2)); if (!ok) xr[i] = (u32x4){0u, 0u, 0u, 0u}; }
            GAS unsigned char* dst = ws + (tq == 0 ? WS_VN : (tq == 1 ? WS_KN : WS_QN)) + hm0 * 2;
            const float qs = (tq == 2) ? 0.08838834764831845f : 1.0f;
#pragma unroll
            for (int i = 0; i < 16; ++i) {
                float y[8];
#pragma unroll
                for (int e = 0; e < 8; ++e) y[e] = 0.f;
#pragma unroll
                for (int j = 0; j < 4; ++j) { const u32x4 x_ = xr[i + j];
                    y[0] += bflo(x_.x) * cw[j][0].x; y[1] += bfhi(x_.x) * cw[j][0].y; y[2] += bflo(x_.y) * cw[j][0].z; y[3] += bfhi(x_.y) * cw[j][0].w;
                    y[4] += bflo(x_.z) * cw[j][1].x; y[5] += bfhi(x_.z) * cw[j][1].y; y[6] += bflo(x_.w) * cw[j][1].z; y[7] += bfhi(x_.w) * cw[j][1].w; }
                float ss = 0.f;
#pragma unroll
                for (int e = 0; e < 8; ++e) { y[e] = siluf_(y[e]); ss += y[e] * y[e]; }
                float sc = 1.0f;
                if (tq != 0) sc = qs / sqrtf(row16_sum(ss) + RMS_EPS);
                *(GAS bf16x8*)(dst + (unsigned)(((16 * rb + i) * HD + 8 * cc) * 2)) = pack8s(y, sc);
            }
        }
    }
    VM_WAIT();
    for (int u = gw; u < NB * NCH * NH; u += NGW) {
        int lane = lane0; asm volatile("" : "+v"(lane));
        const int g = lane >> 4, r16 = lane & 15;
        const int b = u >> 10, n = (u >> 3) & 127, h = u & 7;
        const int t0 = n * CH; const size_t row0 = (size_t)b * SEQ + t0;
        const size_t hm0 = ((size_t)(b * NH + h) * SEQ + t0) * HD;
        bf16x8 kf[4][4];
#pragma unroll
        for (int rt = 0; rt < 4; ++rt)
#pragma unroll
            for (int ks = 0; ks < 4; ++ks) kf[rt][ks] = *(const GAS bf16x8*)(ws + WS_KN + hm0 * 2 + (unsigned)(((16 * rt + r16) * HD + 32 * ks + 8 * g) * 2));
        bf16x8 qf[4][4];
#pragma unroll
        for (int rt = 0; rt < 4; ++rt)
#pragma unroll
            for (int ks = 0; ks < 4; ++ks) qf[rt][ks] = *(const GAS bf16x8*)(ws + WS_QN + hm0 * 2 + (unsigned)(((16 * rt + r16) * HD + 32 * ks + 8 * g) * 2));
        float gc, beta;
        { const GAS float* sm = (const GAS float*)(ws + WS_SM) + (row0 + lane) * 32;
          const float a_in = sm[8 + h], b_in = sm[16 + h];
          gc = -__expf(((const GAS float*)p.a_log)[l * NH + h]) * softplusf_(a_in + ((const GAS float*)p.dt_bias)[l * NH + h]);
          beta = 1.0f / (1.0f + __expf(-b_in));
#pragma unroll
          for (int o = 1; o < 64; o <<= 1) { const float t = __shfl_up(gc, o); if (lane >= o) gc += t; }
          GAS f32x2* gb = (GAS f32x2*)(ws + WS_GCB) + ((size_t)(b * NH + h) * SEQ + t0 + lane);
          *gb = (f32x2){gc, beta}; }
        float gi[4], bi[4], gj[4][4];
#pragma unroll
        for (int rt = 0; rt < 4; ++rt) { gi[rt] = __shfl(gc, 16 * rt + r16); bi[rt] = __shfl(beta, 16 * rt + r16); }
#pragma unroll
        for (int ct = 0; ct < 4; ++ct)
#pragma unroll
            for (int r = 0; r < 4; ++r) gj[ct][r] = __shfl(gc, 16 * ct + 4 * g + r);
        f32x4 mvals[10];
        { int ti = 0;
#pragma unroll
          for (int rt = 0; rt < 4; ++rt)
#pragma unroll
            for (int ct = 0; ct <= rt; ++ct) {
                const int i = 16 * rt + r16, j0 = 16 * ct + 4 * g;
                f32x4 kk = (f32x4){0.f, 0.f, 0.f, 0.f};
#pragma unroll
                for (int ks = 0; ks < 4; ++ks) kk = mfma16(kf[ct][ks], kf[rt][ks], kk);
#pragma unroll
                for (int r = 0; r < 4; ++r) { const int j = j0 + r; const float dec = __expf(fminf(gi[rt] - gj[ct][r], 0.f)); mvals[ti][r] = (j < i) ? bi[rt] * kk[r] * dec : 0.f; }
                ++ti; } }
        GAS bf16* Ag = (GAS bf16*)(ws + WS_AA) + (size_t)u * 4096;
        LDS_WAIT(); __builtin_amdgcn_wave_barrier(); asm volatile("" ::: "memory");
#pragma unroll
        for (int rt = 0; rt < 4; ++rt) {
            bf16x8 qfr[4];
#pragma unroll
            for (int ks = 0; ks < 4; ++ks) qfr[ks] = qf[rt][ks];
#pragma unroll
            for (int ct = 0; ct < 4; ++ct) {
                const int i = 16 * rt + r16, j0 = 16 * ct + 4 * g;
                if (ct <= rt) {
                    f32x4 qk = (f32x4){0.f, 0.f, 0.f, 0.f};
#pragma unroll
                    for (int ks = 0; ks < 4; ++ks) qk = mfma16(kf[ct][ks], qfr[ks], qk);
                    f32x4 av;
#pragma unroll
                    for (int r = 0; r < 4; ++r) { const int j = j0 + r; const float dec = __expf(fminf(gi[rt] - gj[ct][r], 0.f)); av[r] = (j <= i) ? qk[r] * dec : 0.f; }
                    u32x2 ao; ao.x = pk2(av[0], av[1]); ao.y = pk2(av[2], av[3]);
                    *(GAS u32x2*)((GAS unsigned char*)Ag + (unsigned)((i * 64 + j0) * 2)) = ao;
                } else {
                    { unsigned zz = 0u; asm volatile("" : "+v"(zz)); *(GAS u32x2*)((GAS unsigned char*)Ag + (unsigned)((i * 64 + j0) * 2)) = (u32x2){zz, zz}; }
                }
            }
            __builtin_amdgcn_sched_barrier(0);
        }
        LDS_WAIT(); __builtin_amdgcn_wave_barrier(); asm volatile("" ::: "memory");
        { int ti = 0;
#pragma unroll
          for (int rt = 0; rt < 4; ++rt)
#pragma unroll
            for (int ct = 0; ct <= rt; ++ct) { *(LAS f32x4*)(Mw + (16 * rt + r16) * 64 + 16 * ct + 4 * g) = mvals[ti]; ++ti; } }
        LDS_WAIT(); __builtin_amdgcn_wave_barrier(); asm volatile("" ::: "memory");
        {
            float x[64];
            GAS bf16* Tg = (GAS bf16*)(ws + WS_TT) + (size_t)u * 4096;
#pragma unroll
            for (int i = 0; i < 64; ++i) {
                float a0 = (i == lane) ? 1.f : 0.f, a1 = 0.f;
#pragma unroll
                for (int j4 = 0; j4 < (i + 3) / 4; ++j4) {
                    const f32x4 m = *(const LAS f32x4*)(Mw + i * 64 + 4 * j4);
#pragma unroll
                    for (int jj = 0; jj < 4; ++jj) { const int j = 4 * j4 + jj; if (j < i) { if (jj & 1) a1 -= m[jj] * x[j]; else a0 -= m[jj] * x[j]; } }
                }
                x[i] = a0 + a1;
                *(GAS bf16*)((GAS unsigned char*)Tg + (unsigned)((i * 64 + lane) * 2)) = (bf16)f2bf(x[i]);
            }
        }
        LDS_WAIT(); __builtin_amdgcn_wave_barrier(); asm volatile("" ::: "memory");
    }
}

#define TRRD(dst, addr, off) asm volatile("ds_read_b64_tr_b16 %0, %1 offset:%2" : "=&v"(dst) : "v"(addr), "i"(off) : "memory")
__device__ __forceinline__ bf16x8 cat4(s16x4 a, s16x4 b) { return (bf16x8){a[0], a[1], a[2], a[3], b[0], b[1], b[2], b[3]}; }
__device__ __forceinline__ bf16x8 pack_cc(f32x4 a, f32x4 b) { u32x4 w; w.x = pk2(a[0], a[1]); w.y = pk2(a[2], a[3]); w.z = pk2(b[0], b[1]); w.w = pk2(b[2], b[3]); return __builtin_bit_cast(bf16x8, w); }

constexpr int SC_K = 0, SC_Q = 17408, SC_V = 34816, SC_O = 52224, SC_T = 69632, SC_A = 78848, SC_GB = 88064, SC_END = 88576;
constexpr int SC_P1 = 272, SC_P2 = 144;

__device__ __forceinline__ void gdn_scan_bh(const Params& p, LAS unsigned char* lds, int bh) {
    const int b = bh >> 3, h = bh & 7;
    const int tid = ltid(), lane = tid & 63, w = tid >> 6, g = lane >> 4, i16 = lane & 15;
    GAS unsigned char* ws = (GAS unsigned char*)p.ws;
    const GAS bf16* KN = (const GAS bf16*)(ws + WS_KN) + (size_t)bh * SEQ * HD;
    const GAS bf16* QN = (const GAS bf16*)(ws + WS_QN) + (size_t)bh * SEQ * HD;
    const GAS bf16* VN = (const GAS bf16*)(ws + WS_VN) + (size_t)bh * SEQ * HD;
    const GAS f32x2* GCB = (const GAS f32x2*)(ws + WS_GCB) + (size_t)bh * SEQ;
    GAS bf16* OA = (GAS bf16*)(ws + WS_OA) + (size_t)b * SEQ * 1024 + h * 128;
    u32x4 st_k[2], st_q[2], st_v[2], st_t, st_a; f32x2 st_gb = (f32x2){0.f, 0.f};
    const int prow = tid >> 4, pch = tid & 15;
    const int trow_ = tid >> 3, tch = tid & 7;
#define SC_LOAD(n_) do { const size_t e0 = (size_t)(n_) * CH * HD; const size_t uu = ((size_t)(b * NCH + (n_)) * NH + h) * 4096; \
        _Pragma("unroll") for (int i_ = 0; i_ < 2; ++i_) { const size_t eo = e0 + (size_t)(prow + 32 * i_) * HD + pch * 8; \
            st_k[i_] = *(const GAS u32x4*)(KN + eo); st_q[i_] = *(const GAS u32x4*)(QN + eo); st_v[i_] = *(const GAS u32x4*)(VN + eo); } \
        st_t = *(const GAS u32x4*)((const GAS bf16*)(ws + WS_TT) + uu + trow_ * 64 + tch * 8); st_a = *(const GAS u32x4*)((const GAS bf16*)(ws + WS_AA) + uu + trow_ * 64 + tch * 8); \
        if (tid < 64) st_gb = GCB[(n_) * CH + tid]; } while (0)
#define SC_WRITE() do { _Pragma("unroll") for (int i_ = 0; i_ < 2; ++i_) { const int o_ = (prow + 32 * i_) * SC_P1 + pch * 16; \
            *(LAS u32x4*)(lds + SC_K + o_) = st_k[i_]; *(LAS u32x4*)(lds + SC_Q + o_) = st_q[i_]; *(LAS u32x4*)(lds + SC_V + o_) = st_v[i_]; } \
        *(LAS u32x4*)(lds + SC_T + trow_ * SC_P2 + tch * 16) = st_t; *(LAS u32x4*)(lds + SC_A + trow_ * SC_P2 + tch * 16) = st_a; \
        if (tid < 64) { ((LAS float*)(lds + SC_GB))[tid] = st_gb.x; ((LAS float*)(lds + SC_GB))[64 + tid] = st_gb.y; } } while (0)
#define SC_LOADZ(n_) do { _Pragma("unroll") for (int i_ = 0; i_ < 2; ++i_) st_z[i_] = *(const GAS u32x4*)(ZBp + (size_t)((n_) * CH + prow + 32 * i_) * 1024 + pch * 8); } while (0)
#define SC_OUT(n_) do { _Pragma("unroll") for (int i_ = 0; i_ < 2; ++i_) { const u32x4 ov_ = *(const LAS u32x4*)(lds + SC_O + (prow + 32 * i_) * SC_P1 + pch * 16); const u32x4 zv_ = st_z[i_]; \
            float o_[8] = {bflo(ov_.x), bfhi(ov_.x), bflo(ov_.y), bfhi(ov_.y), bflo(ov_.z), bfhi(ov_.z), bflo(ov_.w), bfhi(ov_.w)};                          \
            const float z_[8] = {bflo(zv_.x), bfhi(zv_.x), bflo(zv_.y), bfhi(zv_.y), bflo(zv_.z), bfhi(zv_.z), bflo(zv_.w), bfhi(zv_.w)};                    \
            float ss_ = 0.f; _Pragma("unroll") for (int e = 0; e < 8; ++e) ss_ += o_[e] * o_[e];                                                           \
            ss_ = row16_sum(ss_); const float rs_ = __builtin_amdgcn_rsqf(ss_ * (1.0f / HD) + RMS_EPS);                                                     \
            _Pragma("unroll") for (int e = 0; e < 8; ++e) o_[e] = o_[e] * rs_ * nwv[e] * z_[e];                                                            \
            u32x4 r_; r_.x = pk2(o_[0], o_[1]); r_.y = pk2(o_[2], o_[3]); r_.z = pk2(o_[4], o_[5]); r_.w = pk2(o_[6], o_[7]);                               \
            *(GAS u32x4*)(OA + (size_t)((n_) * CH + prow + 32 * i_) * 1024 + pch * 8) = r_; } } while (0)
    u32x4 st_z[2];
    const GAS bf16* ZBp = (const GAS bf16*)(ws + WS_ZB) + (size_t)b * SEQ * 1024 + h * 128;
    float nwv[8];
    { const GAS float* nwp = (const GAS float*)p.gdn_norm_w + (size_t)p.layer * HD + pch * 8; const f32x4 n0 = *(const GAS f32x4*)nwp, n1 = *(const GAS f32x4*)(nwp + 4);
      nwv[0] = n0.x; nwv[1] = n0.y; nwv[2] = n0.z; nwv[3] = n0.w; nwv[4] = n1.x; nwv[5] = n1.y; nwv[6] = n1.z; nwv[7] = n1.w; }
    SC_LOAD(0); SC_WRITE();
    __syncthreads();
    f32x4 Sacc[8];
#pragma unroll
    for (int dt = 0; dt < 8; ++dt) Sacc[dt] = (f32x4){0.f, 0.f, 0.f, 0.f};
    const unsigned rdA = (unsigned)(i16 * SC_P1 + 8 * g);
    const unsigned rdT = (unsigned)(i16 * SC_P2 + 8 * g);
    const unsigned ldsb = (unsigned)(uintptr_t)lds;
    const unsigned trq = (unsigned)((i16 >> 2) * SC_P1 + (i16 & 3) * 8);
    const unsigned trV = ldsb + SC_V + trq + (unsigned)(4 * g * SC_P1 + 32 * w);
    const unsigned trK = ldsb + SC_K + trq + (unsigned)(4 * g * SC_P1);
    for (int n = 0; n < NCH; ++n) {
        if (n > 0) SC_OUT(n - 1);
        SC_LOADZ(n);
        if (n + 1 < NCH) SC_LOAD(n + 1);
        bf16x8 Sb[4];
#pragma unroll
        for (int ks = 0; ks < 4; ++ks) Sb[ks] = pack_cc(Sacc[2 * ks], Sacc[2 * ks + 1]);
        f32x4 KS[4], QS[4];
#pragma unroll
        for (int ct = 0; ct < 4; ++ct) { KS[ct] = (f32x4){0.f, 0.f, 0.f, 0.f}; QS[ct] = (f32x4){0.f, 0.f, 0.f, 0.f};
#pragma unroll
            for (int ks = 0; ks < 4; ++ks) {
                const LAS unsigned char* ka = lds + SC_K + rdA + ct * 16 * SC_P1 + ks * 64; const LAS unsigned char* qa = lds + SC_Q + rdA + ct * 16 * SC_P1 + ks * 64;
                const bf16x8 kfr = cat4(*(const LAS s16x4*)ka, *(const LAS s16x4*)(ka + 32)); const bf16x8 qfr = cat4(*(const LAS s16x4*)qa, *(const LAS s16x4*)(qa + 32));
                KS[ct] = mfma16(kfr, Sb[ks], KS[ct]); QS[ct] = mfma16(qfr, Sb[ks], QS[ct]); } }
        s16x4 vv[4];
#pragma unroll
        for (int ct = 0; ct < 4; ++ct) TRRD(vv[ct], trV, ct * 16 * SC_P1);
        f32x4 gcv[4], btv[4];
#pragma unroll
        for (int ct = 0; ct < 4; ++ct) { gcv[ct] = *(const LAS f32x4*)(lds + SC_GB + (16 * ct + 4 * g) * 4); btv[ct] = *(const LAS f32x4*)(lds + SC_GB + 256 + (16 * ct + 4 * g) * 4); }
        const float gl = ((const LAS float*)(lds + SC_GB))[63];
        asm volatile("s_waitcnt lgkmcnt(0)" : "+v"(vv[0]), "+v"(vv[1]), "+v"(vv[2]), "+v"(vv[3]) :: "memory");
        f32x4 eg[4], tmp[4];
#pragma unroll
        for (int ct = 0; ct < 4; ++ct)
#pragma unroll
            for (int r = 0; r < 4; ++r) { eg[ct][r] = __expf(gcv[ct][r]); tmp[ct][r] = btv[ct][r] * (bf2f((unsigned short)vv[ct][r]) - eg[ct][r] * KS[ct][r]); }
        bf16x8 tb[2]; tb[0] = pack_cc(tmp[0], tmp[1]); tb[1] = pack_cc(tmp[2], tmp[3]);
        f32x4 vn[4];
#pragma unroll
        for (int ct = 0; ct < 4; ++ct) { vn[ct] = (f32x4){0.f, 0.f, 0.f, 0.f};
#pragma unroll
            for (int k2 = 0; k2 < 2; ++k2) { const LAS unsigned char* ta = lds + SC_T + rdT + ct * 16 * SC_P2 + k2 * 64;
                vn[ct] = mfma16(cat4(*(const LAS s16x4*)ta, *(const LAS s16x4*)(ta + 32)), tb[k2], vn[ct]); } }
        bf16x8 vb[2]; vb[0] = pack_cc(vn[0], vn[1]); vb[1] = pack_cc(vn[2], vn[3]);
        f32x4 o[4];
#pragma unroll
        for (int ct = 0; ct < 4; ++ct) { o[ct] = QS[ct] * eg[ct];
#pragma unroll
            for (int k2 = 0; k2 < 2; ++k2) { const LAS unsigned char* aa = lds + SC_A + rdT + ct * 16 * SC_P2 + k2 * 64;
                o[ct] = mfma16(cat4(*(const LAS s16x4*)aa, *(const LAS s16x4*)(aa + 32)), vb[k2], o[ct]); } }
        f32x4 vd[4];
#pragma unroll
        for (int ct = 0; ct < 4; ++ct)
#pragma unroll
            for (int r = 0; r < 4; ++r) vd[ct][r] = vn[ct][r] * __expf(gl - gcv[ct][r]);
        bf16x8 vdb[2]; vdb[0] = pack_cc(vd[0], vd[1]); vdb[1] = pack_cc(vd[2], vd[3]);
        const float gt = __expf(gl);
#pragma unroll
        for (int dt = 0; dt < 8; ++dt) {
            s16x4 a0, a1, a2, a3;
            TRRD(a0, trK, dt * 32); TRRD(a1, trK, dt * 32 + 16 * SC_P1); TRRD(a2, trK, dt * 32 + 32 * SC_P1); TRRD(a3, trK, dt * 32 + 48 * SC_P1);
            asm volatile("s_waitcnt lgkmcnt(0)" : "+v"(a0), "+v"(a1), "+v"(a2), "+v"(a3) :: "memory");
            Sacc[dt] = Sacc[dt] * gt;
            Sacc[dt] = mfma16(cat4(a0, a1), vdb[0], Sacc[dt]);
            Sacc[dt] = mfma16(cat4(a2, a3), vdb[1], Sacc[dt]);
        }
        __syncthreads();
        if (n + 1 < NCH) SC_WRITE();
#pragma unroll
        for (int ct = 0; ct < 4; ++ct)
#pragma unroll
            for (int r = 0; r < 4; ++r) *(LAS bf16*)(lds + SC_O + (16 * ct + 4 * g + r) * SC_P1 + (16 * w + i16) * 2) = (bf16)f2bf(o[ct][r]);
        __syncthreads();
    }
    SC_OUT(NCH - 1);
    __syncthreads();
#undef SC_LOAD
#undef SC_WRITE
#undef SC_OUT
#undef SC_LOADZ
}
__device__ __forceinline__ void phase_gdn_scan(const Params& p, LAS unsigned char* lds) {
    if (blockIdx.x >= NB * NH) return;
    gdn_scan_bh(p, lds, (int)blockIdx.x);
}

__device__ __forceinline__ void finalize_oa(const Params& p) {
    const int tid = ltid(), lane = tid & 63, wave = tid >> 6;
    const int gw = blockIdx.x * NWAVES + wave, NGW = gridDim.x * NWAVES;
    GAS unsigned char* ws = (GAS unsigned char*)p.ws;
    const GAS float* nwp = (const GAS float*)p.gdn_norm_w + (size_t)p.layer * HD + (lane & 15) * 8;
    const f32x4 n0 = *(const GAS f32x4*)nwp, n1 = *(const GAS f32x4*)(nwp + 4);
    for (int m = gw; m < M; m += NGW) {
#pragma unroll
        for (int hf = 0; hf < 2; ++hf) {
            const size_t off = ((size_t)m * 1024 + hf * 512 + lane * 8) * 2;
            const u32x4 ov = *(const GAS u32x4*)(ws + WS_OA + off), zv = *(const GAS u32x4*)(ws + WS_ZB + off);
            float o[8] = {bflo(ov.x), bfhi(ov.x), bflo(ov.y), bfhi(ov.y), bflo(ov.z), bfhi(ov.z), bflo(ov.w), bfhi(ov.w)};
            const float z[8] = {bflo(zv.x), bfhi(zv.x), bflo(zv.y), bfhi(zv.y), bflo(zv.z), bfhi(zv.z), bflo(zv.w), bfhi(zv.w)};
            float ss = 0.f;
#pragma unroll
            for (int e = 0; e < 8; ++e) ss += o[e] * o[e];
            ss = row16_sum(ss);
            const float rs = __builtin_amdgcn_rsqf(ss * (1.0f / HD) + RMS_EPS);
            const float nv[8] = {n0.x, n0.y, n0.z, n0.w, n1.x, n1.y, n1.z, n1.w};
#pragma unroll
            for (int e = 0; e < 8; ++e) o[e] = o[e] * rs * nv[e] * z[e];
            u32x4 r; r.x = pk2(o[0], o[1]); r.y = pk2(o[2], o[3]); r.z = pk2(o[4], o[5]); r.w = pk2(o[6], o[7]);
            *(GAS u32x4*)(ws + WS_OA + off) = r;
        }
    }
}

constexpr int IX_CAPW = 128;
constexpr int IX_POS = 65536;
constexpr int IX_MT = 98304;
constexpr int IX_META = 131072;
constexpr int IXM_SEGC = 0, IXM_CHI = 128, IXM_LO = 256, IXM_HI = 272, IXM_TAU = 288, IXM_FAIL = 304, IXM_PREF = 320, IXM_KREM = 336;
typedef _Float16 h2_t __attribute__((ext_vector_type(2)));
__device__ __forceinline__ float relu_i(float x) { const int b = __builtin_bit_cast(int, x); return __builtin_bit_cast(float, b > 0 ? b : 0); }
__device__ __forceinline__ unsigned fkey(float s) { const unsigned u = __builtin_bit_cast(unsigned, s); return u ^ ((u >> 31) ? 0xFFFFFFFFu : 0x80000000u); }

constexpr int IX_HIST = IX_META + 4096;
__device__ __forceinline__ unsigned wave_incl_scan(unsigned v) {
    v += (unsigned)__builtin_amdgcn_update_dpp(0, (int)v, 0x111, 0xf, 0xf, false);
    v += (unsigned)__builtin_amdgcn_update_dpp(0, (int)v, 0x112, 0xf, 0xf, false);
    v += (unsigned)__builtin_amdgcn_update_dpp(0, (int)v, 0x114, 0xf, 0xf, false);
    v += (unsigned)__builtin_amdgcn_update_dpp(0, (int)v, 0x118, 0xf, 0xf, false);
    v += (unsigned)__builtin_amdgcn_update_dpp(0, (int)v, 0x142, 0xa, 0xf, false);
    v += (unsigned)__builtin_amdgcn_update_dpp(0, (int)v, 0x143, 0xc, 0xf, false);
    return v;
}
struct IxKeys { unsigned n[8]; unsigned e[8][2]; };
__device__ __forceinline__ void ix_load_keys(IxKeys& K, const LAS unsigned* list, const LAS unsigned* segc, int q, int lane) {
#pragma unroll
    for (int s = 0; s < 8; ++s) { const unsigned c = (unsigned)__builtin_amdgcn_readfirstlane((int)segc[q * 8 + s]); K.n[s] = c < (unsigned)IX_CAPW ? c : (unsigned)IX_CAPW; }
#pragma unroll
    for (int s = 0; s < 8; ++s) { K.e[s][0] = list[(q * 8 + s) * IX_CAPW + lane]; K.e[s][1] = list[(q * 8 + s) * IX_CAPW + 64 + lane]; }
}
__device__ __forceinline__ unsigned ix_round(const IxKeys& K, LAS unsigned* hist, unsigned prefix, int shift, bool first, unsigned& k, int lane) {
    *(LAS u32x4*)(hist + 4 * lane) = zero4_();
    const unsigned dumpw = 256u + (unsigned)lane;
#pragma unroll
    for (int s = 0; s < 8; ++s) {
#pragma unroll
        for (int r = 0; r < 2; ++r) { const unsigned e = K.e[s][r]; const bool ok = ((unsigned)(r * 64 + lane) < K.n[s]) && (first || ((e >> (shift + 8)) == (prefix >> (shift + 8))));
            __hip_atomic_fetch_add(hist + (ok ? ((e >> shift) & 255u) : dumpw), 1u, __ATOMIC_RELAXED, __HIP_MEMORY_SCOPE_WORKGROUP); }
    }
    LDS_WAIT(); __builtin_amdgcn_wave_barrier(); asm volatile("" ::: "memory");
    const u32x4 c4 = *(const LAS u32x4*)(hist + 4 * lane);
    const unsigned tot = c4.x + c4.y + c4.z + c4.w;
    const unsigned pre = wave_incl_scan(tot);
    const unsigned all = (unsigned)__builtin_amdgcn_readlane((int)pre, 63);
    const unsigned suf = all - pre + tot;
    const unsigned long long bal = __ballot(suf >= k);
    const int L = bal ? (63 - __builtin_clzll(bal)) : 0;
    unsigned d = 0u, nk = k;
    { unsigned run = suf - tot;
      if (run + c4.w >= k) { d = 3u; nk = k - run; } else { run += c4.w;
      if (run + c4.z >= k) { d = 2u; nk = k - run; } else { run += c4.z;
      if (run + c4.y >= k) { d = 1u; nk = k - run; } else { run += c4.y; d = 0u; nk = k - run; } } } }
    d = (unsigned)__builtin_amdgcn_readlane((int)d, L); k = (unsigned)__builtin_amdgcn_readlane((int)nk, L);
    __builtin_amdgcn_wave_barrier(); asm volatile("" ::: "memory");
    return (unsigned)(4 * L) + d;
}

template <int MODE>
__device__ __forceinline__ void ix_pass(const GAS _Float16* KIb, GAS unsigned* MASKg, LAS unsigned* lst, LAS unsigned* meta, const f16x8 (&af)[4][4], const unsigned (&wv)[4][2][4],
                                        int t0, int ntiles, int w_in, int lane_in) {
    int lane = lane_in; asm volatile("" : "+v"(lane));
    int w = w_in; asm volatile("" : "+s"(w));
    const int c32 = lane & 31, hh = lane >> 5;
    const unsigned ltm = (1u << c32) - 1u;
    const unsigned dump = (unsigned)((IX_META + 2048) / 4 + w * 64 + lane);
    const unsigned dumpp = (unsigned)((IX_META + 2048 - IX_POS) / 2 + w * 64 + lane);
    unsigned thr_a[4][2], thr_b[4][2];
#pragma unroll
    for (int T4 = 0; T4 < 4; ++T4)
#pragma unroll
        for (int qs = 0; qs < 2; ++qs) { const int ql = 4 * T4 + 2 * hh + qs;
            thr_a[T4][qs] = (MODE == 1) ? meta[IXM_LO + ql] : (MODE == 2) ? meta[IXM_TAU + ql] : (MODE >= 4) ? meta[IXM_PREF + ql] : 0u;
            thr_b[T4][qs] = (MODE == 1) ? meta[IXM_HI + ql] : 0u; }
    unsigned cntA[8], cntB[8], chiA[8], chiB[8];
#pragma unroll
    for (int i = 0; i < 8; ++i) { cntA[i] = 0u; cntB[i] = 0u; chiA[i] = 0u; chiB[i] = 0u; }
    const int kstep = (MODE == 0) ? 64 : 8, kfirst = (MODE == 0) ? (8 * w + 3) : w;
    f16x8 bnx[4];
    if (kfirst < ntiles) {
#pragma unroll
        for (int s = 0; s < 4; ++s) bnx[s] = *(const GAS f16x8*)(KIb + (size_t)(kfirst * 32 + c32) * 64 + 16 * s + 8 * hh);
    }
    for (int kt = kfirst; kt < ntiles; kt += kstep) {
        const int key = kt * 32 + c32;
        f16x8 bfr[4];
#pragma unroll
        for (int s = 0; s < 4; ++s) bfr[s] = bnx[s];
        if (kt + kstep < ntiles) {
#pragma unroll
            for (int s = 0; s < 4; ++s) bnx[s] = *(const GAS f16x8*)(KIb + (size_t)((kt + kstep) * 32 + c32) * 64 + 16 * s + 8 * hh);
        }
        unsigned mwv = 0u;
        f32x16 accn = {};
#pragma unroll
        for (int s = 0; s < 4; ++s) accn = __builtin_amdgcn_mfma_f32_32x32x16_f16(af[0][s], bfr[s], accn, 0, 0, 0);
#pragma unroll
        for (int T4 = 0; T4 < 4; ++T4) {
            const f32x16 acc = accn;
            if (T4 + 1 < 4) { accn = f32x16{};
#pragma unroll
                for (int s = 0; s < 4; ++s) accn = __builtin_amdgcn_mfma_f32_32x32x16_f16(af[T4 + 1][s], bfr[s], accn, 0, 0, 0); }
            float scq[2] = {0.f, 0.f};
#pragma unroll
            for (int h = 0; h < 4; ++h) {
                const float r00 = relu_i(acc[2 * h]), r01 = relu_i(acc[2 * h + 1]), r10 = relu_i(acc[8 + 2 * h]), r11 = relu_i(acc[8 + 2 * h + 1]);
                asm volatile("v_fma_mix_f32 %0, %1, %2, %0 op_sel:[0,0,0] op_sel_hi:[1,0,0]" : "+v"(scq[0]) : "v"(wv[T4][0][h]), "v"(r00));
                asm volatile("v_fma_mix_f32 %0, %1, %2, %0 op_sel:[0,0,0] op_sel_hi:[1,0,0]" : "+v"(scq[1]) : "v"(wv[T4][1][h]), "v"(r10));
                asm volatile("v_fma_mix_f32 %0, %1, %2, %0 op_sel:[1,0,0] op_sel_hi:[1,0,0]" : "+v"(scq[0]) : "v"(wv[T4][0][h]), "v"(r01));
                asm volatile("v_fma_mix_f32 %0, %1, %2, %0 op_sel:[1,0,0] op_sel_hi:[1,0,0]" : "+v"(scq[1]) : "v"(wv[T4][1][h]), "v"(r11)); }
#pragma unroll
            for (int qs = 0; qs < 2; ++qs) {
                const float sc = scq[qs];
                const int ql = 4 * T4 + 2 * hh + qs, idx = 2 * T4 + qs;
                const bool valid = key <= t0 + ql;
                const unsigned uk = fkey(sc);
                if constexpr (MODE == 0 || MODE == 1) {
                    bool pred = valid;
                    if constexpr (MODE == 1) {
                        const bool ge = valid && (uk >= thr_b[T4][qs]);
                        const unsigned long long bg = __ballot(ge);
                        mwv = (lane == 4 * T4 + qs) ? (unsigned)bg : mwv; mwv = (lane == 4 * T4 + 2 + qs) ? (unsigned)(bg >> 32) : mwv;
                        chiA[idx] = (unsigned)__builtin_amdgcn_readfirstlane((int)(chiA[idx] + (unsigned)__builtin_popcount((unsigned)bg))); chiB[idx] = (unsigned)__builtin_amdgcn_readfirstlane((int)(chiB[idx] + (unsigned)__builtin_popcount((unsigned)(bg >> 32))));
                        pred = valid && !ge && (uk >= thr_a[T4][qs]);
                    }
                    const unsigned long long bal = __ballot(pred);
                    const unsigned blo = (unsigned)bal, bhi = (unsigned)(bal >> 32);
                    const unsigned slot = (hh ? cntB[idx] : cntA[idx]) + (unsigned)__builtin_popcount((hh ? bhi : blo) & ltm);
                    const bool okw = pred && slot < (unsigned)IX_CAPW;
                    const unsigned addr = okw ? (unsigned)((ql * 8 + w) * IX_CAPW) + slot : dump;
                    lst[addr] = uk;
                    if constexpr (MODE == 1) ((LAS unsigned short*)((LAS unsigned char*)lst + IX_POS))[okw ? addr : dumpp] = (unsigned short)key;
                    cntA[idx] = (unsigned)__builtin_amdgcn_readfirstlane((int)(cntA[idx] + (unsigned)__builtin_popcount(blo))); cntB[idx] = (unsigned)__builtin_amdgcn_readfirstlane((int)(cntB[idx] + (unsigned)__builtin_popcount(bhi)));
                } else if constexpr (MODE == 2) {
                    const bool sel = valid && (uk >= thr_a[T4][qs]);
                    const unsigned long long bal = __ballot(sel);
                    mwv = (lane == 4 * T4 + qs) ? (unsigned)bal : mwv; mwv = (lane == 4 * T4 + 2 + qs) ? (unsigned)(bal >> 32) : mwv;
                } else if constexpr (MODE == 3) { if (valid) __hip_atomic_fetch_add(&lst[ql * 2048 + (uk >> 21)], 1u, __ATOMIC_RELAXED, __HIP_MEMORY_SCOPE_WORKGROUP); }
                else if constexpr (MODE == 4) { if (valid && (uk >> 21) == thr_a[T4][qs]) __hip_atomic_fetch_add(&lst[ql * 2048 + ((uk >> 10) & 2047u)], 1u, __ATOMIC_RELAXED, __HIP_MEMORY_SCOPE_WORKGROUP); }
                else { if (valid && (uk >> 10) == thr_a[T4][qs]) __hip_atomic_fetch_add(&lst[ql * 2048 + (uk & 1023u)], 1u, __ATOMIC_RELAXED, __HIP_MEMORY_SCOPE_WORKGROUP); }
            }
        }
        if constexpr (MODE == 1 || MODE == 2) { if (lane < 16) ((LAS unsigned*)((LAS unsigned char*)lst + IX_MT))[lane * 256 + kt] = mwv; }
    }
    if constexpr (MODE == 0 || MODE == 1) {
        if (lane == 0) {
#pragma unroll
            for (int T4 = 0; T4 < 4; ++T4)
#pragma unroll
                for (int qs = 0; qs < 2; ++qs) { const int idx = 2 * T4 + qs, qa = 4 * T4 + qs, qb = qa + 2;
                    meta[IXM_SEGC + qa * 8 + w] = cntA[idx]; meta[IXM_SEGC + qb * 8 + w] = cntB[idx];
                    if constexpr (MODE == 1) { meta[IXM_CHI + qa * 8 + w] = chiA[idx]; meta[IXM_CHI + qb * 8 + w] = chiB[idx]; } }
        }
    }
}

__device__ __forceinline__ void phase_indexer(const Params& p, LAS unsigned char* lds) {
    const int tid = ltid(), lane0 = tid & 63, w = __builtin_amdgcn_readfirstlane(tid >> 6);
    GAS unsigned char* ws = (GAS unsigned char*)p.ws;
    const GAS _Float16* QI = (const GAS _Float16*)(ws + WS_QI);
    const GAS _Float16* KI = (const GAS _Float16*)(ws + WS_KI);
    const GAS float* SM = (const GAS float*)(ws + WS_SM);
    GAS unsigned* MASK = (GAS unsigned*)(ws + WS_MASK);
    LAS unsigned* lst = (LAS unsigned*)lds;
    LAS unsigned* meta = (LAS unsigned*)(lds + IX_META);
    LAS unsigned* hist = (LAS unsigned*)(lds + IX_HIST) + w * 320;
    const int G = gridDim.x, bid = blockIdx.x;
    constexpr int NGRP = NB * SEQ / 16;
    for (int it = 0;; ++it) {
        const int pos = it * G + ((it & 1) ? (G - 1 - bid) : bid);
        if (pos >= NGRP) break;
        int lane = lane0; asm volatile("" : "+v"(lane));
        const int c32 = lane & 31, hh = lane >> 5;
        const int tq = pos >> 2, b = pos & 3, t0 = tq * 16;
        const size_t rowbase = (size_t)b * SEQ + t0;
        f16x8 af[4][4]; unsigned wv[4][2][4];
        { const int a = c32 >> 3, bb = (c32 >> 2) & 1, c = c32 & 3, hd = c + 4 * (a & 1), qsub = a >> 1;
#pragma unroll
          for (int T4 = 0; T4 < 4; ++T4) { const int ql = 4 * T4 + 2 * bb + qsub;
#pragma unroll
              for (int s = 0; s < 4; ++s) af[T4][s] = *(const GAS f16x8*)(QI + (rowbase + ql) * 512 + hd * 64 + 16 * s + 8 * hh); }
#pragma unroll
          for (int T4 = 0; T4 < 4; ++T4)
#pragma unroll
              for (int qs = 0; qs < 2; ++qs) { const GAS float* wp = SM + (rowbase + 4 * T4 + 2 * hh + qs) * 32;
                  const f32x4 w0 = *(const GAS f32x4*)wp, w1 = *(const GAS f32x4*)(wp + 4);
                  wv[T4][qs][0] = __builtin_bit_cast(unsigned, (h2_t){(_Float16)w0.x, (_Float16)w0.y}); wv[T4][qs][1] = __builtin_bit_cast(unsigned, (h2_t){(_Float16)w0.z, (_Float16)w0.w});
                  wv[T4][qs][2] = __builtin_bit_cast(unsigned, (h2_t){(_Float16)w1.x, (_Float16)w1.y}); wv[T4][qs][3] = __builtin_bit_cast(unsigned, (h2_t){(_Float16)w1.z, (_Float16)w1.w}); } }
        const int ntiles = (t0 + 15) / 32 + 1;
        const GAS _Float16* KIb = KI + (size_t)b * SEQ * 64;
        GAS unsigned* MASKg = MASK + rowbase * 256;
        const bool small = (t0 + 16 <= 8 * IX_CAPW);
        if (tid < 16) { meta[IXM_LO + tid] = 0u; meta[IXM_HI + tid] = 0xFFFFFFFFu; meta[IXM_TAU + tid] = 0u; }
        if (tid == 0) meta[IXM_FAIL] = 0u;
#pragma unroll
        for (int i = 0; i < 2; ++i) *(LAS u32x4*)(lds + IX_MT + (size_t)(i * NTHR + tid) * 16) = zero4_();
        __syncthreads();
        if (!small) {
            ix_pass<0>(KIb, MASKg, lst, meta, af, wv, t0, ntiles, w, lane);
            __syncthreads();
#pragma unroll 1
            for (int qq = 0; qq < 2; ++qq) { const int q = 2 * w + qq;
                unsigned ns = 0u;
                for (int s = 0; s < 8; ++s) ns += meta[IXM_SEGC + q * 8 + s];
                ns = (unsigned)__builtin_amdgcn_readfirstlane((int)ns);
                unsigned lo = 0u, hi = 0xFFFFFFFFu;
                if (ns >= 72u) { IxKeys K; ix_load_keys(K, lst, meta + IXM_SEGC, q, lane);
                    unsigned k1 = 72u; const unsigned d1 = ix_round(K, hist, 0u, 24, true, k1, lane); const unsigned d2 = ix_round(K, hist, d1 << 24, 16, false, k1, lane); lo = (d1 << 24) | (d2 << 16);
                    unsigned k2 = 12u; const unsigned g1 = ix_round(K, hist, 0u, 24, true, k2, lane); const unsigned g2 = ix_round(K, hist, g1 << 24, 16, false, k2, lane); const unsigned ph = (g1 << 24) | (g2 << 16);
                    hi = (ph >= 0xFFFF0000u) ? 0xFFFFFFFFu : ph + 0x10000u; }
                if (lane == 0) { meta[IXM_LO + q] = lo; meta[IXM_HI + q] = hi; } }
            __syncthreads();
        }
        ix_pass<1>(KIb, MASKg, lst, meta, af, wv, t0, ntiles, w, lane);
        __syncthreads();
#pragma unroll 1
        for (int qq = 0; qq < 2; ++qq) { const int q = 2 * w + qq;
            const bool allsel = (t0 + q + 1 <= 256);
            unsigned n = 0u, chi = 0u, over = 0u;
            for (int s = 0; s < 8; ++s) { const unsigned c = meta[IXM_SEGC + q * 8 + s]; n += c; over |= (c > (unsigned)IX_CAPW) ? 1u : 0u; chi += meta[IXM_CHI + q * 8 + s]; }
            n = (unsigned)__builtin_amdgcn_readfirstlane((int)n); chi = (unsigned)__builtin_amdgcn_readfirstlane((int)chi); over = (unsigned)__builtin_amdgcn_readfirstlane((int)over);
            if (!allsel && (over || chi >= 256u || chi + n < 256u)) { if (lane == 0) meta[IXM_FAIL] = 1u; continue; }
            const unsigned lo_ = (unsigned)__builtin_amdgcn_readfirstlane((int)meta[IXM_LO + q]), hi_ = (unsigned)__builtin_amdgcn_readfirstlane((int)meta[IXM_HI + q]);
            const unsigned df = lo_ ^ (hi_ - 1u);
            const int sh0 = (df >> 24) ? 24 : ((df >> 16) ? 16 : ((df >> 8) ? 8 : 0));
            unsigned tau = (sh0 == 24) ? 0u : (lo_ & (0xFFFFFFFFu << (sh0 + 8)));
            unsigned kk = 256u - chi;
            { IxKeys K; ix_load_keys(K, lst, meta + IXM_SEGC, q, lane);
              if (allsel) tau = 0u; else { for (int sh = sh0; sh >= 0; sh -= 8) tau |= ix_round(K, hist, tau, sh, sh == 24, kk, lane) << sh; }
              LAS unsigned* mt = (LAS unsigned*)(lds + IX_MT) + q * 256; const LAS unsigned short* pl = (const LAS unsigned short*)(lds + IX_POS);
#pragma unroll
              for (int s = 0; s < 8; ++s)
#pragma unroll
                  for (int r = 0; r < 2; ++r) { const bool on = ((unsigned)(r * 64 + lane) < K.n[s]) && (K.e[s][r] >= tau);
                      const unsigned ps = pl[(q * 8 + s) * IX_CAPW + r * 64 + lane];
                      if (on) __hip_atomic_fetch_or(mt + (ps >> 5), 1u << (ps & 31u), __ATOMIC_RELAXED, __HIP_MEMORY_SCOPE_WORKGROUP); } }
            if (lane == 0) meta[IXM_TAU + q] = tau; }
        __syncthreads();
        if (meta[IXM_FAIL] != 0u) {
            __syncthreads();
            if (tid < 16) { meta[IXM_PREF + tid] = 0u; meta[IXM_KREM + tid] = 256u; }
#pragma unroll 1
            for (int pass = 0; pass < 3; ++pass) {
#pragma unroll
                for (int i = 0; i < 16; ++i) *(LAS u32x4*)(lds + (size_t)(i * NTHR + tid) * 16) = zero4_();
                __syncthreads();
                if (pass == 0) ix_pass<3>(KIb, MASKg, lst, meta, af, wv, t0, ntiles, w, lane);
                else if (pass == 1) ix_pass<4>(KIb, MASKg, lst, meta, af, wv, t0, ntiles, w, lane);
                else ix_pass<5>(KIb, MASKg, lst, meta, af, wv, t0, ntiles, w, lane);
                __syncthreads();
#pragma unroll 1
                for (int qq = 0; qq < 2; ++qq) {
                    const int q = 2 * w + qq;
                    if (t0 + q + 1 <= 256) { if (lane == 0 && pass == 2) meta[IXM_TAU + q] = 0u; continue; }
                    const int per = (pass == 2) ? 16 : 32, base = lane * per;
                    unsigned cnt = 0;
                    for (int i = 0; i < per; ++i) cnt += lst[q * 2048 + base + i];
                    unsigned suf = cnt;
#pragma unroll
                    for (int o = 1; o < 64; o <<= 1) { const unsigned t = __shfl_down(suf, o); if (lane + o < 64) suf += t; }
                    const unsigned kr = meta[IXM_KREM + q];
                    const unsigned long long bal = __ballot(suf >= kr);
                    const int L = bal ? (63 - __builtin_clzll(bal)) : 0;
                    unsigned binv = 0, nkr = kr;
                    if (lane == L) { unsigned run = suf - cnt;
                        for (int i = per - 1; i >= 0; --i) { const unsigned c = lst[q * 2048 + base + i]; if (run + c >= kr) { binv = (unsigned)(base + i); nkr = kr - run; break; } run += c; } }
                    binv = __shfl(binv, L); nkr = __shfl(nkr, L);
                    if (lane == 0) { const unsigned pr = meta[IXM_PREF + q];
                        const unsigned npr = (pass == 0) ? binv : ((pass == 1) ? ((pr << 11) | binv) : ((pr << 10) | binv));
                        meta[IXM_PREF + q] = npr; meta[IXM_KREM + q] = nkr; if (pass == 2) meta[IXM_TAU + q] = npr; }
                }
                __syncthreads();
            }
#pragma unroll
            for (int i = 0; i < 2; ++i) *(LAS u32x4*)(lds + IX_MT + (size_t)(i * NTHR + tid) * 16) = zero4_();
            __syncthreads();
            ix_pass<2>(KIb, MASKg, lst, meta, af, wv, t0, ntiles, w, lane);
            __syncthreads();
        }
        { const int last = ((t0 >> 8) << 3) + 7; const int row = tid >> 5, c4 = (tid & 31) * 4;
#pragma unroll
          for (int i = 0; i < 2; ++i) { const int cw = c4 + 128 * i; if (cw <= last) *(GAS u32x4*)(MASKg + (size_t)row * 256 + cw) = *(const LAS u32x4*)(lds + IX_MT + (row * 256 + cw) * 4); } }
        __syncthreads();
    }
}

namespace at {
constexpr float SCALE = 0.08838834764831845f;
constexpr int D = 128, PITCH = 1024;
constexpr int NW = 8, QBLK = 32, KVBLK = 64, QB = NW * QBLK;
constexpr int SHM_V = KVBLK * D * 2, SHM_K = KVBLK * D * 2;
constexpr int OFF_WS = 2 * SHM_V + 2 * SHM_K;
constexpr int OFF_BLUT = OFF_WS + NW * 64 * 4;
constexpr int LDS_NEED = OFF_BLUT + 8 * 132 * 4;
constexpr float THR = 8.f;

#define KSWZ(row, colB) ((row) * 256 + ((colB) ^ (((row) & 7) << 4)))
#define SBAR() __builtin_amdgcn_sched_barrier(0)
__device__ __forceinline__ int v_st(int k, int c) { const int kk = (k & ~0xC) | ((k & 4) << 1) | ((k & 8) >> 1); return ((kk >> 3) * 4 + (c >> 5)) * 512 + ((kk & 7) * 32 + (c & 31)) * 2; }
__device__ __forceinline__ int v_rd_base(int lane) { return ((lane & 3) << 3) | (((lane >> 2) & 3) << 6) | (((lane >> 4) & 1) << 5) | (((lane >> 5) & 1) << 8); }
constexpr int v_rd_off(int d0, int ks, int half) { return d0 * 512 + ks * 4096 + half * 2048; }
__device__ __forceinline__ int crow(int r, int hi) { return (r & 3) + 8 * (r >> 2) + 4 * hi; }
__device__ __forceinline__ bf16x8 load8(const GAS bf16* p) { return *(const GAS bf16x8*)p; }

__device__ __forceinline__ void mask_tile(f32x16& p0, f32x16& p1, int dq) {
    const float NEG = -__builtin_inff();
#pragma unroll
    for (int r = 0; r < 16; ++r) {
        const int c = (r & 3) + 8 * (r >> 2);
        if (dq - c < 0) p0[r] = NEG;
        if (dq - c - 32 < 0) p1[r] = NEG;
    }
}
__device__ __forceinline__ void bias_tile(f32x16& p0, f32x16& p1, int dq, const float* bl) {
#pragma unroll
    for (int r = 0; r < 16; ++r) {
        const int c = (r & 3) + 8 * (r >> 2);
        int d0 = dq - c, d1 = dq - c - 32;
        d0 = d0 < 0 ? 0 : (d0 > 128 ? 128 : d0); d1 = d1 < 0 ? 0 : (d1 > 128 ? 128 : d1);
        p0[r] += bl[d0]; p1[r] += bl[d1];
    }
}
__device__ __forceinline__ void partialSM(f32x16& p0, f32x16& p1, float& m_reg, float& mn, float& alpha, float cb, unsigned mlo) {
    float pmax = p0[0];
#pragma unroll
    for (int r = 1; r < 16; ++r) pmax = fmaxf(pmax, p0[r]);
#pragma unroll
    for (int r = 0; r < 16; ++r) pmax = fmaxf(pmax, p1[r]);
    { auto rr = __builtin_amdgcn_permlane32_swap(__float_as_uint(pmax), __float_as_uint(pmax), false, false);
      pmax = fmaxf(__uint_as_float(rr[0]), __uint_as_float(rr[1])); }
    pmax += cb;
    constexpr float C2 = 1.4426950408889634f * SCALE;
    if (__builtin_expect(__all((pmax - m_reg) * SCALE <= THR), 1)) { mn = m_reg; alpha = 1.f; }
    else { mn = fmaxf(m_reg, pmax); alpha = __builtin_amdgcn_exp2f((m_reg - mn) * C2); m_reg = mn; }
    const float mnL = (cb - mn) * C2;
#pragma unroll
    for (int r = 0; r < 16; ++r) p0[r] = fmaf(p0[r], C2, mnL);
#pragma unroll
    for (int r = 0; r < 16; ++r) p1[r] = fmaf(p1[r], C2, mnL);
#pragma unroll
    for (int r = 0; r < 16; ++r) { const int c = (r & 3) + 8 * (r >> 2);
        int sm_ = __builtin_amdgcn_sbfe((int)mlo, (unsigned)c, 1u); asm volatile("" : "+v"(sm_));
        p0[r] = __uint_as_float(__float_as_uint(__builtin_amdgcn_exp2f(p0[r])) & (unsigned)sm_); }
}
__device__ __forceinline__ void finishSM(f32x16& p0, f32x16& p1, float alpha, float& l_reg, bf16x8& pa0, bf16x8& pa1, bf16x8& pa2, bf16x8& pa3, unsigned mhi) {
#pragma unroll
    for (int r = 0; r < 16; ++r) { const int c = (r & 3) + 8 * (r >> 2);
        int sm_ = __builtin_amdgcn_sbfe((int)mhi, (unsigned)c, 1u); asm volatile("" : "+v"(sm_));
        p1[r] = __uint_as_float(__float_as_uint(__builtin_amdgcn_exp2f(p1[r])) & (unsigned)sm_); }
    float ps = 0;
#pragma unroll
    for (int r = 0; r < 16; ++r) ps += p0[r];
#pragma unroll
    for (int r = 0; r < 16; ++r) ps += p1[r];
    { auto rr = __builtin_amdgcn_permlane32_swap(__float_as_uint(ps), __float_as_uint(ps), false, false);
      ps = __uint_as_float(rr[0]) + __uint_as_float(rr[1]); }
    l_reg = l_reg * alpha + ps;
#define PK4(P, B_, OUT) do { unsigned a0 = pk2(P[B_+0], P[B_+1]), a1 = pk2(P[B_+2], P[B_+3]);                          \
        unsigned b0 = pk2(P[B_+4], P[B_+5]), b1 = pk2(P[B_+6], P[B_+7]);                                             \
        auto r0 = __builtin_amdgcn_permlane32_swap(a0, b0, false, false); auto r1 = __builtin_amdgcn_permlane32_swap(a1, b1, false, false); \
        u32x4 w = {r0[0], r1[0], r0[1], r1[1]}; OUT = *reinterpret_cast<bf16x8*>(&w); } while (0)
    PK4(p0, 0, pa0); PK4(p0, 8, pa1); PK4(p1, 0, pa2); PK4(p1, 8, pa3);
#undef PK4
}
template <int KB>
__device__ __forceinline__ void qkt(f32x16& p0, f32x16& p1, int ka0, const bf16x8* qr) {
#define KRD2(dx, dy, d0) do { int t_; asm volatile("v_xor_b32 %2, %4, %3\n\tds_read_b128 %0, %2 offset:%5\n\tds_read_b128 %1, %2 offset:%6"                       \
        : "=&v"(dx), "=&v"(dy), "=&v"(t_) : "v"(ka0), "i"(((d0) & 3) << 5), "i"(KB * SHM_K + ((d0) >> 2) * 128), "i"(KB * SHM_K + ((d0) >> 2) * 128 + 32 * 256) : "memory"); } while (0)
#define KWAIT(n, x, y) asm volatile("s_waitcnt lgkmcnt(" #n ")" : "+v"(x), "+v"(y) :: "memory")
    bf16x8 a0, a1, b0, b1;
    KRD2(a0, a1, 0); KRD2(b0, b1, 1);
    KWAIT(2, a0, a1);
    p0 = __builtin_amdgcn_mfma_f32_32x32x16_bf16(a0, qr[0], f32x16{}, 0, 0, 0); p1 = __builtin_amdgcn_mfma_f32_32x32x16_bf16(a1, qr[0], f32x16{}, 0, 0, 0);
    KRD2(a0, a1, 2);
    KWAIT(2, b0, b1);
    p0 = __builtin_amdgcn_mfma_f32_32x32x16_bf16(b0, qr[1], p0, 0, 0, 0); p1 = __builtin_amdgcn_mfma_f32_32x32x16_bf16(b1, qr[1], p1, 0, 0, 0);
    KRD2(b0, b1, 3);
#define QK_PAIR(d0, LASTW)                                                                                                        \
    KWAIT(2, a0, a1);                                                                                                            \
    p0 = __builtin_amdgcn_mfma_f32_32x32x16_bf16(a0, qr[d0], p0, 0, 0, 0); p1 = __builtin_amdgcn_mfma_f32_32x32x16_bf16(a1, qr[d0], p1, 0, 0, 0);             \
    if ((d0) + 2 < 8) { KRD2(a0, a1, (d0) + 2); KWAIT(2, b0, b1); } else { KWAIT(0, b0, b1); }                \
    p0 = __builtin_amdgcn_mfma_f32_32x32x16_bf16(b0, qr[(d0) + 1], p0, 0, 0, 0); p1 = __builtin_amdgcn_mfma_f32_32x32x16_bf16(b1, qr[(d0) + 1], p1, 0, 0, 0);   \
    if ((d0) + 3 < 8) { KRD2(b0, b1, (d0) + 3); }
    QK_PAIR(2, 0) QK_PAIR(4, 0) QK_PAIR(6, 1)
#undef QK_PAIR
#undef KRD2
#undef KWAIT
}
template <int VB>
__device__ __forceinline__ void pv_tile(f32x16* o, int vb0, bf16x8 pa0, bf16x8 pa1, bf16x8 pa2, bf16x8 pa3) {
#define TRRDA(dst, off) asm volatile("ds_read_b64_tr_b16 %0, %1 offset:%2" : "=&v"(dst) : "v"(vb0), "i"(off) : "memory")
#define PV_D0(d0) do { s16x4 l0, l1, l2, l3, h0, h1, h2, h3; constexpr int b_ = VB * SHM_V + v_rd_off(d0, 0, 0); \
        TRRDA(l0, b_); TRRDA(h0, b_ + 2048); TRRDA(l1, b_ + 4096); TRRDA(h1, b_ + 6144); TRRDA(l2, b_ + 8192); TRRDA(h2, b_ + 10240); TRRDA(l3, b_ + 12288); TRRDA(h3, b_ + 14336); \
        asm volatile("s_waitcnt lgkmcnt(0)" : "+v"(l0), "+v"(h0), "+v"(l1), "+v"(h1), "+v"(l2), "+v"(h2), "+v"(l3), "+v"(h3) :: "memory"); SBAR();   \
        o[d0] = __builtin_amdgcn_mfma_f32_32x32x16_bf16(pa0, (bf16x8){l0[0], l0[1], l0[2], l0[3], h0[0], h0[1], h0[2], h0[3]}, o[d0], 0, 0, 0);   \
        o[d0] = __builtin_amdgcn_mfma_f32_32x32x16_bf16(pa1, (bf16x8){l1[0], l1[1], l1[2], l1[3], h1[0], h1[1], h1[2], h1[3]}, o[d0], 0, 0, 0);   \
        o[d0] = __builtin_amdgcn_mfma_f32_32x32x16_bf16(pa2, (bf16x8){l2[0], l2[1], l2[2], l2[3], h2[0], h2[1], h2[2], h2[3]}, o[d0], 0, 0, 0);   \
        o[d0] = __builtin_amdgcn_mfma_f32_32x32x16_bf16(pa3, (bf16x8){l3[0], l3[1], l3[2], l3[3], h3[0], h3[1], h3[2], h3[3]}, o[d0], 0, 0, 0); } while (0)
    PV_D0(0); PV_D0(1); PV_D0(2); PV_D0(3);
#undef PV_D0
#undef TRRDA
}

__device__ __forceinline__ int lane_fresh() { int l; asm volatile("v_mbcnt_lo_u32_b32 %0, -1, 0\n\tv_mbcnt_hi_u32_b32 %0, -1, %0" : "=v"(l)); return l; }
struct BlockRef { const GAS bf16* Q; const GAS bf16* K; const GAS bf16* V; GAS bf16* O; const GAS unsigned long long* MW; int P0; int h; };
struct Seam { bf16x8 qr[8]; };
#define VMW() asm volatile("s_waitcnt vmcnt(0)" ::: "memory")
#define DMA16(gp, ldsoff) __builtin_amdgcn_global_load_lds((const GAS unsigned*)(gp), (LAS unsigned*)(ldsw_ + (ldsoff)), 16, 0, 0)
#define KDMA(Kbytes, bf) do { DMA16((Kbytes) + koff0, 2 * SHM_V + (bf) * SHM_K); DMA16((Kbytes) + koff1, 2 * SHM_V + (bf) * SHM_K + 1024); } while (0)
#define VDMA(Vbytes, bf) do { DMA16((Vbytes) + voff0, (bf) * SHM_V); DMA16((Vbytes) + voff1, (bf) * SHM_V + 1024); } while (0)
#define DMA_OFFS()                                                                                                             \
    LAS unsigned char* ldsw_ = (LAS unsigned char*)lds + wid * 2048;                                \
    unsigned koff0, koff1, voff0, voff1;                                                                                       \
    { const int r0 = wid * 8 + (lane >> 4), r1 = r0 + 4, pc = lane & 15;                                                       \
      koff0 = (unsigned)(r0 * PITCH * 2 + ((pc ^ (r0 & 7)) << 4)); koff1 = (unsigned)(r1 * PITCH * 2 + ((pc ^ (r1 & 7)) << 4)); \
      const int kl = (lane & 31) >> 2, c8 = lane & 3;                                                                          \
      const int sub0 = wid * 4 + (lane >> 5), sub1 = sub0 + 2;                                                                 \
      const int kk0 = (sub0 >> 2) * 8 + kl, kk1 = (sub1 >> 2) * 8 + kl;                                                        \
      const int k0_ = (kk0 & ~0xC) | ((kk0 & 4) << 1) | ((kk0 & 8) >> 1), k1_ = (kk1 & ~0xC) | ((kk1 & 4) << 1) | ((kk1 & 8) >> 1); \
      voff0 = (unsigned)(k0_ * PITCH * 2 + ((sub0 & 3) * 32 + c8 * 8) * 2); voff1 = (unsigned)(k1_ * PITCH * 2 + ((sub1 & 3) * 32 + c8 * 8) * 2); }
constexpr unsigned TILE_BYTES = KVBLK * PITCH * 2;
__device__ __forceinline__ void attn_prime(const BlockRef& cur, char* lds, Seam& S) {
    const int tid = ltid(), wid = __builtin_amdgcn_readfirstlane(tid >> 6), lane = tid & 63, r32 = lane & 31, hi = lane >> 5;
    DMA_OFFS();
#pragma unroll
    for (int d0 = 0; d0 < 8; ++d0) S.qr[d0] = load8(cur.Q + (unsigned)((wid * QBLK + r32) * PITCH + d0 * 16 + hi * 8));
    KDMA((const GAS unsigned char*)cur.K, 0); (void)voff0; (void)voff1; VMW();
    __syncthreads();
}
__device__ __forceinline__ void attn_block(const BlockRef& cur, const BlockRef& nxt, char* lds, Seam& S) {
    const int tid = ltid(), wid = __builtin_amdgcn_readfirstlane(tid >> 6), lane = tid & 63, r32 = lane & 31, hi = lane >> 5;
    const int NT = (cur.P0 + QB - 1) / KVBLK + 1;
    const int qlo = cur.P0 + wid * QBLK, qm = qlo + r32 - 4 * hi;
    char* V_lds = lds; char* K_lds = lds + 2 * SHM_V;
    const float* bl = (const float*)(lds + OFF_BLUT) + cur.h * 132;
    const float cb_far = __builtin_bit_cast(float, __builtin_amdgcn_readfirstlane(__builtin_bit_cast(int, bl[128])));
    float m_reg = -1e30f, l_reg = 0; f32x16 o[4] = {};
    DMA_OFFS();
    const int vb0 = (int)(uintptr_t)V_lds + v_rd_base(lane);
    const int ka = (int)(uintptr_t)K_lds + KSWZ(r32, hi * 16);
    const GAS unsigned char* Kh = (const GAS unsigned char*)cur.K; const GAS unsigned char* Vh = (const GAS unsigned char*)cur.V;
    const GAS unsigned char* mbase = (const GAS unsigned char*)cur.MW; const unsigned moff = (unsigned)(qlo + r32) * 1024u;
#define RESC(a) do { if (__any((a) < 1.f)) { const int l_ = lane_fresh(), r_ = l_ & 31, h_ = l_ >> 5; float* al_ = (float*)(lds + OFF_WS) + wid * 64 + 32;   \
                     if (h_ == 0) al_[r_] = (a); asm volatile("s_waitcnt lgkmcnt(0)" ::: "memory");                                     \
                     for (int d_ = 0; d_ < 4; ++d_) for (int r = 0; r < 16; ++r) o[d_][r] *= al_[crow(r, h_)]; } } while (0)
#define KBASE(t) ((t) * KVBLK)
#define PREP(P0_, P1_, t, cbv) do { const int kb_ = KBASE(t);                                                                   \
        if (kb_ > qlo - 191) { bias_tile(P0_, P1_, qm - kb_, bl); cbv = 0.f; } else cbv = cb_far; } while (0)
#define MLOAD(mv, t) do { mv = *(const GAS unsigned long long*)(mbase + moff + (unsigned)(t) * 8u); } while (0)
#define MLO(mv) ((unsigned)(mv) >> (4 * hi))
#define MHI(mv) ((unsigned)((mv) >> 32) >> (4 * hi))
    f32x16 pA0, pA1, pB0, pB1; float mnA, mnB, alA, alB; bf16x8 pa0, pa1, pa2, pa3; unsigned long long mA, mB; float cbA, cbB;
    SBAR(); KDMA(Kh + TILE_BYTES, 1); VDMA(Vh, 0); MLOAD(mA, 0);
    SBAR(); qkt<0>(pA0, pA1, ka, S.qr);
    PREP(pA0, pA1, 0, cbA); partialSM(pA0, pA1, m_reg, mnA, alA, cbA, MLO(mA));
    VMW(); __syncthreads();
#define STEP(PX0, PX1, mnX, alX, mX, cbX, PY0, PY1, alY, mY, t, KB, VB, KSRC) do {                                              \
        SBAR(); KDMA(KSRC, (KB) ^ 1); VDMA(Vh + (unsigned)(t) * TILE_BYTES, (VB) ^ 1); MLOAD(mX, t); SBAR();                    \
        qkt<KB>(PX0, PX1, ka, S.qr); SBAR();                                                                                  \
        finishSM(PY0, PY1, alY, l_reg, pa0, pa1, pa2, pa3, MHI(mY)); SBAR();                                                   \
        pv_tile<VB>(o, vb0, pa0, pa1, pa2, pa3); SBAR();                                                                      \
        PREP(PX0, PX1, (t), cbX); partialSM(PX0, PX1, m_reg, mnX, alX, cbX, MLO(mX)); SBAR();                                  \
        RESC(alX); VMW(); __syncthreads(); } while (0)
    for (int t = 1; t + 1 < NT; t += 2) {
        STEP(pB0, pB1, mnB, alB, mB, cbB, pA0, pA1, alA, mA, t, 1, 0, Kh + (unsigned)(t + 1) * TILE_BYTES);
        STEP(pA0, pA1, mnA, alA, mA, cbA, pB0, pB1, alB, mB, t + 1, 0, 1, Kh + (unsigned)(t + 2) * TILE_BYTES);
    }
    STEP(pB0, pB1, mnB, alB, mB, cbB, pA0, pA1, alA, mA, NT - 1, 1, 0, (const GAS unsigned char*)nxt.K);
    finishSM(pB0, pB1, alB, l_reg, pa0, pa1, pa2, pa3, MHI(mB)); SBAR();
    { const int l_ = lane_fresh(), r_ = l_ & 31, h_ = l_ >> 5;
#pragma unroll
      for (int d0 = 0; d0 < 8; ++d0) S.qr[d0] = load8(nxt.Q + (unsigned)((wid * QBLK + r_) * PITCH + d0 * 16 + h_ * 8)); }
    SBAR(); pv_tile<1>(o, vb0, pa0, pa1, pa2, pa3);
    SBAR();
    { const int l_ = lane_fresh(), r_ = l_ & 31, h_ = l_ >> 5; float* li_ = (float*)(lds + OFF_WS) + wid * 64;
      if (h_ == 0) li_[r_] = l_reg; asm volatile("s_waitcnt lgkmcnt(0)" ::: "memory");
      float rli[16];
#pragma unroll
      for (int r = 0; r < 16; ++r) rli[r] = __builtin_amdgcn_rcpf(li_[crow(r, h_)]);
      GAS bf16* Ow = cur.O + (unsigned)((wid * QBLK) * PITCH);
#pragma unroll
      for (int r = 0; r < 16; ++r) { const int orow = crow(r, h_);
#pragma unroll
        for (int d0 = 0; d0 < 4; ++d0) { const float v = o[d0][r] * rli[r];
            const float vn = __shfl_xor(v, 1);
            if ((r_ & 1) == 0) *(GAS unsigned*)(Ow + (unsigned)(orow * PITCH + d0 * 32 + r_)) = pk2(v, vn); } } }
#undef RESC
#undef KBASE
#undef PREP
#undef MLOAD
#undef MLO
#undef MHI
#undef STEP
}
#undef VMW
#undef DMA16
#undef KDMA
#undef VDMA
#undef DMA_OFFS
}

constexpr int ATT_NQB = SEQ / at::QB, ATT_ITEMS = ATT_NQB * NB * NH;
constexpr size_t WS_QCTR = WS_CTL + 512 * 1024;
__device__ __forceinline__ at::BlockRef attn_mkref(unsigned char* ws, int Li) {
    const int qb = ATT_NQB - 1 - ((Li & 127) >> 2), bh = (Li >> 7) * 4 + (Li & 3), b = bh >> 3, h = bh & 7;
    at::BlockRef r; const size_t rb = (size_t)b * SEQ;
    GAS unsigned char* wg = (GAS unsigned char*)ws;
    r.Q = (const GAS bf16*)(wg + WS_QB) + (rb + (size_t)qb * at::QB) * at::PITCH + h * 128; r.O = (GAS bf16*)(wg + WS_OB) + (rb + (size_t)qb * at::QB) * at::PITCH + h * 128;
    r.K = (const GAS bf16*)(wg + WS_KB) + rb * at::PITCH + h * 128; r.V = (const GAS bf16*)(wg + WS_VB) + rb * at::PITCH + h * 128;
    r.MW = (const GAS unsigned long long*)(wg + WS_MASK) + rb * 128; r.P0 = qb * at::QB; r.h = h; return r;
}
__device__ __forceinline__ int attn_fetch(gu32* ctr, volatile LAS unsigned* slot, int tid) {
    if (tid == 0) {
        unsigned v = 0x7fffffffu, q = slot[1], tries = slot[2];
        while (tries < 8u) {
            const unsigned t = __hip_atomic_fetch_add(ctr + q * 32u, 1u, __ATOMIC_RELAXED, __HIP_MEMORY_SCOPE_AGENT);
            if (t < 128u) { v = q * 128u + t; break; }
            q = (q + 1u) & 7u; ++tries;
        }
        slot[0] = v; slot[1] = q; slot[2] = tries;
    }
    __syncthreads();
    const int v = (int)slot[0];
    return __builtin_amdgcn_readfirstlane(v);
}
__device__ __forceinline__ void phase_attn(const Params& p, LAS unsigned char* ldsl) {
    char* lds = (char*)ldsl;
    unsigned char* ws = p.ws;
    const int tid = ltid();
    { const GAS float* bg = (const GAS float*)((GAS unsigned char*)ws + WS_BLUT); float* bl = (float*)(lds + at::OFF_BLUT); for (int i = tid; i < 8 * 132; i += NTHR) bl[i] = bg[i]; }
    gu32* ctr = (gu32*)(ws + WS_QCTR) + p.layer * 256;

    volatile LAS unsigned* slot = (volatile LAS unsigned*)(ldsl + at::LDS_NEED);
    if (tid == 0) { slot[1] = (unsigned)__builtin_amdgcn_s_getreg((3 << 11) | 20) & 7u; slot[2] = 0; }
    int L = attn_fetch(ctr, slot, tid);
    if (L >= ATT_ITEMS) return;
    at::BlockRef cur = attn_mkref(ws, L);
    at::Seam S;
    at::attn_prime(cur, lds, S);
    for (;;) {
        const int Ln = attn_fetch(ctr, slot, tid);
        const bool last = Ln >= ATT_ITEMS;
        const at::BlockRef nxt = last ? cur : attn_mkref(ws, Ln);
        at::attn_block(cur, nxt, lds, S);
        if (last) break;
        cur = nxt;
    }
}
__device__ __forceinline__ void phase_mix(const Params& p, LAS unsigned char* lds) {
    if (blockIdx.x < NB * NH) gdn_scan_bh(p, lds, (int)blockIdx.x);
    if (p.layer + 1 < DEPTH) {
        if (gridDim.x >= 2 * NB * NH) { if (blockIdx.x >= NB * NH && blockIdx.x < 2 * NB * NH) { convert_weights(p, lds, p.layer + 1, ((int)blockIdx.x - NB * NH) * NWAVES + (ltid() >> 6), NB * NH * NWAVES); __syncthreads(); } }
        else { convert_weights(p, lds, p.layer + 1, (int)blockIdx.x * NWAVES + (ltid() >> 6), (int)gridDim.x * NWAVES); __syncthreads(); }
    }
    phase_attn(p, lds);
}

#define XB_TMO      128
#define XB_XCNT(j)  (256  + 64 * (j))
#define XB_XSUB(j)  (1280 + 64 * (j))
#define XB_XGEN(j)  (2304 + 64 * (j))
#define XB_TOP      3328
#define XB_TOPGEN   3392
#define XCD_BAR_WORDS 3456
#define XB_SPIN_CAP (1u << 18)

__device__ __forceinline__ unsigned xb_ld(unsigned* p)              { return __hip_atomic_load(p, __ATOMIC_RELAXED, __HIP_MEMORY_SCOPE_AGENT); }
__device__ __forceinline__ unsigned xb_add(unsigned* p, unsigned v) { return __hip_atomic_fetch_add(p, v, __ATOMIC_RELAXED, __HIP_MEMORY_SCOPE_AGENT); }
__device__ __forceinline__ unsigned xb_xcc_id() { return (unsigned)__builtin_amdgcn_s_getreg((3 << 11) | 20) & 0xFu; }
#define XB_SPIN(cond, bar) do { unsigned _sp = 0; while (cond) { __builtin_amdgcn_s_sleep(1); \
    if ((++_sp & 255u) == 0u) { if (xb_ld(&(bar)[XB_TMO])) break; if (_sp > XB_SPIN_CAP) { atomicAdd(&(bar)[XB_TMO], 1u); break; } } } } while (0)

struct XcdBarrier {
    unsigned* bar; unsigned x;
    volatile LAS unsigned* st;
};

__device__ __forceinline__ XcdBarrier xcd_barrier_post(unsigned* bar, volatile LAS unsigned* st) {
    XcdBarrier b; b.bar = bar; b.x = xb_xcc_id(); b.st = st;
    if (threadIdx.x == 0) (void)xb_add(&bar[XB_XCNT(b.x)], 1u);
    return b;
}
__device__ __forceinline__ void xcd_barrier_complete(unsigned* bar, unsigned x, unsigned& nloc, unsigned& nx) {
    const unsigned G = gridDim.x * gridDim.y * gridDim.z;
    unsigned sum, cnt, mine, sp = 0u;
    for (;;) {
        sum = 0u; cnt = 0u; mine = 0u;
#pragma unroll
        for (unsigned j = 0; j < 16; ++j) { const unsigned c = xb_ld(&bar[XB_XCNT(j)]); sum += c; cnt += (c > 0u) ? 1u : 0u; mine = (j == x) ? c : mine; }
        if (sum == G) break;
        __builtin_amdgcn_s_sleep(1);
        if ((++sp & 255u) == 0u) { if (xb_ld(&bar[XB_TMO])) break; if (sp > XB_SPIN_CAP) { atomicAdd(&bar[XB_TMO], 1u); break; } }
    }
    nloc = mine > 0u ? mine : 1u; nx = cnt > 0u ? cnt : 1u;
}

__device__ __forceinline__ void xcd_barrier(const XcdBarrier& b) {
    asm volatile("s_waitcnt vmcnt(0)" ::: "memory");
    __syncthreads();
    if (threadIdx.x == 0) {
        unsigned* bar = b.bar;
        __builtin_amdgcn_s_waitcnt(0);
        unsigned nloc = b.st[0], nx = b.st[1];
        if (nloc == 0u) { xcd_barrier_complete(bar, b.x, nloc, nx); b.st[0] = nloc; b.st[1] = nx; }
        const unsigned old = xb_add(&bar[XB_XSUB(b.x)], 1u);
        const unsigned gen = old / nloc;
        if (old + 1u == (gen + 1u) * nloc) {
            __builtin_amdgcn_fence(__ATOMIC_RELEASE, "agent");
            asm volatile("s_waitcnt vmcnt(0)" ::: "memory");
            const unsigned og = xb_add(&bar[XB_TOP], 1u);
            const unsigned tg = og / nx;
            if (og + 1u == (tg + 1u) * nx) xb_add(&bar[XB_TOPGEN], 1u);
            else XB_SPIN(xb_ld(&bar[XB_TOPGEN]) == tg, bar);
            __builtin_amdgcn_fence(__ATOMIC_ACQUIRE, "agent");
            xb_add(&bar[XB_XGEN(b.x)], 1u);
            asm volatile("s_waitcnt vmcnt(0)" ::: "memory");
        } else {
            XB_SPIN(xb_ld(&bar[XB_XGEN(b.x)]) == gen, bar);
            __builtin_amdgcn_fence(__ATOMIC_ACQUIRE, "agent");
            asm volatile("s_waitcnt vmcnt(0)" ::: "memory");
        }
    }
    __syncthreads();
}

enum { PH_CONVERT = 0, PH_INPROJ, PH_GDN_LOCAL, PH_INDEXER, PH_GDN_SCAN, PH_ATTN, PH_GATES, PH_BRANCH_A, PH_BRANCH_B, PH_WOUT, PH_LN1, PH_FFN_IN, PH_FFN_OUT, PH_LN2, PH_COUNT };

template <class Epi>
__device__ __forceinline__ void run_gemm(LAS unsigned char* lds, const void* A, const void* Bt, int N, int K, const Epi& E) {
    pg8::Gemm g{(const pg8::bf16_t*)A, (const pg8::bf16_t*)Bt, M, N, K};
    pg8::StaticOrder S; S.init(M, N, (int)gridDim.x, (int)blockIdx.x);
    pg8::gemm_phase<Epi, pg8::StaticOrder, true, true>(lds, g, S, E);
}

__device__ __forceinline__ const float* ldp(volatile LAS unsigned long long* t, int i) { const unsigned long long v = t[i];
    return (const float*)((unsigned long long)(unsigned)__builtin_amdgcn_readfirstlane((int)(unsigned)v) | ((unsigned long long)(unsigned)__builtin_amdgcn_readfirstlane((int)(unsigned)(v >> 32)) << 32)); }
template <int PH>
__device__ __forceinline__ void run_phase(volatile LAS unsigned long long* t, int layer, int rep, LAS unsigned char* lds) {
    Params p{}; p.layer = layer; p.pad = rep;
    p.ws = (unsigned char*)ldp(t, 17);
    if constexpr (PH == PH_CONVERT) { p.x = ldp(t, 0); p.rel_bias = ldp(t, 1); p.w_in = ldp(t, 2); p.w_a = ldp(t, 7); p.w_b = ldp(t, 8); p.w_out = ldp(t, 9); p.w_ffn_in = ldp(t, 12); p.w_ffn_out = ldp(t, 13); }
    if constexpr (PH == PH_GDN_LOCAL) { p.conv_w = ldp(t, 3); p.a_log = ldp(t, 4); p.dt_bias = ldp(t, 5); }
    if constexpr (PH == PH_WOUT) { p.x = ldp(t, 0); p.out = (float*)ldp(t, 16); p.ln2_g = ldp(t, 14); p.ln2_b = ldp(t, 15); }
    if constexpr (PH == PH_LN1 || PH == PH_FFN_OUT) { p.ln1_g = ldp(t, 10); p.ln1_b = ldp(t, 11); p.out = (float*)ldp(t, 16); }
    if constexpr (PH == PH_LN2) { p.ln2_g = ldp(t, 14); p.ln2_b = ldp(t, 15); p.out = (float*)ldp(t, 16); }
    if constexpr (PH == PH_ATTN) { p.gdn_norm_w = ldp(t, 6); p.w_in = ldp(t, 2); p.w_a = ldp(t, 7); p.w_b = ldp(t, 8); p.w_out = ldp(t, 9); p.w_ffn_in = ldp(t, 12); p.w_ffn_out = ldp(t, 13); }
    unsigned char* ws = p.ws;
    unsigned char* wsw = p.ws + (size_t)(layer & 1) * WSET_STRIDE;
    if constexpr (PH == PH_CONVERT) phase_convert(p, lds);
    else if constexpr (PH == PH_INPROJ) { EpiProj E{ws}; run_gemm(lds, ws + WS_XB, wsw + WS_WIN, NP1, DM, E); }
    else if constexpr (PH == PH_GDN_LOCAL) { phase_gdn_local(p, lds); __syncthreads(); phase_indexer(p, lds); }
    else if constexpr (PH == PH_INDEXER) { }
    else if constexpr (PH == PH_GDN_SCAN) { }
    else if constexpr (PH == PH_ATTN) phase_mix(p, lds);
    else if constexpr (PH == PH_GATES) { EpiGate E{ws}; run_gemm(lds, ws + WS_XB, wsw + WS_WG, NGT, DM, E); }
    else if constexpr (PH == PH_BRANCH_A) { { EpiBranch<0> E{ws}; run_gemm(lds, ws + WS_OA, wsw + WS_WA, DM, 1024, E); }
        __syncthreads();
        { EpiBranch<1> E{ws}; run_gemm(lds, ws + WS_OB, wsw + WS_WB, DM, 1024, E); } }
    else if constexpr (PH == PH_BRANCH_B) { }
    else if constexpr (PH == PH_WOUT) { EpiResidB E{ws, p.layer == 0 ? p.x : nullptr}; run_gemm(lds, ws + WS_MERGED, wsw + WS_WO, DM, DM, E); }
    else if constexpr (PH == PH_LN1) phase_ln_b(p, p.ln1_g, p.ln1_b, false);
    else if constexpr (PH == PH_FFN_IN) { EpiSwiGLU E{ws}; run_gemm(lds, ws + WS_XB, wsw + WS_W1, 2 * DFF, DM, E); }
    else if constexpr (PH == PH_FFN_OUT) {
        if (p.layer == DEPTH - 1) { EpiResidC E{ws, nullptr, p.ln1_g + (size_t)p.layer * DM, p.ln1_b + (size_t)p.layer * DM, p.out}; run_gemm(lds, ws + WS_HID, wsw + WS_W2, DM, DFF, E); }
        else { EpiResidB E{ws, nullptr}; run_gemm(lds, ws + WS_HID, wsw + WS_W2, DM, DFF, E); } }
    else if constexpr (PH == PH_LN2) { if (p.layer == DEPTH - 1) phase_ln(p, p.ln2_g, p.ln2_b, true); else phase_ln_b(p, p.ln2_g, p.ln2_b, false); }
}


__device__ constexpr int kRep[PH_COUNT] = { 1, 1, 1, 0, 0, 1, 1, 1, 0, 1, 1, 1, 1, 1 };
__global__ void __launch_bounds__(NTHR, 2) fwd_kernel(Params p0) {
    extern __shared__ __attribute__((aligned(16))) unsigned char smem[];
    LAS unsigned char* lds = (LAS unsigned char*)smem;
    if (threadIdx.x < 4) ((LAS unsigned*)(lds + LDS_MISC))[threadIdx.x] = 0u;
    if ((threadIdx.x & 63) == 0) ((LAS int*)(lds + LDS_WTAB))[(unsigned)__builtin_amdgcn_s_getreg(63492) & 63u] = (int)(threadIdx.x >> 6);
    volatile LAS unsigned long long* ptab = (volatile LAS unsigned long long*)(lds + LDS_MISC + 64);
    if (threadIdx.x == 0) { ptab[0] = (unsigned long long)p0.x; ptab[1] = (unsigned long long)p0.rel_bias; ptab[2] = (unsigned long long)p0.w_in; ptab[3] = (unsigned long long)p0.conv_w;
        ptab[4] = (unsigned long long)p0.a_log; ptab[5] = (unsigned long long)p0.dt_bias; ptab[6] = (unsigned long long)p0.gdn_norm_w; ptab[7] = (unsigned long long)p0.w_a;
        ptab[8] = (unsigned long long)p0.w_b; ptab[9] = (unsigned long long)p0.w_out; ptab[10] = (unsigned long long)p0.ln1_g; ptab[11] = (unsigned long long)p0.ln1_b;
        ptab[12] = (unsigned long long)p0.w_ffn_in; ptab[13] = (unsigned long long)p0.w_ffn_out; ptab[14] = (unsigned long long)p0.ln2_g; ptab[15] = (unsigned long long)p0.ln2_b;
        ptab[16] = (unsigned long long)p0.out; ptab[17] = (unsigned long long)p0.ws; }
    __syncthreads();
    XcdBarrier bar = xcd_barrier_post((unsigned*)(p0.ws + WS_CTL) + p0.pad * 4096, (volatile LAS unsigned*)(lds + LDS_MISC));
    const int lo = p0.ph_lo, hi = p0.ph_hi;
#define PHASE(PH) do { const int gi_ = l * PH_COUNT + (PH); if (gi_ >= lo && gi_ < hi) { for (int rep_ = 0; rep_ < kRep[PH]; ++rep_) { run_phase<PH>(ptab, l, rep_, lds); if (gi_ + 1 < hi || rep_ + 1 < kRep[PH]) xcd_barrier(bar); } } } while (0)
    for (int l = 0; l < DEPTH; ++l) {
        if (l == 0) { PHASE(PH_CONVERT); } PHASE(PH_INPROJ); PHASE(PH_GDN_LOCAL); PHASE(PH_INDEXER); PHASE(PH_GDN_SCAN); PHASE(PH_ATTN); PHASE(PH_GATES);
        PHASE(PH_BRANCH_A); PHASE(PH_BRANCH_B); PHASE(PH_WOUT); PHASE(PH_LN1); PHASE(PH_FFN_IN); PHASE(PH_FFN_OUT); PHASE(PH_LN2);
    }
#undef PHASE
}

extern "C" void kernel_launch(void* const* d_in, const int* in_sizes, int n_in, void* d_out, int out_size, void* d_ws, size_t ws_size, hipStream_t stream) {
    if (n_in != 16 || out_size != M * DM || ws_size < WS_END) { fprintf(stderr, "kernel_launch: unexpected shapes (n_in %d, out %d, ws %zu < %zu)\n", n_in, out_size, ws_size, (size_t)WS_END); return; }
    Params p{};
    p.x = (const float*)d_in[0]; p.rel_bias = (const float*)d_in[1]; p.w_in = (const float*)d_in[2]; p.conv_w = (const float*)d_in[3];
    p.a_log = (const float*)d_in[4]; p.dt_bias = (const float*)d_in[5]; p.gdn_norm_w = (const float*)d_in[6]; p.w_a = (const float*)d_in[7];
    p.w_b = (const float*)d_in[8]; p.w_out = (const float*)d_in[9]; p.ln1_g = (const float*)d_in[10]; p.ln1_b = (const float*)d_in[11];
    p.w_ffn_in = (const float*)d_in[12]; p.w_ffn_out = (const float*)d_in[13]; p.ln2_g = (const float*)d_in[14]; p.ln2_b = (const float*)d_in[15];
    p.out = (float*)d_out; p.ws = (unsigned char*)d_ws;
    static int grid = 0;
    if (!grid) {
        int dev = 0, cus = 0, per_cu = 0;
        (void)hipGetDevice(&dev);
        if (hipDeviceGetAttribute(&cus, hipDeviceAttributeMultiprocessorCount, dev) != hipSuccess || cus <= 0) cus = 256;
        (void)hipFuncSetAttribute((const void*)fwd_kernel, hipFuncAttributeMaxDynamicSharedMemorySize, LDS_BYTES);
        if (hipOccupancyMaxActiveBlocksPerMultiprocessor(&per_cu, (const void*)fwd_kernel, NTHR, LDS_BYTES) != hipSuccess || per_cu < 1)
            fprintf(stderr, "kernel_launch: occupancy query reports %d workgroups per CU\n", per_cu);
        grid = cus;
    }
    (void)hipMemsetAsync((char*)d_ws + WS_CTL, 0, 1024 * 1024, stream);
    p.ph_lo = 0; p.ph_hi = DEPTH * PH_COUNT; p.pad = 0;
    fwd_kernel<<<dim3(grid), dim3(NTHR), LDS_BYTES, stream>>>(p);
}
```

```cpp
#include <hip/hip_runtime.h>
#include <cstdio>
#include <cstdint>

#define GAS __attribute__((address_space(1)))
#define LAS __attribute__((address_space(3)))
typedef unsigned short bf16;
typedef GAS unsigned gu32;
typedef short bf16x8 __attribute__((ext_vector_type(8)));
typedef short s16x4 __attribute__((ext_vector_type(4)));
typedef _Float16 f16x8 __attribute__((ext_vector_type(8)));
typedef float f32x2 __attribute__((ext_vector_type(2)));
typedef float f32x4 __attribute__((ext_vector_type(4)));
typedef float f32x16 __attribute__((ext_vector_type(16)));
typedef unsigned u32x2 __attribute__((ext_vector_type(2)));
typedef unsigned u32x4 __attribute__((ext_vector_type(4)));

constexpr int NB = 4, SEQ = 8192, DM = 2048, DEPTH = 4;
constexpr int M = NB * SEQ;
constexpr int NH = 8, HD = 128, CH = 64, NCH = SEQ / CH;
constexpr int DIN = 11864, DFF = 5632;
constexpr int NP1 = 7936;
constexpr int NGT = 4096;
constexpr int SMW = 768;
constexpr float ALPHA = 1.681792830507429f;
constexpr float LN_EPS = 1e-5f, RMS_EPS = 1e-6f;
constexpr int NWAVES = 8, NTHR = 512;

constexpr int C_QKVA = 0, C_A = 3072, C_B = 3080, C_Z = 3088, C_QB = 4112, C_QI = 7184, C_KI = 7696, C_WI = 7760, C_GA = 7768;

constexpr size_t MiB = 1u << 20;
constexpr size_t WS_CTL = 0;
constexpr size_t CTL_BYTES = 1 * MiB;
constexpr size_t WS_WIN = 1 * MiB;
constexpr size_t WS_WG  = WS_WIN + (size_t)NP1 * DM * 2;
constexpr size_t WS_WA  = WS_WG + (size_t)NGT * DM * 2;
constexpr size_t WS_WB  = WS_WA + (size_t)DM * 1024 * 2;
constexpr size_t WS_WO  = WS_WB + (size_t)DM * 1024 * 2;
constexpr size_t WS_W1  = WS_WO + (size_t)DM * DM * 2;
constexpr size_t WS_W2  = WS_W1 + (size_t)2 * DFF * DM * 2;
constexpr size_t WS_WEND = WS_W2 + (size_t)DM * DFF * 2;
constexpr size_t WS_XB  = 131 * MiB;
constexpr size_t WS_GQKV = WS_XB + 128 * MiB;
constexpr size_t WS_ZB  = WS_GQKV + 192 * MiB;
constexpr size_t WS_QB  = WS_ZB + 64 * MiB;
constexpr size_t WS_KB  = WS_QB + 64 * MiB;
constexpr size_t WS_VB  = WS_KB + 64 * MiB;
constexpr size_t WS_SM  = WS_VB + 64 * MiB;
constexpr size_t WS_QN  = WS_SM + 96 * MiB;
constexpr size_t WS_KN  = WS_QN + 64 * MiB;
constexpr size_t WS_VN  = WS_KN + 64 * MiB;
constexpr size_t WS_TT  = WS_VN + 64 * MiB;
constexpr size_t WS_AA  = WS_TT + 32 * MiB;
constexpr size_t WS_GCB = WS_AA + 32 * MiB;
constexpr size_t WS_QI  = WS_GCB + 2 * MiB;
constexpr size_t WS_KI  = WS_QI + 32 * MiB;
constexpr size_t WS_MASK = WS_KI + 4 * MiB;
constexpr size_t WS_OA  = WS_MASK + 32 * MiB;
constexpr size_t WS_BLUT = WS_OA + 64 * MiB;
constexpr size_t WS_OB = WS_BLUT + 1 * MiB;
constexpr size_t WS_STATS = WS_OB + 64 * MiB;
constexpr size_t WS_WSET2 = WS_STATS + 1 * MiB;
constexpr size_t WSET_STRIDE = WS_WSET2 - WS_WIN;
constexpr size_t WS_END = WS_WSET2 + (WS_WEND - WS_WIN);
constexpr size_t WS_YB = WS_QN;
constexpr size_t WS_GATES = WS_GQKV;
constexpr size_t WS_MERGED = WS_KB;
constexpr size_t WS_HID = WS_GQKV;
static_assert(WS_WEND <= WS_XB, "weights fit");
static_assert((size_t)M * DFF * 2 <= 384 * MiB, "hid overlay");

constexpr int LDS_BYTES = 144 * 1024;
constexpr int LDS_MISC = 143 * 1024;

struct Params {
    const float* x; const float* rel_bias; const float* w_in; const float* conv_w; const float* a_log; const float* dt_bias;
    const float* gdn_norm_w; const float* w_a; const float* w_b; const float* w_out; const float* ln1_g; const float* ln1_b;
    const float* w_ffn_in; const float* w_ffn_out; const float* ln2_g; const float* ln2_b;
    float* out; unsigned char* ws;
    int layer, ph_lo, ph_hi, pad;
};

__device__ __forceinline__ unsigned f2bf(float f) { return (unsigned)__builtin_bit_cast(unsigned short, (__bf16)f); }
typedef __bf16 bf16v2_t __attribute__((ext_vector_type(2)));
__device__ __forceinline__ unsigned pk2(float lo, float hi) { const f32x2 v = {lo, hi}; return __builtin_bit_cast(unsigned, __builtin_convertvector(v, bf16v2_t)); }
__device__ __forceinline__ float bf2f(unsigned short h) { return __builtin_bit_cast(float, (unsigned)h << 16); }
__device__ __forceinline__ float bflo(unsigned w) { return __builtin_bit_cast(float, w << 16); }
__device__ __forceinline__ float bfhi(unsigned w) { return __builtin_bit_cast(float, w & 0xffff0000u); }
__device__ __forceinline__ float fast_exp(float x) { return __builtin_amdgcn_exp2f(x * 1.4426950408889634f); }
__device__ __forceinline__ float sigmoidf_(float x) { return __builtin_amdgcn_rcpf(1.0f + fast_exp(-x)); }
__device__ __forceinline__ float siluf_(float x) { return x * sigmoidf_(x); }
__device__ __forceinline__ u32x4 zero4_() { unsigned z; asm volatile("v_mov_b32 %0, 0" : "=v"(z)); return (u32x4){z, z, z, z}; }
constexpr int LDS_WTAB = 143 * 1024 + 256;
__device__ __forceinline__ int ltid() {
    extern __shared__ __attribute__((aligned(16))) unsigned char smem_base_[];
    const unsigned slot = (unsigned)__builtin_amdgcn_s_getreg(63492) & 63u;
    const int w = ((volatile LAS int*)((LAS unsigned char*)smem_base_ + LDS_WTAB))[slot];
    int lane; asm volatile("v_mbcnt_lo_u32_b32 %0, -1, 0\n\tv_mbcnt_hi_u32_b32 %0, -1, %0" : "=v"(lane));
    return __builtin_amdgcn_readfirstlane(w) * 64 + lane;
}
#define LDS_WAIT() asm volatile("s_waitcnt lgkmcnt(0)" ::: "memory")
#define VM_WAIT() asm volatile("s_waitcnt vmcnt(0)" ::: "memory")

__device__ const unsigned char T5_LUT[132] = {0, 1, 2, 3, 4, 5, 6, 7, 8, 9, 10, 11, 12, 13, 14, 15, 16, 16, 16, 17, 17, 18, 18, 18, 19, 19, 19, 20, 20, 20, 20, 21, 21, 21, 21, 22, 22, 22, 22, 22,
    23, 23, 23, 23, 23, 23, 24, 24, 24, 24, 24, 24, 25, 25, 25, 25, 25, 25, 25, 26, 26, 26, 26, 26, 26, 26, 26, 27, 27, 27, 27, 27, 27, 27, 27, 27, 27, 28, 28, 28, 28, 28, 28, 28, 28, 28, 28,
    29, 29, 29, 29, 29, 29, 29, 29, 29, 29, 29, 29, 30, 30, 30, 30, 30, 30, 30, 30, 30, 30, 30, 30, 30, 30, 31, 31, 31, 31, 31, 31, 31, 31, 31, 31, 31, 31, 31, 31, 31, 31, 31, 31, 31};

namespace pg8 {
#define PG8_LAS __attribute__((address_space(3)))
typedef unsigned short bf16_t;
typedef short bf16x8 __attribute__((ext_vector_type(8)));
typedef float f32x4 __attribute__((ext_vector_type(4)));
typedef unsigned u32x4 __attribute__((ext_vector_type(4)));
constexpr int BM = 256, BK = 64, HALF = 128, HTB = HALF * BK * 2  , STAGE_BYTES = 8 * HTB, NXCD = 8, WGM = 4;

__host__ __device__ __forceinline__ int lds_byte(int r, int c) { const int st = (r >> 4) * 2 + (c >> 5), rr = r & 15, cc = c & 31, ob = rr * 64 + cc * 2; return st * 1024 + (ob ^ (((ob >> 9) & 1) << 5)); }
__host__ __device__ __forceinline__ void stage_rc(int b, int& R, int& C) { const int st = b / 1024, sb = b % 1024, swz = sb ^ (((sb >> 9) & 1) << 5); R = (st >> 1) * 16 + swz / 64; C = (st & 1) * 32 + (swz % 64) / 2; }
__host__ __device__ __forceinline__ int perm32(int rho) { const int n = rho >> 4, i = rho & 15; return 8 * (i >> 2) + 4 * n + (i & 3); }

struct Unit { int pm, pn; };
struct Gemm { const bf16_t* A; const bf16_t* Bt; int M, N, K; };

struct StaticOrder {
    int nM, nN, nwg, G, c;
    __host__ __device__ void init(int M, int N, int G_, int c_) { nM = M / BM; nN = N / BM; nwg = nM * nN; G = G_; c = c_; }
    __host__ __device__ bool next(int i, Unit& u) const {
        const long L = (long)i * G + c; if (L >= nwg) return false;
        int wgid = (int)L; { const int q = nwg / NXCD, r = nwg % NXCD, xcd = wgid % NXCD, off = wgid / NXCD; wgid = (xcd < r ? xcd * (q + 1) : r * (q + 1) + (xcd - r) * q) + off; }
        const int nig = WGM * nN, gid = wgid / nig, fm = gid * WGM, gsz = (nM - fm) < WGM ? (nM - fm) : WGM;
        u.pm = fm + ((wgid % nig) % gsz); u.pn = (wgid % nig) / gsz; return true;
    }
    __device__ __forceinline__ void a_ready(const Unit&) const {}
    __device__ __forceinline__ void done(const Unit&) const {}
};
template <class Epi, class Sched, bool ALIGN_EPI = false, bool SP2 = false>
__device__ __forceinline__ void gemm_phase(PG8_LAS unsigned char* lds, const Gemm g, const Sched& S, const Epi& E) {
    const int tid = ltid(), wid = __builtin_amdgcn_readfirstlane(tid >> 6), lane = tid & 63, wr = wid >> 2, wc = wid & 3, fr = lane & 15, fq = lane >> 4;
    const int K = g.K, nt = K / BK;
    unsigned voffA[2], voffB[2];
#pragma unroll
    for (int i = 0; i < 2; ++i) { int R, C; stage_rc(tid * 16 + i * 8192, R, C); const int Rb = Epi::PERM ? ((R & ~31) + perm32(R & 31)) : R;
        voffA[i] = (unsigned)(R * K + C) * 2u; voffB[i] = (unsigned)(Rb * K + C) * 2u; }
    const size_t kstep = (size_t)(BK * 2);
    const size_t hstep = (size_t)HALF * K * 2;
    const size_t tstep = 2 * hstep;
    const unsigned ldsw = (unsigned)wid * 1024u;
    const int aoff = lds_byte(wr * 64 + fr, fq * 8), boff = lds_byte(wc * 32 + fr, fq * 8);
#define PG8_SA(b, h) (((b) * 2 + (h)) * HTB)
#define PG8_SB(b, h) ((4 + (b) * 2 + (h)) * HTB)
#define PG8_STAGE(bufoff, gbase, voff) do { _Pragma("unroll") for (int _i = 0; _i < 2; ++_i) \
        __builtin_amdgcn_global_load_lds((const unsigned*)((const char*)(gbase) + (voff)[_i]), (PG8_LAS unsigned*)(lds + (bufoff) + ldsw + _i * 8192), 16, 0, 0); } while (0)
#define PG8_LDA(dst, b, h) do { _Pragma("unroll") for (int m = 0; m < 4; ++m) _Pragma("unroll") for (int k = 0; k < 2; ++k) dst[m][k] = *(const PG8_LAS bf16x8*)(lds + PG8_SA(b, h) + aoff + m * 2048 + k * 1024); } while (0)
#define PG8_LDB(dst, b, h) do { _Pragma("unroll") for (int n = 0; n < 2; ++n) _Pragma("unroll") for (int k = 0; k < 2; ++k) dst[n][k] = *(const PG8_LAS bf16x8*)(lds + PG8_SB(b, h) + boff + n * 2048 + k * 1024); } while (0)
#define PG8_MMA(ai, bj, At, Bt) do { __builtin_amdgcn_s_setprio(1); _Pragma("unroll") for (int m = 0; m < 4; ++m) _Pragma("unroll") for (int n = 0; n < 2; ++n) _Pragma("unroll") for (int k = 0; k < 2; ++k) \
        acc[ai][bj][m][n] = __builtin_amdgcn_mfma_f32_16x16x32_bf16(Bt[n][k], At[m][k], acc[ai][bj][m][n], 0, 0, 0); __builtin_amdgcn_s_setprio(0); } while (0)
#define PG8_WAIT_V(n) asm volatile("s_waitcnt vmcnt(" #n ")" ::: "memory")
#define PG8_WAIT_L(n) asm volatile("s_waitcnt lgkmcnt(" #n ")" ::: "memory")
#define PG8_BAR __builtin_amdgcn_s_barrier()
#define PG8_SCHED __builtin_amdgcn_sched_barrier(0)
    Unit cur, nxt; int ui = 0;
    if (!S.next(0, cur)) return;
    f32x4 acc[2][2][4][2];
#pragma unroll
    for (int a = 0; a < 2; ++a)
#pragma unroll
        for (int b = 0; b < 2; ++b)
#pragma unroll
            for (int m = 0; m < 4; ++m)
#pragma unroll
                for (int n = 0; n < 2; ++n) acc[a][b][m][n] = (f32x4){0.f, 0.f, 0.f, 0.f};
    bf16x8 At[4][2], B0[2][2], B1[2][2];
    const char* cA = (const char*)g.A + (size_t)cur.pm * tstep; const char* cB = (const char*)g.Bt + (size_t)cur.pn * tstep;
    S.a_ready(cur);
    if constexpr (SP2) {
        PG8_STAGE(PG8_SB(0, 0), cB, voffB); PG8_STAGE(PG8_SB(0, 1), cB + hstep, voffB); PG8_STAGE(PG8_SA(0, 0), cA, voffA); PG8_STAGE(PG8_SA(0, 1), cA + hstep, voffA);
        if (wr == 1) PG8_BAR;
        PG8_WAIT_V(2); PG8_BAR;
        PG8_STAGE(PG8_SB(1, 0), cB + kstep, voffB); PG8_STAGE(PG8_SA(1, 0), cA + kstep, voffA); PG8_STAGE(PG8_SB(1, 1), cB + hstep + kstep, voffB);
        PG8_WAIT_V(6); PG8_BAR;
    } else {
        PG8_STAGE(PG8_SB(0, 0), cB, voffB); PG8_STAGE(PG8_SA(0, 0), cA, voffA); PG8_STAGE(PG8_SB(0, 1), cB + hstep, voffB); PG8_STAGE(PG8_SA(0, 1), cA + hstep, voffA);
        if (wr == 1) PG8_BAR;
        PG8_WAIT_V(4); PG8_BAR;
        PG8_STAGE(PG8_SB(1, 0), cB + kstep, voffB); PG8_STAGE(PG8_SA(1, 0), cA + kstep, voffA); PG8_STAGE(PG8_SB(1, 1), cB + hstep + kstep, voffB);
        PG8_WAIT_V(6); PG8_BAR;
    }
    for (;;) {
        const bool has_next = S.next(ui + 1, nxt);
        const char* nA = has_next ? (const char*)g.A + (size_t)nxt.pm * tstep : cA; const char* nB = has_next ? (const char*)g.Bt + (size_t)nxt.pn * tstep : cB;
        for (int t = 0; t < nt; t += 2) {
            const bool last = (t == nt - 2);
            const char* a1 = cA + (size_t)(t + 1) * kstep;
            const char* a2 = last ? nA : cA + (size_t)(t + 2) * kstep; const char* b2 = last ? nB : cB + (size_t)(t + 2) * kstep;
            const char* a3 = a2 + kstep; const char* b3 = b2 + kstep;
            if (last && has_next) S.a_ready(nxt);
            if constexpr (SP2) {
            PG8_LDB(B0, 0, 0); PG8_LDB(B1, 0, 1); PG8_SCHED; PG8_LDA(At, 0, 0); PG8_STAGE(PG8_SA(1, 1), a1 + hstep, voffA);
            PG8_WAIT_V(8); PG8_WAIT_L(0); PG8_BAR; PG8_MMA(0, 0, At, B0); PG8_MMA(0, 1, At, B1); PG8_BAR; PG8_SCHED;
            PG8_LDA(At, 0, 1); PG8_STAGE(PG8_SB(0, 0), b2, voffB); PG8_STAGE(PG8_SB(0, 1), b2 + hstep, voffB); PG8_STAGE(PG8_SA(0, 0), a2, voffA);
            PG8_WAIT_V(8); PG8_WAIT_L(0); PG8_BAR; PG8_MMA(1, 0, At, B0); PG8_MMA(1, 1, At, B1); PG8_BAR; PG8_SCHED;
            PG8_LDB(B0, 1, 0); PG8_LDB(B1, 1, 1); PG8_SCHED; PG8_LDA(At, 1, 0); PG8_STAGE(PG8_SA(0, 1), a2 + hstep, voffA);
            PG8_WAIT_V(8); PG8_WAIT_L(0); PG8_BAR; PG8_MMA(0, 0, At, B0); PG8_MMA(0, 1, At, B1); PG8_BAR; PG8_SCHED;
            PG8_LDA(At, 1, 1); PG8_STAGE(PG8_SB(1, 0), b3, voffB); PG8_STAGE(PG8_SB(1, 1), b3 + hstep, voffB); PG8_STAGE(PG8_SA(1, 0), a3, voffA);
            PG8_WAIT_V(8); PG8_WAIT_L(0); PG8_BAR; PG8_MMA(1, 0, At, B0); PG8_MMA(1, 1, At, B1); PG8_BAR; PG8_SCHED;
            } else {
            PG8_LDB(B0, 0, 0); PG8_SCHED; PG8_LDA(At, 0, 0); PG8_STAGE(PG8_SA(1, 1), a1 + hstep, voffA);
            PG8_WAIT_L(8); PG8_BAR; PG8_WAIT_L(0); PG8_MMA(0, 0, At, B0); PG8_BAR; PG8_SCHED;
            PG8_LDB(B1, 0, 1); PG8_STAGE(PG8_SB(0, 0), b2, voffB);
            PG8_BAR; PG8_WAIT_L(0); PG8_MMA(0, 1, At, B1); PG8_BAR;
            PG8_LDA(At, 0, 1); PG8_STAGE(PG8_SA(0, 0), a2, voffA);
            PG8_BAR; PG8_WAIT_L(0); PG8_MMA(1, 0, At, B0); PG8_BAR; PG8_SCHED;
            PG8_STAGE(PG8_SB(0, 1), b2 + hstep, voffB);
            PG8_WAIT_V(6); PG8_BAR; PG8_MMA(1, 1, At, B1); PG8_BAR;
            PG8_LDB(B0, 1, 0); PG8_SCHED; PG8_LDA(At, 1, 0); PG8_STAGE(PG8_SA(0, 1), a2 + hstep, voffA);
            PG8_WAIT_L(8); PG8_BAR; PG8_WAIT_L(0); PG8_MMA(0, 0, At, B0); PG8_BAR; PG8_SCHED;
            PG8_LDB(B1, 1, 1); PG8_STAGE(PG8_SB(1, 0), b3, voffB);
            PG8_BAR; PG8_WAIT_L(0); PG8_MMA(0, 1, At, B1); PG8_BAR;
            PG8_LDA(At, 1, 1); PG8_STAGE(PG8_SA(1, 0), a3, voffA);
            PG8_BAR; PG8_WAIT_L(0); PG8_MMA(1, 0, At, B0); PG8_BAR; PG8_SCHED;
            PG8_STAGE(PG8_SB(1, 1), b3 + hstep, voffB);
            PG8_WAIT_V(6); PG8_BAR; PG8_MMA(1, 1, At, B1); PG8_BAR;
            }
        }
        if constexpr (ALIGN_EPI) { if (wr == 0) PG8_BAR; }
        if constexpr (!Epi::AFTER_DRAIN) { E(acc, cur, wr, wc, fr, fq); S.done(cur); }
        if (!has_next) break;
#pragma unroll
        for (int a = 0; a < 2; ++a)
#pragma unroll
            for (int b = 0; b < 2; ++b)
#pragma unroll
                for (int m = 0; m < 4; ++m)
#pragma unroll
                    for (int n = 0; n < 2; ++n) acc[a][b][m][n] = (f32x4){0.f, 0.f, 0.f, 0.f};
        cur = nxt; cA = nA; cB = nB; ++ui;
        if constexpr (ALIGN_EPI) { if (wr == 1) PG8_BAR; }
    }
    PG8_WAIT_V(0);
    if constexpr (!ALIGN_EPI) { if (wr == 0) PG8_BAR; }
    PG8_BAR;
    if constexpr (Epi::AFTER_DRAIN) { E.fused(acc, cur, wr, wc, fr, fq, lds, wid, lane); S.done(cur); }
#undef PG8_SA
#undef PG8_SB
#undef PG8_STAGE
#undef PG8_LDA
#undef PG8_LDB
#undef PG8_MMA
#undef PG8_WAIT_V
#undef PG8_WAIT_L
#undef PG8_BAR
#undef PG8_SCHED
}
}

__device__ __forceinline__ int map_win(int n) {
    if (n < 3072) return n;
    if (n < 4096) return C_Z + (n - 3072);
    if (n < 7168) return C_QB + (n - 4096);
    const int s = n - 7168;
    if (s < 512) return C_QI + s;
    if (s < 576) return C_KI + (s - 512);
    if (s < 584) return C_WI + (s - 576);
    if (s < 592) return C_A + (s - 584);
    if (s < 600) return C_B + (s - 592);
    return -1;
}
struct CvItem { const GAS float* src; GAS bf16* dst; int ldw8, K8, ok; };
template <int MODE>
__device__ __forceinline__ CvItem cv_make(const GAS float* W, int ldw, int K, GAS bf16* WT, int coff, int item, int lane) {
    const int nkh = K / 128, g = item >> 3, w8 = item & 7, nb = 4 * (g / nkh) + (w8 & 3), kb = 2 * (g % nkh) + (w8 >> 2), k0 = 64 * kb, n0 = 32 * nb;
    const int n = n0 + (lane & 7) * 4;
    int sc;
    if (MODE == 0) sc = map_win(n);
    else if (MODE == 1) sc = coff + n;
    else { const int t = n >> 8, r = n & 255; sc = (r < 128) ? (128 * t + r) : (DFF + 128 * t + (r - 128)); }
    CvItem c; c.ok = sc >= 0; c.src = W + (size_t)(k0 + (lane >> 3)) * ldw + (sc >= 0 ? sc : 0); c.dst = WT + (size_t)(n0 + (lane >> 3)) * K + k0 + 8 * (lane & 7);
    c.ldw8 = 8 * ldw; c.K8 = 8 * K; return c;
}
constexpr int CV_NIT = (DM / 64) * (NP1 / 32) + (DM / 64) * (NGT / 32) + 2 * (1024 / 64) * (DM / 32) + (DM / 64) * (DM / 32) + (DM / 64) * (2 * DFF / 32) + (DFF / 64) * (DM / 32);
__device__ __forceinline__ CvItem cv_decode(const Params& p, int l, int it, int lane) {
    GAS unsigned char* ws = (GAS unsigned char*)p.ws + (size_t)(l & 1) * WSET_STRIDE;
    const GAS float* w_in = (const GAS float*)p.w_in + (size_t)l * DM * DIN;
    constexpr int I0 = (DM / 64) * (NP1 / 32), I1 = (DM / 64) * (NGT / 32), I2 = (1024 / 64) * (DM / 32), I3 = I2, I4 = (DM / 64) * (DM / 32), I5 = (DM / 64) * (2 * DFF / 32);
    int r = it;
    if (r < I0) return cv_make<0>(w_in, DIN, DM, (GAS bf16*)(ws + WS_WIN), 0, r, lane); r -= I0;
    if (r < I1) return cv_make<1>(w_in, DIN, DM, (GAS bf16*)(ws + WS_WG), C_GA, r, lane); r -= I1;
    if (r < I2) return cv_make<1>((const GAS float*)p.w_a + (size_t)l * 1024 * DM, DM, 1024, (GAS bf16*)(ws + WS_WA), 0, r, lane); r -= I2;
    if (r < I3) return cv_make<1>((const GAS float*)p.w_b + (size_t)l * 1024 * DM, DM, 1024, (GAS bf16*)(ws + WS_WB), 0, r, lane); r -= I3;
    if (r < I4) return cv_make<1>((const GAS float*)p.w_out + (size_t)l * DM * DM, DM, DM, (GAS bf16*)(ws + WS_WO), 0, r, lane); r -= I4;
    if (r < I5) return cv_make<2>((const GAS float*)p.w_ffn_in + (size_t)l * DM * 2 * DFF, 2 * DFF, DM, (GAS bf16*)(ws + WS_W1), 0, r, lane); r -= I5;
    return cv_make<1>((const GAS float*)p.w_ffn_out + (size_t)l * DFF * DM, DM, DFF, (GAS bf16*)(ws + WS_W2), 0, r, lane);
}
__device__ __forceinline__ void cv_load(const CvItem& c, f32x4 (&wv)[8]) {
#pragma unroll
    for (int i = 0; i < 8; ++i) wv[i] = c.ok ? *(const GAS f32x4*)(c.src + (size_t)i * c.ldw8) : (f32x4){0.f, 0.f, 0.f, 0.f};
}
__device__ __forceinline__ void cv_store(const CvItem& c, const f32x4 (&wv)[8], LAS float* scr, int lane) {
#pragma unroll
    for (int i = 0; i < 8; ++i) { const int kk = 8 * i + (lane >> 3); LAS float* d = scr + kk * 33 + (lane & 7) * 4; d[0] = wv[i].x; d[1] = wv[i].y; d[2] = wv[i].z; d[3] = wv[i].w; }
    LDS_WAIT(); asm volatile("" ::: "memory");
    const int cc = lane & 7;
#pragma unroll
    for (int j = 0; j < 4; ++j) { const int nn = (lane >> 3) + 8 * j; const LAS float* s = scr + (8 * cc) * 33 + nn;
        u32x4 o; o.x = pk2(s[0 * 33], s[1 * 33]); o.y = pk2(s[2 * 33], s[3 * 33]); o.z = pk2(s[4 * 33], s[5 * 33]); o.w = pk2(s[6 * 33], s[7 * 33]);
        *(GAS u32x4*)(c.dst + (size_t)j * c.K8) = o; }
    LDS_WAIT(); asm volatile("" ::: "memory");
}
__device__ __forceinline__ void convert_weights(const Params& p, LAS unsigned char* lds, int l, int cw, int ncw) {
    const int tid = ltid(), lane = tid & 63, wave = tid >> 6;
    LAS float* scr = (LAS float*)(lds + wave * 16384);
    if (cw < CV_NIT) {
        f32x4 wa[8], wb[8];
        CvItem ca = cv_decode(p, l, cw, lane), cb = ca;
        cv_load(ca, wa);
        for (int it = cw;;) {
            const int i1 = it + ncw; const bool h1 = i1 < CV_NIT;
            if (h1) { cb = cv_decode(p, l, i1, lane); cv_load(cb, wb); }
            cv_store(ca, wa, scr, lane);
            if (!h1) break;
            const int i2 = i1 + ncw; const bool h2 = i2 < CV_NIT;
            if (h2) { ca = cv_decode(p, l, i2, lane); cv_load(ca, wa); }
            cv_store(cb, wb, scr, lane);
            if (!h2) break;
            it = i2;
        }
    }
}

__device__ __forceinline__ void phase_convert(const Params& p, LAS unsigned char* lds) {
    const int tid = ltid(), wave = tid >> 6;
    const int l = p.layer;
    GAS unsigned char* ws = (GAS unsigned char*)p.ws;
    convert_weights(p, lds, 0, (int)blockIdx.x * NWAVES + wave, (int)gridDim.x * NWAVES);
    if (l == 0) {
        const GAS f32x4* xs = (const GAS f32x4*)p.x; GAS u32x2* xd = (GAS u32x2*)(ws + WS_XB);
        const unsigned n4 = (unsigned)((size_t)M * DM / 4), st_ = gridDim.x * NTHR;
        for (unsigned i = blockIdx.x * NTHR + tid; i < n4; i += 4 * st_) { f32x4 v[4];
#pragma unroll
            for (int q = 0; q < 4; ++q) v[q] = xs[i + q * st_];
#pragma unroll
            for (int q = 0; q < 4; ++q) { u32x2 o; o.x = pk2(v[q].x, v[q].y); o.y = pk2(v[q].z, v[q].w); xd[i + q * st_] = o; } }
        if (blockIdx.x == 0) {
            GAS float* bl = (GAS float*)(ws + WS_BLUT);
            for (int i = tid; i < 8 * 132; i += NTHR) { const int h = i / 132, d = i % 132; const int dd = d > 128 ? 128 : d;
                bl[i] = ((const GAS float*)p.rel_bias)[(int)T5_LUT[dd] * 8 + h] * 11.313708498984761f; }
        }
    }
}

__device__ __forceinline__ float wave_sum(float v) {
#pragma unroll
    for (int o = 1; o < 64; o <<= 1) v += __shfl_xor(v, o);
    return v;
}
__device__ __forceinline__ float wave_sum_dpp(float v) {
    v += __builtin_bit_cast(float, __builtin_amdgcn_update_dpp(0, __builtin_bit_cast(int, v), 0x111, 0xf, 0xf, false));
    v += __builtin_bit_cast(float, __builtin_amdgcn_update_dpp(0, __builtin_bit_cast(int, v), 0x112, 0xf, 0xf, false));
    v += __builtin_bit_cast(float, __builtin_amdgcn_update_dpp(0, __builtin_bit_cast(int, v), 0x114, 0xf, 0xf, false));
    v += __builtin_bit_cast(float, __builtin_amdgcn_update_dpp(0, __builtin_bit_cast(int, v), 0x118, 0xf, 0xf, false));
    v += __builtin_bit_cast(float, __builtin_amdgcn_update_dpp(0, __builtin_bit_cast(int, v), 0x142, 0xa, 0xf, false));
    v += __builtin_bit_cast(float, __builtin_amdgcn_update_dpp(0, __builtin_bit_cast(int, v), 0x143, 0xc, 0xf, false));
    return __builtin_bit_cast(float, __builtin_amdgcn_readlane(__builtin_bit_cast(int, v), 63));
}
constexpr int LNR = 4;
__device__ __forceinline__ void phase_ln(const Params& p, const float* gptr, const float* bptr, bool final_out) {
    const int tid = ltid(), lane = tid & 63, wave = tid >> 6;
    const int gw = blockIdx.x * NWAVES + wave, NGW = gridDim.x * NWAVES;
    const GAS f32x4* g4 = (const GAS f32x4*)(gptr + (size_t)p.layer * DM) + lane;
    const GAS f32x4* b4 = (const GAS f32x4*)(bptr + (size_t)p.layer * DM) + lane;
    GAS unsigned char* ws = (GAS unsigned char*)p.ws;
    for (int m0 = LNR * gw; m0 < M; m0 += LNR * NGW) {
        f32x4 v[LNR][8]; float s[LNR];
#pragma unroll
        for (int r = 0; r < LNR; ++r) { const GAS f32x4* xr = (const GAS f32x4*)(p.out + (size_t)(m0 + r) * DM) + lane; s[r] = 0.f;
#pragma unroll
            for (int j = 0; j < 8; ++j) { v[r][j] = xr[64 * j]; s[r] += (v[r][j].x + v[r][j].y) + (v[r][j].z + v[r][j].w); } }
        float mean[LNR], rstd[LNR];
#pragma unroll
        for (int r = 0; r < LNR; ++r) mean[r] = wave_sum_dpp(s[r]) * (1.f / DM);
#pragma unroll
        for (int r = 0; r < LNR; ++r) { float s2 = 0.f;
#pragma unroll
            for (int j = 0; j < 8; ++j) { v[r][j] = v[r][j] - mean[r]; s2 += (v[r][j].x * v[r][j].x + v[r][j].y * v[r][j].y) + (v[r][j].z * v[r][j].z + v[r][j].w * v[r][j].w); }
            s[r] = s2; }
#pragma unroll
        for (int r = 0; r < LNR; ++r) rstd[r] = 1.0f / sqrtf(wave_sum_dpp(s[r]) * (1.f / DM) + LN_EPS);
#pragma unroll
        for (int r = 0; r < LNR; ++r) if (lane == r) ((GAS f32x2*)(ws + WS_STATS))[m0 + r] = (f32x2){mean[r], rstd[r]};
#pragma unroll
        for (int j = 0; j < 8; ++j) { const f32x4 g = g4[64 * j], b = b4[64 * j];
#pragma unroll
            for (int r = 0; r < LNR; ++r) { const f32x4 y = v[r][j] * rstd[r] * g + b;
                if (final_out) ((GAS f32x4*)(p.out + (size_t)(m0 + r) * DM) + lane)[64 * j] = y;
                if (!final_out) { u32x2 o; o.x = pk2(y.x, y.y); o.y = pk2(y.z, y.w); ((GAS u32x2*)(ws + WS_XB + (size_t)(m0 + r) * DM * 2) + lane)[64 * j] = o; } } }
    }
}

__device__ __forceinline__ void phase_ln_b(const Params& p, const float* gptr, const float* bptr, bool final_out) {
    const int tid = ltid(), lane = tid & 63, wave = tid >> 6;
    const int gw = blockIdx.x * NWAVES + wave, NGW = gridDim.x * NWAVES;
    const GAS float* gp = (const GAS float*)(gptr + (size_t)p.layer * DM) + lane * 8;
    const GAS float* bp = (const GAS float*)(bptr + (size_t)p.layer * DM) + lane * 8;
    GAS unsigned char* ws = (GAS unsigned char*)p.ws;
    for (int m0 = LNR * gw; m0 < M; m0 += LNR * NGW) {
        float v[LNR][4][8]; float s[LNR];
#pragma unroll
        for (int r = 0; r < LNR; ++r) { const GAS u32x4* yr = (const GAS u32x4*)(ws + WS_YB + (size_t)(m0 + r) * DM * 2) + lane; s[r] = 0.f;
            u32x4 t[4];
#pragma unroll
            for (int j = 0; j < 4; ++j) t[j] = yr[64 * j];
#pragma unroll
            for (int j = 0; j < 4; ++j) { v[r][j][0] = bflo(t[j].x); v[r][j][1] = bfhi(t[j].x); v[r][j][2] = bflo(t[j].y); v[r][j][3] = bfhi(t[j].y);
                v[r][j][4] = bflo(t[j].z); v[r][j][5] = bfhi(t[j].z); v[r][j][6] = bflo(t[j].w); v[r][j][7] = bfhi(t[j].w);
                s[r] += ((v[r][j][0] + v[r][j][1]) + (v[r][j][2] + v[r][j][3])) + ((v[r][j][4] + v[r][j][5]) + (v[r][j][6] + v[r][j][7])); } }
        float mean[LNR], rstd[LNR];
#pragma unroll
        for (int r = 0; r < LNR; ++r) mean[r] = wave_sum_dpp(s[r]) * (1.f / DM);
#pragma unroll
        for (int r = 0; r < LNR; ++r) { float s2 = 0.f;
#pragma unroll
            for (int j = 0; j < 4; ++j)
#pragma unroll
                for (int e = 0; e < 8; ++e) { v[r][j][e] -= mean[r]; s2 += v[r][j][e] * v[r][j][e]; }
            s[r] = s2; }
#pragma unroll
        for (int r = 0; r < LNR; ++r) rstd[r] = 1.0f / sqrtf(wave_sum_dpp(s[r]) * (1.f / DM) + LN_EPS);
#pragma unroll
        for (int r = 0; r < LNR; ++r) if (lane == r) ((GAS f32x2*)(ws + WS_STATS))[m0 + r] = (f32x2){mean[r], rstd[r]};
#pragma unroll
        for (int j = 0; j < 4; ++j) { const f32x4 g0 = *(const GAS f32x4*)(gp + 512 * j), g1 = *(const GAS f32x4*)(gp + 512 * j + 4), b0 = *(const GAS f32x4*)(bp + 512 * j), b1 = *(const GAS f32x4*)(bp + 512 * j + 4);
            const float gg[8] = {g0.x, g0.y, g0.z, g0.w, g1.x, g1.y, g1.z, g1.w}, bb[8] = {b0.x, b0.y, b0.z, b0.w, b1.x, b1.y, b1.z, b1.w};
#pragma unroll
            for (int r = 0; r < LNR; ++r) { float y[8];
#pragma unroll
                for (int e = 0; e < 8; ++e) y[e] = v[r][j][e] * rstd[r] * gg[e] + bb[e];
                if (final_out) { GAS f32x4* op = (GAS f32x4*)(p.out + (size_t)(m0 + r) * DM + 512 * j + lane * 8); op[0] = (f32x4){y[0], y[1], y[2], y[3]}; op[1] = (f32x4){y[4], y[5], y[6], y[7]}; }
                u32x4 o; o.x = pk2(y[0], y[1]); o.y = pk2(y[2], y[3]); o.z = pk2(y[4], y[5]); o.w = pk2(y[6], y[7]);
                ((GAS u32x4*)(ws + WS_XB + (size_t)(m0 + r) * DM * 2) + lane)[64 * j] = o; } }
    }
}

struct EpiProj {
    static constexpr bool PERM = true, AFTER_DRAIN = false;
    unsigned char* ws;
    __device__ __forceinline__ void operator()(const pg8::f32x4 (&acc)[2][2][4][2], const pg8::Unit& u, int wr, int wc, int fr, int fq) const {
        GAS unsigned char* w = (GAS unsigned char*)ws;
        const int row0 = u.pm * 256 + wr * 64 + fr, cin = wc * 32 + 8 * fq, pn = u.pn;
        if (pn < 28) {
            GAS bf16* base; int ld, colt; bool act = false;
            if (pn < 12) { base = (GAS bf16*)(w + WS_GQKV); ld = 3072; colt = pn * 256; }
            else if (pn < 16) { base = (GAS bf16*)(w + WS_ZB); ld = 1024; colt = (pn - 12) * 256; act = true; }
            else { const int t = (pn - 16) >> 2; base = (GAS bf16*)(w + WS_QB + (size_t)t * 64 * MiB); ld = 1024; colt = ((pn - 16) & 3) * 256; }
#pragma unroll
            for (int ai = 0; ai < 2; ++ai)
#pragma unroll
                for (int m = 0; m < 4; ++m) { GAS bf16* rowp = base + (size_t)(row0 + ai * 128 + m * 16) * ld + colt + cin;
#pragma unroll
                    for (int bj = 0; bj < 2; ++bj) { pg8::f32x4 v0 = acc[ai][bj][m][0], v1 = acc[ai][bj][m][1];
                        if (act) {
#pragma unroll
                            for (int j = 0; j < 4; ++j) { v0[j] = siluf_(v0[j]); v1[j] = siluf_(v1[j]); } }
                        u32x4 o; o.x = pk2(v0[0], v0[1]); o.y = pk2(v0[2], v0[3]); o.z = pk2(v1[0], v1[1]); o.w = pk2(v1[2], v1[3]);
                        *(GAS u32x4*)(rowp + bj * 128) = o; } }
        } else {
            typedef _Float16 h8_t __attribute__((ext_vector_type(8)));
#pragma unroll
            for (int ai = 0; ai < 2; ++ai)
#pragma unroll
                for (int m = 0; m < 4; ++m) { const size_t row = (size_t)(row0 + ai * 128 + m * 16);
#pragma unroll
                    for (int bj = 0; bj < 2; ++bj) { const pg8::f32x4 v0 = acc[ai][bj][m][0], v1 = acc[ai][bj][m][1];
                        const int c = (pn - 28) * 256 + bj * 128 + cin;
                        if (c < 576) { const h8_t o = {(_Float16)v0[0], (_Float16)v0[1], (_Float16)v0[2], (_Float16)v0[3], (_Float16)v1[0], (_Float16)v1[1], (_Float16)v1[2], (_Float16)v1[3]};
                            if (c < 512) *(GAS h8_t*)((GAS _Float16*)(w + WS_QI) + row * 512 + c) = o; else *(GAS h8_t*)((GAS _Float16*)(w + WS_KI) + row * 64 + (c - 512)) = o; }
                        else if (c < 600) { GAS float* d = (GAS float*)(w + WS_SM) + row * 32 + (c - 576); *(GAS pg8::f32x4*)d = v0; *(GAS pg8::f32x4*)(d + 4) = v1; } } }
        }
    }
};
struct EpiGate {
    static constexpr bool PERM = true, AFTER_DRAIN = false;
    unsigned char* ws;
    __device__ __forceinline__ void operator()(const pg8::f32x4 (&acc)[2][2][4][2], const pg8::Unit& u, int wr, int wc, int fr, int fq) const {
        GAS bf16* base = (GAS bf16*)((GAS unsigned char*)ws + WS_GATES);
        const int row0 = u.pm * 256 + wr * 64 + fr, col0 = u.pn * 256 + wc * 32 + 8 * fq;
#pragma unroll
        for (int ai = 0; ai < 2; ++ai)
#pragma unroll
            for (int m = 0; m < 4; ++m) { GAS bf16* rowp = base + (size_t)(row0 + ai * 128 + m * 16) * NGT + col0;
#pragma unroll
                for (int bj = 0; bj < 2; ++bj) { pg8::f32x4 v0 = acc[ai][bj][m][0], v1 = acc[ai][bj][m][1];
#pragma unroll
                    for (int j = 0; j < 4; ++j) { v0[j] = sigmoidf_(v0[j]); v1[j] = sigmoidf_(v1[j]); }
                    u32x4 o; o.x = pk2(v0[0], v0[1]); o.y = pk2(v0[2], v0[3]); o.z = pk2(v1[0], v1[1]); o.w = pk2(v1[2], v1[3]);
                    *(GAS u32x4*)(rowp + bj * 128) = o; } }
    }
};
template <int SECOND> struct EpiBranch {
    static constexpr bool PERM = true, AFTER_DRAIN = false;
    unsigned char* ws;
    __device__ __forceinline__ void operator()(const pg8::f32x4 (&acc)[2][2][4][2], const pg8::Unit& u, int wr, int wc, int fr, int fq) const {
        const GAS unsigned char* gates = (const GAS unsigned char*)ws + WS_GATES + (SECOND ? 2048 * 2 : 0);
        GAS unsigned char* mg = (GAS unsigned char*)ws + WS_MERGED;
        const int row0 = u.pm * 256 + wr * 64 + fr, col0 = u.pn * 256 + wc * 32 + 8 * fq;
#pragma unroll
        for (int ai = 0; ai < 2; ++ai) {
            u32x4 gv[4][2];
#pragma unroll
            for (int m = 0; m < 4; ++m)
#pragma unroll
                for (int bj = 0; bj < 2; ++bj) gv[m][bj] = *(const GAS u32x4*)(gates + ((size_t)(row0 + ai * 128 + m * 16) * NGT + col0 + bj * 128) * 2);
#pragma unroll
            for (int m = 0; m < 4; ++m)
#pragma unroll
                for (int bj = 0; bj < 2; ++bj) { const pg8::f32x4 v0 = acc[ai][bj][m][0], v1 = acc[ai][bj][m][1]; const u32x4 g = gv[m][bj];
                    float r[8] = {bflo(g.x) * v0[0], bfhi(g.x) * v0[1], bflo(g.y) * v0[2], bfhi(g.y) * v0[3], bflo(g.z) * v1[0], bfhi(g.z) * v1[1], bflo(g.w) * v1[2], bfhi(g.w) * v1[3]};
                    if (SECOND) { const u32x4 t = *(const GAS u32x4*)(mg + ((size_t)(row0 + ai * 128 + m * 16) * DM + col0 + bj * 128) * 2); r[0] += bflo(t.x); r[1] += bfhi(t.x); r[2] += bflo(t.y); r[3] += bfhi(t.y); r[4] += bflo(t.z); r[5] += bfhi(t.z); r[6] += bflo(t.w); r[7] += bfhi(t.w); }
                    u32x4 o; o.x = pk2(r[0], r[1]); o.y = pk2(r[2], r[3]); o.z = pk2(r[4], r[5]); o.w = pk2(r[6], r[7]);
                    *(GAS u32x4*)(mg + ((size_t)(row0 + ai * 128 + m * 16) * DM + col0 + bj * 128) * 2) = o; }
        }
    }
};
struct EpiResid {
    static constexpr bool PERM = false, AFTER_DRAIN = false;
    const float* yprev; float* out; const float* stats; const float* g; const float* b;
    __device__ __forceinline__ void operator()(const pg8::f32x4 (&acc)[2][2][4][2], const pg8::Unit& u, int wr, int wc, int fr, int fq) const {
        const int row0 = u.pm * 256 + wr * 64 + fr, col0 = u.pn * 256 + wc * 32 + 4 * fq;
        f32x4 gv[2][2], bv[2][2];
        if (g) {
#pragma unroll
            for (int bj = 0; bj < 2; ++bj)
#pragma unroll
                for (int n = 0; n < 2; ++n) { gv[bj][n] = *(const GAS f32x4*)(g + col0 + bj * 128 + n * 16); bv[bj][n] = *(const GAS f32x4*)(b + col0 + bj * 128 + n * 16); }
        }
#pragma unroll
        for (int ai = 0; ai < 2; ++ai)
#pragma unroll
            for (int mp = 0; mp < 2; ++mp) {
                f32x4 rr[2][2][2]; f32x2 ms[2];
#pragma unroll
                for (int mm = 0; mm < 2; ++mm) { const int row = row0 + ai * 128 + (2 * mp + mm) * 16; const size_t off = (size_t)row * DM + col0;
                    if (g) ms[mm] = ((const GAS f32x2*)stats)[row]; else { ms[mm].x = 0.f; ms[mm].y = 0.f; }
#pragma unroll
                    for (int bj = 0; bj < 2; ++bj)
#pragma unroll
                        for (int n = 0; n < 2; ++n) rr[mm][bj][n] = *(const GAS f32x4*)(yprev + off + bj * 128 + n * 16); }
#pragma unroll
                for (int mm = 0; mm < 2; ++mm) { const int m = 2 * mp + mm; const size_t off = (size_t)(row0 + ai * 128 + m * 16) * DM + col0;
#pragma unroll
                    for (int bj = 0; bj < 2; ++bj)
#pragma unroll
                        for (int n = 0; n < 2; ++n) { f32x4 r = rr[mm][bj][n];
                            if (g) r = (r - ms[mm].x) * ms[mm].y * gv[bj][n] + bv[bj][n];
                            *(GAS f32x4*)(out + off + bj * 128 + n * 16) = r * ALPHA + acc[ai][bj][m][n]; } }
            }
    }
};
struct EpiResidB {
    static constexpr bool PERM = true, AFTER_DRAIN = false;
    unsigned char* ws; const float* xf;
    __device__ __forceinline__ void operator()(const pg8::f32x4 (&acc)[2][2][4][2], const pg8::Unit& u, int wr, int wc, int fr, int fq) const {
        const int row0 = u.pm * 256 + wr * 64 + fr, col0 = u.pn * 256 + wc * 32 + 8 * fq;
        GAS unsigned char* yb = (GAS unsigned char*)ws + WS_YB;
#pragma unroll
        for (int ai = 0; ai < 2; ++ai) {
            float x[4][2][8];
            if (xf) {
                f32x4 t[4][2][2];
#pragma unroll
                for (int m = 0; m < 4; ++m)
#pragma unroll
                    for (int bj = 0; bj < 2; ++bj) { const GAS float* xp = (const GAS float*)xf + (size_t)(row0 + ai * 128 + m * 16) * DM + col0 + bj * 128; t[m][bj][0] = *(const GAS f32x4*)xp; t[m][bj][1] = *(const GAS f32x4*)(xp + 4); }
#pragma unroll
                for (int m = 0; m < 4; ++m)
#pragma unroll
                    for (int bj = 0; bj < 2; ++bj)
#pragma unroll
                        for (int e = 0; e < 4; ++e) { x[m][bj][e] = t[m][bj][0][e]; x[m][bj][4 + e] = t[m][bj][1][e]; }
            } else {
                u32x4 t[4][2];
#pragma unroll
                for (int m = 0; m < 4; ++m)
#pragma unroll
                    for (int bj = 0; bj < 2; ++bj) t[m][bj] = *(const GAS u32x4*)((const GAS unsigned char*)ws + WS_XB + ((size_t)(row0 + ai * 128 + m * 16) * DM + col0 + bj * 128) * 2);
#pragma unroll
                for (int m = 0; m < 4; ++m)
#pragma unroll
                    for (int bj = 0; bj < 2; ++bj) { const u32x4 q = t[m][bj]; x[m][bj][0] = bflo(q.x); x[m][bj][1] = bfhi(q.x); x[m][bj][2] = bflo(q.y); x[m][bj][3] = bfhi(q.y);
                        x[m][bj][4] = bflo(q.z); x[m][bj][5] = bfhi(q.z); x[m][bj][6] = bflo(q.w); x[m][bj][7] = bfhi(q.w); }
            }
#pragma unroll
            for (int m = 0; m < 4; ++m)
#pragma unroll
                for (int bj = 0; bj < 2; ++bj) { const pg8::f32x4 v0 = acc[ai][bj][m][0], v1 = acc[ai][bj][m][1];
                    float r[8];
#pragma unroll
                    for (int e = 0; e < 4; ++e) { r[e] = x[m][bj][e] * ALPHA + v0[e]; r[4 + e] = x[m][bj][4 + e] * ALPHA + v1[e]; }
                    u32x4 o; o.x = pk2(r[0], r[1]); o.y = pk2(r[2], r[3]); o.z = pk2(r[4], r[5]); o.w = pk2(r[6], r[7]);
                    *(GAS u32x4*)(yb + ((size_t)(row0 + ai * 128 + m * 16) * DM + col0 + bj * 128) * 2) = o; }
        }
    }
};
struct EpiResidC {
    static constexpr bool PERM = true, AFTER_DRAIN = false;
    unsigned char* ws; const float* xf; const float* g; const float* b; float* yf;
    __device__ __forceinline__ void operator()(const pg8::f32x4 (&acc)[2][2][4][2], const pg8::Unit& u, int wr, int wc, int fr, int fq) const {
        const int row0 = u.pm * 256 + wr * 64 + fr, col0 = u.pn * 256 + wc * 32 + 8 * fq;
        GAS unsigned char* yb = (GAS unsigned char*)ws + WS_YB;
        if (xf) {
#pragma unroll
            for (int ai = 0; ai < 2; ++ai)
#pragma unroll
                for (int mp = 0; mp < 2; ++mp) { f32x4 t[2][2][2];
#pragma unroll
                    for (int mm = 0; mm < 2; ++mm)
#pragma unroll
                        for (int bj = 0; bj < 2; ++bj) { const GAS float* xp = (const GAS float*)xf + (size_t)(row0 + ai * 128 + (2 * mp + mm) * 16) * DM + col0 + bj * 128; t[mm][bj][0] = *(const GAS f32x4*)xp; t[mm][bj][1] = *(const GAS f32x4*)(xp + 4); }
#pragma unroll
                    for (int mm = 0; mm < 2; ++mm)
#pragma unroll
                        for (int bj = 0; bj < 2; ++bj) { const int m = 2 * mp + mm; const pg8::f32x4 r0 = t[mm][bj][0] * ALPHA + acc[ai][bj][m][0], r1 = t[mm][bj][1] * ALPHA + acc[ai][bj][m][1];
                            u32x4 o; o.x = pk2(r0[0], r0[1]); o.y = pk2(r0[2], r0[3]); o.z = pk2(r1[0], r1[1]); o.w = pk2(r1[2], r1[3]);
                            *(GAS u32x4*)(yb + ((size_t)(row0 + ai * 128 + m * 16) * DM + col0 + bj * 128) * 2) = o; } }
            return;
        }
        f32x4 gv[2][2], bv[2][2];
#pragma unroll
        for (int bj = 0; bj < 2; ++bj)
#pragma unroll
            for (int n = 0; n < 2; ++n) { gv[bj][n] = *(const GAS f32x4*)((const GAS float*)g + col0 + bj * 128 + n * 4); bv[bj][n] = *(const GAS f32x4*)((const GAS float*)b + col0 + bj * 128 + n * 4); }
#pragma unroll
        for (int ai = 0; ai < 2; ++ai)
#pragma unroll
            for (int mp = 0; mp < 2; ++mp) {
                u32x4 t[2][2]; f32x2 ms[2];
#pragma unroll
                for (int mm = 0; mm < 2; ++mm) { const int row = row0 + ai * 128 + (2 * mp + mm) * 16; ms[mm] = ((const GAS f32x2*)((const GAS unsigned char*)ws + WS_STATS))[row];
#pragma unroll
                    for (int bj = 0; bj < 2; ++bj) t[mm][bj] = *(const GAS u32x4*)(yb + ((size_t)row * DM + col0 + bj * 128) * 2); }
#pragma unroll
                for (int mm = 0; mm < 2; ++mm)
#pragma unroll
                    for (int bj = 0; bj < 2; ++bj) { const int m = 2 * mp + mm; const u32x4 q = t[mm][bj];
                        pg8::f32x4 y0 = {bflo(q.x), bfhi(q.x), bflo(q.y), bfhi(q.y)}, y1 = {bflo(q.z), bfhi(q.z), bflo(q.w), bfhi(q.w)};
                        y0 = (y0 - ms[mm].x) * ms[mm].y * gv[bj][0] + bv[bj][0]; y1 = (y1 - ms[mm].x) * ms[mm].y * gv[bj][1] + bv[bj][1];
                        const pg8::f32x4 r0 = y0 * ALPHA + acc[ai][bj][m][0], r1 = y1 * ALPHA + acc[ai][bj][m][1];
                        if (yf) { GAS pg8::f32x4* op = (GAS pg8::f32x4*)((GAS float*)yf + (size_t)(row0 + ai * 128 + m * 16) * DM + col0 + bj * 128); op[0] = r0; op[1] = r1; }
                        else { u32x4 o; o.x = pk2(r0[0], r0[1]); o.y = pk2(r0[2], r0[3]); o.z = pk2(r1[0], r1[1]); o.w = pk2(r1[2], r1[3]);
                            *(GAS u32x4*)(yb + ((size_t)(row0 + ai * 128 + m * 16) * DM + col0 + bj * 128) * 2) = o; } }
            }
    }
};
struct EpiSwiGLU {
    static constexpr bool PERM = true, AFTER_DRAIN = false;
    unsigned char* ws;
    __device__ __forceinline__ void operator()(const pg8::f32x4 (&acc)[2][2][4][2], const pg8::Unit& u, int wr, int wc, int fr, int fq) const {
        GAS bf16* base = (GAS bf16*)((GAS unsigned char*)ws + WS_HID);
        const int row0 = u.pm * 256 + wr * 64 + fr, col0 = u.pn * 128 + wc * 32 + 8 * fq;
#pragma unroll
        for (int ai = 0; ai < 2; ++ai)
#pragma unroll
            for (int m = 0; m < 4; ++m) { GAS bf16* rowp = base + (size_t)(row0 + ai * 128 + m * 16) * DFF + col0;
                float r[8];
#pragma unroll
                for (int n = 0; n < 2; ++n)
#pragma unroll
                    for (int j = 0; j < 4; ++j) r[4 * n + j] = siluf_(acc[ai][0][m][n][j]) * acc[ai][1][m][n][j];
                u32x4 o; o.x = pk2(r[0], r[1]); o.y = pk2(r[2], r[3]); o.z = pk2(r[4], r[5]); o.w = pk2(r[6], r[7]);
                *(GAS u32x4*)rowp = o; }
    }
};

__device__ __forceinline__ float softplusf_(float x) { return fmaxf(x, 0.f) + __logf(1.0f + __expf(-fabsf(x))); }
__device__ __forceinline__ f32x4 mfma16(bf16x8 a, bf16x8 b, f32x4 c) { return __builtin_amdgcn_mfma_f32_16x16x32_bf16(a, b, c, 0, 0, 0); }

__device__ __forceinline__ void conv_ld_w(const GAS float* cw, f32x4 (&w)[4][2]) {
#pragma unroll
    for (int j = 0; j < 4; ++j) { w[j][0] = *(const GAS f32x4*)(cw + (size_t)j * 3072); w[j][1] = *(const GAS f32x4*)(cw + (size_t)j * 3072 + 4); }
}
__device__ __forceinline__ bf16x8 pack8s(const float (&y)[8], float sc) {
    u32x4 w; w.x = pk2(y[0] * sc, y[1] * sc); w.y = pk2(y[2] * sc, y[3] * sc); w.z = pk2(y[4] * sc, y[5] * sc); w.w = pk2(y[6] * sc, y[7] * sc);
    return __builtin_bit_cast(bf16x8, w);
}

__device__ __forceinline__ float row16_sum(float v) {
    v += __builtin_bit_cast(float, __builtin_amdgcn_update_dpp(0, __builtin_bit_cast(int, v), 0xB1, 0xF, 0xF, true));
    v += __builtin_bit_cast(float, __builtin_amdgcn_update_dpp(0, __builtin_bit_cast(int, v), 0x4E, 0xF, 0xF, true));
    v += __builtin_bit_cast(float, __builtin_amdgcn_update_dpp(0, __builtin_bit_cast(int, v), 0x141, 0xF, 0xF, true));
    v += __builtin_bit_cast(float, __builtin_amdgcn_update_dpp(0, __builtin_bit_cast(int, v), 0x140, 0xF, 0xF, true));
    return v;
}
__device__ __forceinline__ void phase_gdn_local(const Params& p, LAS unsigned char* lds) {
    const int tid = ltid(), lane0 = tid & 63, wave = __builtin_amdgcn_readfirstlane(tid >> 6);
    const int gw = blockIdx.x * NWAVES + wave, NGW = gridDim.x * NWAVES;
    GAS unsigned char* ws = (GAS unsigned char*)p.ws;
    const int l = p.layer;
    LAS float* Mw = (LAS float*)(lds + wave * 16384);
    const GAS float* cwl = (const GAS float*)p.conv_w + (size_t)l * 4 * 3072;
    for (int u = gw; u < NB * NCH * NH; u += NGW) {
        int lane = lane0; asm volatile("" : "+v"(lane));
        const int rb = lane >> 4, cc = lane & 15;
        const int b = u >> 10, n = (u >> 3) & 127, h = u & 7;
        const int t0 = n * CH; const size_t row0 = (size_t)b * SEQ + t0;
        const size_t hm0 = ((size_t)(b * NH + h) * SEQ + t0) * HD;
        const GAS unsigned char* gqb = ws + WS_GQKV + (row0 * 3072) * 2 - 3 * 6144;
#pragma unroll 1
        for (int tq = 0; tq < 3; ++tq) {
            const int gcol = (tq == 0 ? 2048 : (tq == 1 ? 1024 : 0)) + h * 128 + 8 * cc;
            f32x4 cw[4][2]; conv_ld_w(cwl + gcol, cw);
            u32x4 xr[19];
#pragma unroll
            for (int i = 0; i < 19; ++i) { const int tr = 16 * rb - 3 + i; const bool ok = (t0 + tr) >= 0;
                xr[i] = *(const GAS u32x4*)(gqb + (unsigned)((ok ? tr + 3 : 3) * 6144 + gcol * 2)); if (!ok) xr[i] = (u32x4){0u, 0u, 0u, 0u}; }
            GAS unsigned char* dst = ws + (tq == 0 ? WS_VN : (tq == 1 ? WS_KN : WS_QN)) + hm0 * 2;
            const float qs = (tq == 2) ? 0.08838834764831845f : 1.0f;
#pragma unroll
            for (int i = 0; i < 16; ++i) {
                float y[8];
#pragma unroll
                for (int e = 0; e < 8; ++e) y[e] = 0.f;
#pragma unroll
                for (int j = 0; j < 4; ++j) { const u32x4 x_ = xr[i + j];
                    y[0] += bflo(x_.x) * cw[j][0].x; y[1] += bfhi(x_.x) * cw[j][0].y; y[2] += bflo(x_.y) * cw[j][0].z; y[3] += bfhi(x_.y) * cw[j][0].w;
                    y[4] += bflo(x_.z) * cw[j][1].x; y[5] += bfhi(x_.z) * cw[j][1].y; y[6] += bflo(x_.w) * cw[j][1].z; y[7] += bfhi(x_.w) * cw[j][1].w; }
                float ss = 0.f;
#pragma unroll
                for (int e = 0; e < 8; ++e) { y[e] = siluf_(y[e]); ss += y[e] * y[e]; }
                float sc = 1.0f;
                if (tq != 0) sc = qs / sqrtf(row16_sum(ss) + RMS_EPS);
                *(GAS bf16x8*)(dst + (unsigned)(((16 * rb + i) * HD + 8 * cc) * 2)) = pack8s(y, sc);
            }
        }
    }
    VM_WAIT();
    for (int u = gw; u < NB * NCH * NH; u += NGW) {
        int lane = lane0; asm volatile("" : "+v"(lane));
        const int g = lane >> 4, r16 = lane & 15;
        const int b = u >> 10, n = (u >> 3) & 127, h = u & 7;
        const int t0 = n * CH; const size_t row0 = (size_t)b * SEQ + t0;
        const size_t hm0 = ((size_t)(b * NH + h) * SEQ + t0) * HD;
        bf16x8 kf[4][4];
#pragma unroll
        for (int rt = 0; rt < 4; ++rt)
#pragma unroll
            for (int ks = 0; ks < 4; ++ks) kf[rt][ks] = *(const GAS bf16x8*)(ws + WS_KN + hm0 * 2 + (unsigned)(((16 * rt + r16) * HD + 32 * ks + 8 * g) * 2));
        bf16x8 qf[4][4];
#pragma unroll
        for (int rt = 0; rt < 4; ++rt)
#pragma unroll
            for (int ks = 0; ks < 4; ++ks) qf[rt][ks] = *(const GAS bf16x8*)(ws + WS_QN + hm0 * 2 + (unsigned)(((16 * rt + r16) * HD + 32 * ks + 8 * g) * 2));
        float gc, beta;
        { const GAS float* sm = (const GAS float*)(ws + WS_SM) + (row0 + lane) * 32;
          const float a_in = sm[8 + h], b_in = sm[16 + h];
          gc = -__expf(((const GAS float*)p.a_log)[l * NH + h]) * softplusf_(a_in + ((const GAS float*)p.dt_bias)[l * NH + h]);
          beta = 1.0f / (1.0f + __expf(-b_in));
#pragma unroll
          for (int o = 1; o < 64; o <<= 1) { const float t = __shfl_up(gc, o); if (lane >= o) gc += t; }
          GAS f32x2* gb = (GAS f32x2*)(ws + WS_GCB) + ((size_t)(b * NH + h) * SEQ + t0 + lane);
          *gb = (f32x2){gc, beta}; }
        float gi[4], bi[4], gj[4][4];
#pragma unroll
        for (int rt = 0; rt < 4; ++rt) { gi[rt] = __shfl(gc, 16 * rt + r16); bi[rt] = __shfl(beta, 16 * rt + r16); }
#pragma unroll
        for (int ct = 0; ct < 4; ++ct)
#pragma unroll
            for (int r = 0; r < 4; ++r) gj[ct][r] = __shfl(gc, 16 * ct + 4 * g + r);
        f32x4 mvals[10];
        { int ti = 0;
#pragma unroll
          for (int rt = 0; rt < 4; ++rt)
#pragma unroll
            for (int ct = 0; ct <= rt; ++ct) {
                const int i = 16 * rt + r16, j0 = 16 * ct + 4 * g;
                f32x4 kk = (f32x4){0.f, 0.f, 0.f, 0.f};
#pragma unroll
                for (int ks = 0; ks < 4; ++ks) kk = mfma16(kf[ct][ks], kf[rt][ks], kk);
#pragma unroll
                for (int r = 0; r < 4; ++r) { const int j = j0 + r; const float dec = __expf(fminf(gi[rt] - gj[ct][r], 0.f)); mvals[ti][r] = (j < i) ? bi[rt] * kk[r] * dec : 0.f; }
                ++ti; } }
        GAS bf16* Ag = (GAS bf16*)(ws + WS_AA) + (size_t)u * 4096;
        LDS_WAIT(); __builtin_amdgcn_wave_barrier(); asm volatile("" ::: "memory");
#pragma unroll
        for (int rt = 0; rt < 4; ++rt) {
            bf16x8 qfr[4];
#pragma unroll
            for (int ks = 0; ks < 4; ++ks) qfr[ks] = qf[rt][ks];
#pragma unroll
            for (int ct = 0; ct < 4; ++ct) {
                const int i = 16 * rt + r16, j0 = 16 * ct + 4 * g;
                if (ct <= rt) {
                    f32x4 qk = (f32x4){0.f, 0.f, 0.f, 0.f};
#pragma unroll
                    for (int ks = 0; ks < 4; ++ks) qk = mfma16(kf[ct][ks], qfr[ks], qk);
                    f32x4 av;
#pragma unroll
                    for (int r = 0; r < 4; ++r) { const int j = j0 + r; const float dec = __expf(fminf(gi[rt] - gj[ct][r], 0.f)); av[r] = (j <= i) ? qk[r] * dec : 0.f; }
                    u32x2 ao; ao.x = pk2(av[0], av[1]); ao.y = pk2(av[2], av[3]);
                    *(GAS u32x2*)((GAS unsigned char*)Ag + (unsigned)((i * 64 + j0) * 2)) = ao;
                } else {
                    { unsigned zz = 0u; asm volatile("" : "+v"(zz)); *(GAS u32x2*)((GAS unsigned char*)Ag + (unsigned)((i * 64 + j0) * 2)) = (u32x2){zz, zz}; }
                }
            }
            __builtin_amdgcn_sched_barrier(0);
        }
        LDS_WAIT(); __builtin_amdgcn_wave_barrier(); asm volatile("" ::: "memory");
        { int ti = 0;
#pragma unroll
          for (int rt = 0; rt < 4; ++rt)
#pragma unroll
            for (int ct = 0; ct <= rt; ++ct) { *(LAS f32x4*)(Mw + (16 * rt + r16) * 64 + 16 * ct + 4 * g) = mvals[ti]; ++ti; } }
        LDS_WAIT(); __builtin_amdgcn_wave_barrier(); asm volatile("" ::: "memory");
        {
            float x[64];
            GAS bf16* Tg = (GAS bf16*)(ws + WS_TT) + (size_t)u * 4096;
#pragma unroll
            for (int i = 0; i < 64; ++i) {
                float a0 = (i == lane) ? 1.f : 0.f, a1 = 0.f;
#pragma unroll
                for (int j4 = 0; j4 < (i + 3) / 4; ++j4) {
                    const f32x4 m = *(const LAS f32x4*)(Mw + i * 64 + 4 * j4);
#pragma unroll
                    for (int jj = 0; jj < 4; ++jj) { const int j = 4 * j4 + jj; if (j < i) { if (jj & 1) a1 -= m[jj] * x[j]; else a0 -= m[jj] * x[j]; } }
                }
                x[i] = a0 + a1;
                *(GAS bf16*)((GAS unsigned char*)Tg + (unsigned)((i * 64 + lane) * 2)) = (bf16)f2bf(x[i]);
            }
        }
        LDS_WAIT(); __builtin_amdgcn_wave_barrier(); asm volatile("" ::: "memory");
    }
}

#define TRRD(dst, addr, off) asm volatile("ds_read_b64_tr_b16 %0, %1 offset:%2" : "=&v"(dst) : "v"(addr), "i"(off) : "memory")
__device__ __forceinline__ bf16x8 cat4(s16x4 a, s16x4 b) { return (bf16x8){a[0], a[1], a[2], a[3], b[0], b[1], b[2], b[3]}; }
__device__ __forceinline__ bf16x8 pack_cc(f32x4 a, f32x4 b) { u32x4 w; w.x = pk2(a[0], a[1]); w.y = pk2(a[2], a[3]); w.z = pk2(b[0], b[1]); w.w = pk2(b[2], b[3]); return __builtin_bit_cast(bf16x8, w); }

constexpr int SC_K = 0, SC_Q = 17408, SC_V = 34816, SC_O = 52224, SC_T = 69632, SC_A = 78848, SC_GB = 88064, SC_END = 88576;
constexpr int SC_P1 = 272, SC_P2 = 144;

__device__ __forceinline__ void gdn_scan_bh(const Params& p, LAS unsigned char* lds, int bh) {
    const int b = bh >> 3, h = bh & 7;
    const int tid = ltid(), lane = tid & 63, w = tid >> 6, g = lane >> 4, i16 = lane & 15;
    GAS unsigned char* ws = (GAS unsigned char*)p.ws;
    const GAS bf16* KN = (const GAS bf16*)(ws + WS_KN) + (size_t)bh * SEQ * HD;
    const GAS bf16* QN = (const GAS bf16*)(ws + WS_QN) + (size_t)bh * SEQ * HD;
    const GAS bf16* VN = (const GAS bf16*)(ws + WS_VN) + (size_t)bh * SEQ * HD;
    const GAS f32x2* GCB = (const GAS f32x2*)(ws + WS_GCB) + (size_t)bh * SEQ;
    GAS bf16* OA = (GAS bf16*)(ws + WS_OA) + (size_t)b * SEQ * 1024 + h * 128;
    u32x4 st_k[2], st_q[2], st_v[2], st_t, st_a; f32x2 st_gb = (f32x2){0.f, 0.f};
    const int prow = tid >> 4, pch = tid & 15;
    const int trow_ = tid >> 3, tch = tid & 7;
#define SC_LOAD(n_) do { const size_t e0 = (size_t)(n_) * CH * HD; const size_t uu = ((size_t)(b * NCH + (n_)) * NH + h) * 4096; \
        _Pragma("unroll") for (int i_ = 0; i_ < 2; ++i_) { const size_t eo = e0 + (size_t)(prow + 32 * i_) * HD + pch * 8; \
            st_k[i_] = *(const GAS u32x4*)(KN + eo); st_q[i_] = *(const GAS u32x4*)(QN + eo); st_v[i_] = *(const GAS u32x4*)(VN + eo); } \
        st_t = *(const GAS u32x4*)((const GAS bf16*)(ws + WS_TT) + uu + trow_ * 64 + tch * 8); st_a = *(const GAS u32x4*)((const GAS bf16*)(ws + WS_AA) + uu + trow_ * 64 + tch * 8); \
        if (tid < 64) st_gb = GCB[(n_) * CH + tid]; } while (0)
#define SC_WRITE() do { _Pragma("unroll") for (int i_ = 0; i_ < 2; ++i_) { const int o_ = (prow + 32 * i_) * SC_P1 + pch * 16; \
            *(LAS u32x4*)(lds + SC_K + o_) = st_k[i_]; *(LAS u32x4*)(lds + SC_Q + o_) = st_q[i_]; *(LAS u32x4*)(lds + SC_V + o_) = st_v[i_]; } \
        *(LAS u32x4*)(lds + SC_T + trow_ * SC_P2 + tch * 16) = st_t; *(LAS u32x4*)(lds + SC_A + trow_ * SC_P2 + tch * 16) = st_a; \
        if (tid < 64) { ((LAS float*)(lds + SC_GB))[tid] = st_gb.x; ((LAS float*)(lds + SC_GB))[64 + tid] = st_gb.y; } } while (0)
#define SC_LOADZ(n_) do { _Pragma("unroll") for (int i_ = 0; i_ < 2; ++i_) st_z[i_] = *(const GAS u32x4*)(ZBp + (size_t)((n_) * CH + prow + 32 * i_) * 1024 + pch * 8); } while (0)
#define SC_OUT(n_) do { _Pragma("unroll") for (int i_ = 0; i_ < 2; ++i_) { const u32x4 ov_ = *(const LAS u32x4*)(lds + SC_O + (prow + 32 * i_) * SC_P1 + pch * 16); const u32x4 zv_ = st_z[i_]; \
            float o_[8] = {bflo(ov_.x), bfhi(ov_.x), bflo(ov_.y), bfhi(ov_.y), bflo(ov_.z), bfhi(ov_.z), bflo(ov_.w), bfhi(ov_.w)};                          \
            const float z_[8] = {bflo(zv_.x), bfhi(zv_.x), bflo(zv_.y), bfhi(zv_.y), bflo(zv_.z), bfhi(zv_.z), bflo(zv_.w), bfhi(zv_.w)};                    \
            float ss_ = 0.f; _Pragma("unroll") for (int e = 0; e < 8; ++e) ss_ += o_[e] * o_[e];                                                           \
            ss_ = row16_sum(ss_); const float rs_ = __builtin_amdgcn_rsqf(ss_ * (1.0f / HD) + RMS_EPS);                                                     \
            _Pragma("unroll") for (int e = 0; e < 8; ++e) o_[e] = o_[e] * rs_ * nwv[e] * z_[e];                                                            \
            u32x4 r_; r_.x = pk2(o_[0], o_[1]); r_.y = pk2(o_[2], o_[3]); r_.z = pk2(o_[4], o_[5]); r_.w = pk2(o_[6], o_[7]);                               \
            *(GAS u32x4*)(OA + (size_t)((n_) * CH + prow + 32 * i_) * 1024 + pch * 8) = r_; } } while (0)
    u32x4 st_z[2];
    const GAS bf16* ZBp = (const GAS bf16*)(ws + WS_ZB) + (size_t)b * SEQ * 1024 + h * 128;
    float nwv[8];
    { const GAS float* nwp = (const GAS float*)p.gdn_norm_w + (size_t)p.layer * HD + pch * 8; const f32x4 n0 = *(const GAS f32x4*)nwp, n1 = *(const GAS f32x4*)(nwp + 4);
      nwv[0] = n0.x; nwv[1] = n0.y; nwv[2] = n0.z; nwv[3] = n0.w; nwv[4] = n1.x; nwv[5] = n1.y; nwv[6] = n1.z; nwv[7] = n1.w; }
    SC_LOAD(0); SC_WRITE();
    __syncthreads();
    f32x4 Sacc[8];
#pragma unroll
    for (int dt = 0; dt < 8; ++dt) Sacc[dt] = (f32x4){0.f, 0.f, 0.f, 0.f};
    const unsigned rdA = (unsigned)(i16 * SC_P1 + 8 * g);
    const unsigned rdT = (unsigned)(i16 * SC_P2 + 8 * g);
    const unsigned ldsb = (unsigned)(uintptr_t)lds;
    const unsigned trq = (unsigned)((i16 >> 2) * SC_P1 + (i16 & 3) * 8);
    const unsigned trV = ldsb + SC_V + trq + (unsigned)(4 * g * SC_P1 + 32 * w);
    const unsigned trK = ldsb + SC_K + trq + (unsigned)(4 * g * SC_P1);
    for (int n = 0; n < NCH; ++n) {
        if (n > 0) SC_OUT(n - 1);
        SC_LOADZ(n);
        if (n + 1 < NCH) SC_LOAD(n + 1);
        bf16x8 Sb[4];
#pragma unroll
        for (int ks = 0; ks < 4; ++ks) Sb[ks] = pack_cc(Sacc[2 * ks], Sacc[2 * ks + 1]);
        f32x4 KS[4], QS[4];
#pragma unroll
        for (int ct = 0; ct < 4; ++ct) { KS[ct] = (f32x4){0.f, 0.f, 0.f, 0.f}; QS[ct] = (f32x4){0.f, 0.f, 0.f, 0.f};
#pragma unroll
            for (int ks = 0; ks < 4; ++ks) {
                const LAS unsigned char* ka = lds + SC_K + rdA + ct * 16 * SC_P1 + ks * 64; const LAS unsigned char* qa = lds + SC_Q + rdA + ct * 16 * SC_P1 + ks * 64;
                const bf16x8 kfr = cat4(*(const LAS s16x4*)ka, *(const LAS s16x4*)(ka + 32)); const bf16x8 qfr = cat4(*(const LAS s16x4*)qa, *(const LAS s16x4*)(qa + 32));
                KS[ct] = mfma16(kfr, Sb[ks], KS[ct]); QS[ct] = mfma16(qfr, Sb[ks], QS[ct]); } }
        s16x4 vv[4];
#pragma unroll
        for (int ct = 0; ct < 4; ++ct) TRRD(vv[ct], trV, ct * 16 * SC_P1);
        f32x4 gcv[4], btv[4];
#pragma unroll
        for (int ct = 0; ct < 4; ++ct) { gcv[ct] = *(const LAS f32x4*)(lds + SC_GB + (16 * ct + 4 * g) * 4); btv[ct] = *(const LAS f32x4*)(lds + SC_GB + 256 + (16 * ct + 4 * g) * 4); }
        const float gl = ((const LAS float*)(lds + SC_GB))[63];
        asm volatile("s_waitcnt lgkmcnt(0)" : "+v"(vv[0]), "+v"(vv[1]), "+v"(vv[2]), "+v"(vv[3]) :: "memory");
        f32x4 eg[4], tmp[4];
#pragma unroll
        for (int ct = 0; ct < 4; ++ct)
#pragma unroll
            for (int r = 0; r < 4; ++r) { eg[ct][r] = __expf(gcv[ct][r]); tmp[ct][r] = btv[ct][r] * (bf2f((unsigned short)vv[ct][r]) - eg[ct][r] * KS[ct][r]); }
        bf16x8 tb[2]; tb[0] = pack_cc(tmp[0], tmp[1]); tb[1] = pack_cc(tmp[2], tmp[3]);
        f32x4 vn[4];
#pragma unroll
        for (int ct = 0; ct < 4; ++ct) { vn[ct] = (f32x4){0.f, 0.f, 0.f, 0.f};
#pragma unroll
            for (int k2 = 0; k2 < 2; ++k2) { const LAS unsigned char* ta = lds + SC_T + rdT + ct * 16 * SC_P2 + k2 * 64;
                vn[ct] = mfma16(cat4(*(const LAS s16x4*)ta, *(const LAS s16x4*)(ta + 32)), tb[k2], vn[ct]); } }
        bf16x8 vb[2]; vb[0] = pack_cc(vn[0], vn[1]); vb[1] = pack_cc(vn[2], vn[3]);
        f32x4 o[4];
#pragma unroll
        for (int ct = 0; ct < 4; ++ct) { o[ct] = QS[ct] * eg[ct];
#pragma unroll
            for (int k2 = 0; k2 < 2; ++k2) { const LAS unsigned char* aa = lds + SC_A + rdT + ct * 16 * SC_P2 + k2 * 64;
                o[ct] = mfma16(cat4(*(const LAS s16x4*)aa, *(const LAS s16x4*)(aa + 32)), vb[k2], o[ct]); } }
        f32x4 vd[4];
#pragma unroll
        for (int ct = 0; ct < 4; ++ct)
#pragma unroll
            for (int r = 0; r < 4; ++r) vd[ct][r] = vn[ct][r] * __expf(gl - gcv[ct][r]);
        bf16x8 vdb[2]; vdb[0] = pack_cc(vd[0], vd[1]); vdb[1] = pack_cc(vd[2], vd[3]);
        const float gt = __expf(gl);
#pragma unroll
        for (int dt = 0; dt < 8; ++dt) {
            s16x4 a0, a1, a2, a3;
            TRRD(a0, trK, dt * 32); TRRD(a1, trK, dt * 32 + 16 * SC_P1); TRRD(a2, trK, dt * 32 + 32 * SC_P1); TRRD(a3, trK, dt * 32 + 48 * SC_P1);
            asm volatile("s_waitcnt lgkmcnt(0)" : "+v"(a0), "+v"(a1), "+v"(a2), "+v"(a3) :: "memory");
            Sacc[dt] = Sacc[dt] * gt;
            Sacc[dt] = mfma16(cat4(a0, a1), vdb[0], Sacc[dt]);
            Sacc[dt] = mfma16(cat4(a2, a3), vdb[1], Sacc[dt]);
        }
        __syncthreads();
        if (n + 1 < NCH) SC_WRITE();
#pragma unroll
        for (int ct = 0; ct < 4; ++ct)
#pragma unroll
            for (int r = 0; r < 4; ++r) *(LAS bf16*)(lds + SC_O + (16 * ct + 4 * g + r) * SC_P1 + (16 * w + i16) * 2) = (bf16)f2bf(o[ct][r]);
        __syncthreads();
    }
    SC_OUT(NCH - 1);
    __syncthreads();
#undef SC_LOAD
#undef SC_WRITE
#undef SC_OUT
#undef SC_LOADZ
}
__device__ __forceinline__ void phase_gdn_scan(const Params& p, LAS unsigned char* lds) {
    if (blockIdx.x >= NB * NH) return;
    gdn_scan_bh(p, lds, (int)blockIdx.x);
}

__device__ __forceinline__ void finalize_oa(const Params& p) {
    const int tid = ltid(), lane = tid & 63, wave = tid >> 6;
    const int gw = blockIdx.x * NWAVES + wave, NGW = gridDim.x * NWAVES;
    GAS unsigned char* ws = (GAS unsigned char*)p.ws;
    const GAS float* nwp = (const GAS float*)p.gdn_norm_w + (size_t)p.layer * HD + (lane & 15) * 8;
    const f32x4 n0 = *(const GAS f32x4*)nwp, n1 = *(const GAS f32x4*)(nwp + 4);
    for (int m = gw; m < M; m += NGW) {
#pragma unroll
        for (int hf = 0; hf < 2; ++hf) {
            const size_t off = ((size_t)m * 1024 + hf * 512 + lane * 8) * 2;
            const u32x4 ov = *(const GAS u32x4*)(ws + WS_OA + off), zv = *(const GAS u32x4*)(ws + WS_ZB + off);
            float o[8] = {bflo(ov.x), bfhi(ov.x), bflo(ov.y), bfhi(ov.y), bflo(ov.z), bfhi(ov.z), bflo(ov.w), bfhi(ov.w)};
            const float z[8] = {bflo(zv.x), bfhi(zv.x), bflo(zv.y), bfhi(zv.y), bflo(zv.z), bfhi(zv.z), bflo(zv.w), bfhi(zv.w)};
            float ss = 0.f;
#pragma unroll
            for (int e = 0; e < 8; ++e) ss += o[e] * o[e];
            ss = row16_sum(ss);
            const float rs = __builtin_amdgcn_rsqf(ss * (1.0f / HD) + RMS_EPS);
            const float nv[8] = {n0.x, n0.y, n0.z, n0.w, n1.x, n1.y, n1.z, n1.w};
#pragma unroll
            for (int e = 0; e < 8; ++e) o[e] = o[e] * rs * nv[e] * z[e];
            u32x4 r; r.x = pk2(o[0], o[1]); r.y = pk2(o[2], o[3]); r.z = pk2(o[4], o[5]); r.w = pk2(o[6], o[7]);
            *(GAS u32x4*)(ws + WS_OA + off) = r;
        }
    }
}

constexpr int IX_CAPW = 128;
constexpr int IX_POS = 65536;
constexpr int IX_MT = 98304;
constexpr int IX_META = 131072;
constexpr int IXM_SEGC = 0, IXM_CHI = 128, IXM_LO = 256, IXM_HI = 272, IXM_TAU = 288, IXM_FAIL = 304, IXM_PREF = 320, IXM_KREM = 336;
typedef _Float16 h2_t __attribute__((ext_vector_type(2)));
__device__ __forceinline__ float relu_i(float x) { const int b = __builtin_bit_cast(int, x); return __builtin_bit_cast(float, b > 0 ? b : 0); }
__device__ __forceinline__ unsigned fkey(float s) { const unsigned u = __builtin_bit_cast(unsigned, s); return u ^ ((u >> 31) ? 0xFFFFFFFFu : 0x80000000u); }

constexpr int IX_HIST = IX_META + 4096;
__device__ __forceinline__ unsigned wave_incl_scan(unsigned v) {
    v += (unsigned)__builtin_amdgcn_update_dpp(0, (int)v, 0x111, 0xf, 0xf, false);
    v += (unsigned)__builtin_amdgcn_update_dpp(0, (int)v, 0x112, 0xf, 0xf, false);
    v += (unsigned)__builtin_amdgcn_update_dpp(0, (int)v, 0x114, 0xf, 0xf, false);
    v += (unsigned)__builtin_amdgcn_update_dpp(0, (int)v, 0x118, 0xf, 0xf, false);
    v += (unsigned)__builtin_amdgcn_update_dpp(0, (int)v, 0x142, 0xa, 0xf, false);
    v += (unsigned)__builtin_amdgcn_update_dpp(0, (int)v, 0x143, 0xc, 0xf, false);
    return v;
}
struct IxKeys { unsigned n[8]; unsigned e[8][2]; };
__device__ __forceinline__ void ix_load_keys(IxKeys& K, const LAS unsigned* list, const LAS unsigned* segc, int q, int lane) {
#pragma unroll
    for (int s = 0; s < 8; ++s) { const unsigned c = (unsigned)__builtin_amdgcn_readfirstlane((int)segc[q * 8 + s]); K.n[s] = c < (unsigned)IX_CAPW ? c : (unsigned)IX_CAPW; }
#pragma unroll
    for (int s = 0; s < 8; ++s) { K.e[s][0] = list[(q * 8 + s) * IX_CAPW + lane]; K.e[s][1] = list[(q * 8 + s) * IX_CAPW + 64 + lane]; }
}
__device__ __forceinline__ unsigned ix_round(const IxKeys& K, LAS unsigned* hist, unsigned prefix, int shift, bool first, unsigned& k, int lane) {
    *(LAS u32x4*)(hist + 4 * lane) = zero4_();
    const unsigned dumpw = 256u + (unsigned)lane;
#pragma unroll
    for (int s = 0; s < 8; ++s) {
#pragma unroll
        for (int r = 0; r < 2; ++r) { const unsigned e = K.e[s][r]; const bool ok = ((unsigned)(r * 64 + lane) < K.n[s]) && (first || ((e >> (shift + 8)) == (prefix >> (shift + 8))));
            __hip_atomic_fetch_add(hist + (ok ? ((e >> shift) & 255u) : dumpw), 1u, __ATOMIC_RELAXED, __HIP_MEMORY_SCOPE_WORKGROUP); }
    }
    LDS_WAIT(); __builtin_amdgcn_wave_barrier(); asm volatile("" ::: "memory");
    const u32x4 c4 = *(const LAS u32x4*)(hist + 4 * lane);
    const unsigned tot = c4.x + c4.y + c4.z + c4.w;
    const unsigned pre = wave_incl_scan(tot);
    const unsigned all = (unsigned)__builtin_amdgcn_readlane((int)pre, 63);
    const unsigned suf = all - pre + tot;
    const unsigned long long bal = __ballot(suf >= k);
    const int L = bal ? (63 - __builtin_clzll(bal)) : 0;
    unsigned d = 0u, nk = k;
    { unsigned run = suf - tot;
      if (run + c4.w >= k) { d = 3u; nk = k - run; } else { run += c4.w;
      if (run + c4.z >= k) { d = 2u; nk = k - run; } else { run += c4.z;
      if (run + c4.y >= k) { d = 1u; nk = k - run; } else { run += c4.y; d = 0u; nk = k - run; } } } }
    d = (unsigned)__builtin_amdgcn_readlane((int)d, L); k = (unsigned)__builtin_amdgcn_readlane((int)nk, L);
    __builtin_amdgcn_wave_barrier(); asm volatile("" ::: "memory");
    return (unsigned)(4 * L) + d;
}

template <int MODE>
__device__ __forceinline__ void ix_pass(const GAS _Float16* KIb, GAS unsigned* MASKg, LAS unsigned* lst, LAS unsigned* meta, const f16x8 (&af)[4][4], const unsigned (&wv)[4][2][4],
                                        int t0, int ntiles, int w_in, int lane_in) {
    int lane = lane_in; asm volatile("" : "+v"(lane));
    int w = w_in; asm volatile("" : "+s"(w));
    const int c32 = lane & 31, hh = lane >> 5;
    const unsigned ltm = (1u << c32) - 1u;
    const unsigned dump = (unsigned)((IX_META + 2048) / 4 + w * 64 + lane);
    const unsigned dumpp = (unsigned)((IX_META + 2048 - IX_POS) / 2 + w * 64 + lane);
    unsigned thr_a[4][2], thr_b[4][2];
#pragma unroll
    for (int T4 = 0; T4 < 4; ++T4)
#pragma unroll
        for (int qs = 0; qs < 2; ++qs) { const int ql = 4 * T4 + 2 * hh + qs;
            thr_a[T4][qs] = (MODE == 1) ? meta[IXM_LO + ql] : (MODE == 2) ? meta[IXM_TAU + ql] : (MODE >= 4) ? meta[IXM_PREF + ql] : 0u;
            thr_b[T4][qs] = (MODE == 1) ? meta[IXM_HI + ql] : 0u; }
    unsigned cntA[8], cntB[8], chiA[8], chiB[8];
#pragma unroll
    for (int i = 0; i < 8; ++i) { cntA[i] = 0u; cntB[i] = 0u; chiA[i] = 0u; chiB[i] = 0u; }
    const int kstep = (MODE == 0) ? 64 : 8, kfirst = (MODE == 0) ? (8 * w + 3) : w;
    f16x8 bnx[4];
    if (kfirst < ntiles) {
#pragma unroll
        for (int s = 0; s < 4; ++s) bnx[s] = *(const GAS f16x8*)(KIb + (size_t)(kfirst * 32 + c32) * 64 + 16 * s + 8 * hh);
    }
    for (int kt = kfirst; kt < ntiles; kt += kstep) {
        const int key = kt * 32 + c32;
        f16x8 bfr[4];
#pragma unroll
        for (int s = 0; s < 4; ++s) bfr[s] = bnx[s];
        if (kt + kstep < ntiles) {
#pragma unroll
            for (int s = 0; s < 4; ++s) bnx[s] = *(const GAS f16x8*)(KIb + (size_t)((kt + kstep) * 32 + c32) * 64 + 16 * s + 8 * hh);
        }
        unsigned mwv = 0u;
#pragma unroll
        for (int T4 = 0; T4 < 4; ++T4) {
            f32x16 acc = {};
#pragma unroll
            for (int s = 0; s < 4; ++s) acc = __builtin_amdgcn_mfma_f32_32x32x16_f16(af[T4][s], bfr[s], acc, 0, 0, 0);
#pragma unroll
            for (int qs = 0; qs < 2; ++qs) {
                float sc = 0.f;
#pragma unroll
                for (int h = 0; h < 4; ++h) {
                    const float r0 = relu_i(acc[8 * qs + 2 * h]), r1 = relu_i(acc[8 * qs + 2 * h + 1]);
                    asm volatile("v_fma_mix_f32 %0, %1, %2, %0 op_sel:[0,0,0] op_sel_hi:[1,0,0]" : "+v"(sc) : "v"(wv[T4][qs][h]), "v"(r0));
                    asm volatile("v_fma_mix_f32 %0, %1, %2, %0 op_sel:[1,0,0] op_sel_hi:[1,0,0]" : "+v"(sc) : "v"(wv[T4][qs][h]), "v"(r1)); }
                const int ql = 4 * T4 + 2 * hh + qs, idx = 2 * T4 + qs;
                const bool valid = key <= t0 + ql;
                const unsigned uk = fkey(sc);
                if constexpr (MODE == 0 || MODE == 1) {
                    bool pred = valid;
                    if constexpr (MODE == 1) {
                        const bool ge = valid && (uk >= thr_b[T4][qs]);
                        const unsigned long long bg = __ballot(ge);
                        mwv = (lane == 4 * T4 + qs) ? (unsigned)bg : mwv; mwv = (lane == 4 * T4 + 2 + qs) ? (unsigned)(bg >> 32) : mwv;
                        chiA[idx] = (unsigned)__builtin_amdgcn_readfirstlane((int)(chiA[idx] + (unsigned)__builtin_popcount((unsigned)bg))); chiB[idx] = (unsigned)__builtin_amdgcn_readfirstlane((int)(chiB[idx] + (unsigned)__builtin_popcount((unsigned)(bg >> 32))));
                        pred = valid && !ge && (uk >= thr_a[T4][qs]);
                    }
                    const unsigned long long bal = __ballot(pred);
                    const unsigned blo = (unsigned)bal, bhi = (unsigned)(bal >> 32);
                    const unsigned slot = (hh ? cntB[idx] : cntA[idx]) + (unsigned)__builtin_popcount((hh ? bhi : blo) & ltm);
                    const bool okw = pred && slot < (unsigned)IX_CAPW;
                    const unsigned addr = okw ? (unsigned)((ql * 8 + w) * IX_CAPW) + slot : dump;
                    lst[addr] = uk;
                    if constexpr (MODE == 1) ((LAS unsigned short*)((LAS unsigned char*)lst + IX_POS))[okw ? addr : dumpp] = (unsigned short)key;
                    cntA[idx] = (unsigned)__builtin_amdgcn_readfirstlane((int)(cntA[idx] + (unsigned)__builtin_popcount(blo))); cntB[idx] = (unsigned)__builtin_amdgcn_readfirstlane((int)(cntB[idx] + (unsigned)__builtin_popcount(bhi)));
                } else if constexpr (MODE == 2) {
                    const bool sel = valid && (uk >= thr_a[T4][qs]);
                    const unsigned long long bal = __ballot(sel);
                    mwv = (lane == 4 * T4 + qs) ? (unsigned)bal : mwv; mwv = (lane == 4 * T4 + 2 + qs) ? (unsigned)(bal >> 32) : mwv;
                } else if constexpr (MODE == 3) { if (valid) __hip_atomic_fetch_add(&lst[ql * 2048 + (uk >> 21)], 1u, __ATOMIC_RELAXED, __HIP_MEMORY_SCOPE_WORKGROUP); }
                else if constexpr (MODE == 4) { if (valid && (uk >> 21) == thr_a[T4][qs]) __hip_atomic_fetch_add(&lst[ql * 2048 + ((uk >> 10) & 2047u)], 1u, __ATOMIC_RELAXED, __HIP_MEMORY_SCOPE_WORKGROUP); }
                else { if (valid && (uk >> 10) == thr_a[T4][qs]) __hip_atomic_fetch_add(&lst[ql * 2048 + (uk & 1023u)], 1u, __ATOMIC_RELAXED, __HIP_MEMORY_SCOPE_WORKGROUP); }
            }
        }
        if constexpr (MODE == 1 || MODE == 2) { if (lane < 16) ((LAS unsigned*)((LAS unsigned char*)lst + IX_MT))[lane * 256 + kt] = mwv; }
    }
    if constexpr (MODE == 0 || MODE == 1) {
        if (lane == 0) {
#pragma unroll
            for (int T4 = 0; T4 < 4; ++T4)
#pragma unroll
                for (int qs = 0; qs < 2; ++qs) { const int idx = 2 * T4 + qs, qa = 4 * T4 + qs, qb = qa + 2;
                    meta[IXM_SEGC + qa * 8 + w] = cntA[idx]; meta[IXM_SEGC + qb * 8 + w] = cntB[idx];
                    if constexpr (MODE == 1) { meta[IXM_CHI + qa * 8 + w] = chiA[idx]; meta[IXM_CHI + qb * 8 + w] = chiB[idx]; } }
        }
    }
}

__device__ __forceinline__ void phase_indexer(const Params& p, LAS unsigned char* lds) {
    const int tid = ltid(), lane0 = tid & 63, w = __builtin_amdgcn_readfirstlane(tid >> 6);
    GAS unsigned char* ws = (GAS unsigned char*)p.ws;
    const GAS _Float16* QI = (const GAS _Float16*)(ws + WS_QI);
    const GAS _Float16* KI = (const GAS _Float16*)(ws + WS_KI);
    const GAS float* SM = (const GAS float*)(ws + WS_SM);
    GAS unsigned* MASK = (GAS unsigned*)(ws + WS_MASK);
    LAS unsigned* lst = (LAS unsigned*)lds;
    LAS unsigned* meta = (LAS unsigned*)(lds + IX_META);
    LAS unsigned* hist = (LAS unsigned*)(lds + IX_HIST) + w * 320;
    const int G = gridDim.x, bid = blockIdx.x;
    constexpr int NGRP = NB * SEQ / 16;
    for (int it = 0;; ++it) {
        const int pos = it * G + ((it & 1) ? (G - 1 - bid) : bid);
        if (pos >= NGRP) break;
        int lane = lane0; asm volatile("" : "+v"(lane));
        const int c32 = lane & 31, hh = lane >> 5;
        const int tq = pos >> 2, b = pos & 3, t0 = tq * 16;
        const size_t rowbase = (size_t)b * SEQ + t0;
        f16x8 af[4][4]; unsigned wv[4][2][4];
        { const int a = c32 >> 3, bb = (c32 >> 2) & 1, c = c32 & 3, hd = c + 4 * (a & 1), qsub = a >> 1;
#pragma unroll
          for (int T4 = 0; T4 < 4; ++T4) { const int ql = 4 * T4 + 2 * bb + qsub;
#pragma unroll
              for (int s = 0; s < 4; ++s) af[T4][s] = *(const GAS f16x8*)(QI + (rowbase + ql) * 512 + hd * 64 + 16 * s + 8 * hh); }
#pragma unroll
          for (int T4 = 0; T4 < 4; ++T4)
#pragma unroll
              for (int qs = 0; qs < 2; ++qs) { const GAS float* wp = SM + (rowbase + 4 * T4 + 2 * hh + qs) * 32;
                  const f32x4 w0 = *(const GAS f32x4*)wp, w1 = *(const GAS f32x4*)(wp + 4);
                  wv[T4][qs][0] = __builtin_bit_cast(unsigned, (h2_t){(_Float16)w0.x, (_Float16)w0.y}); wv[T4][qs][1] = __builtin_bit_cast(unsigned, (h2_t){(_Float16)w0.z, (_Float16)w0.w});
                  wv[T4][qs][2] = __builtin_bit_cast(unsigned, (h2_t){(_Float16)w1.x, (_Float16)w1.y}); wv[T4][qs][3] = __builtin_bit_cast(unsigned, (h2_t){(_Float16)w1.z, (_Float16)w1.w}); } }
        const int ntiles = (t0 + 15) / 32 + 1;
        const GAS _Float16* KIb = KI + (size_t)b * SEQ * 64;
        GAS unsigned* MASKg = MASK + rowbase * 256;
        const bool small = (t0 + 16 <= 8 * IX_CAPW);
        if (tid < 16) { meta[IXM_LO + tid] = 0u; meta[IXM_HI + tid] = 0xFFFFFFFFu; meta[IXM_TAU + tid] = 0u; }
        if (tid == 0) meta[IXM_FAIL] = 0u;
#pragma unroll
        for (int i = 0; i < 2; ++i) *(LAS u32x4*)(lds + IX_MT + (size_t)(i * NTHR + tid) * 16) = zero4_();
        __syncthreads();
        if (!small) {
            ix_pass<0>(KIb, MASKg, lst, meta, af, wv, t0, ntiles, w, lane);
            __syncthreads();
#pragma unroll 1
            for (int qq = 0; qq < 2; ++qq) { const int q = 2 * w + qq;
                unsigned ns = 0u;
                for (int s = 0; s < 8; ++s) ns += meta[IXM_SEGC + q * 8 + s];
                ns = (unsigned)__builtin_amdgcn_readfirstlane((int)ns);
                unsigned lo = 0u, hi = 0xFFFFFFFFu;
                if (ns >= 72u) { IxKeys K; ix_load_keys(K, lst, meta + IXM_SEGC, q, lane);
                    unsigned k1 = 72u; const unsigned d1 = ix_round(K, hist, 0u, 24, true, k1, lane); const unsigned d2 = ix_round(K, hist, d1 << 24, 16, false, k1, lane); lo = (d1 << 24) | (d2 << 16);
                    unsigned k2 = 12u; const unsigned g1 = ix_round(K, hist, 0u, 24, true, k2, lane); const unsigned g2 = ix_round(K, hist, g1 << 24, 16, false, k2, lane); const unsigned ph = (g1 << 24) | (g2 << 16);
                    hi = (ph >= 0xFFFF0000u) ? 0xFFFFFFFFu : ph + 0x10000u; }
                if (lane == 0) { meta[IXM_LO + q] = lo; meta[IXM_HI + q] = hi; } }
            __syncthreads();
        }
        ix_pass<1>(KIb, MASKg, lst, meta, af, wv, t0, ntiles, w, lane);
        __syncthreads();
#pragma unroll 1
        for (int qq = 0; qq < 2; ++qq) { const int q = 2 * w + qq;
            const bool allsel = (t0 + q + 1 <= 256);
            unsigned n = 0u, chi = 0u, over = 0u;
            for (int s = 0; s < 8; ++s) { const unsigned c = meta[IXM_SEGC + q * 8 + s]; n += c; over |= (c > (unsigned)IX_CAPW) ? 1u : 0u; chi += meta[IXM_CHI + q * 8 + s]; }
            n = (unsigned)__builtin_amdgcn_readfirstlane((int)n); chi = (unsigned)__builtin_amdgcn_readfirstlane((int)chi); over = (unsigned)__builtin_amdgcn_readfirstlane((int)over);
            if (!allsel && (over || chi >= 256u || chi + n < 256u)) { if (lane == 0) meta[IXM_FAIL] = 1u; continue; }
            const unsigned lo_ = (unsigned)__builtin_amdgcn_readfirstlane((int)meta[IXM_LO + q]), hi_ = (unsigned)__builtin_amdgcn_readfirstlane((int)meta[IXM_HI + q]);
            const unsigned df = lo_ ^ (hi_ - 1u);
            const int sh0 = (df >> 24) ? 24 : ((df >> 16) ? 16 : ((df >> 8) ? 8 : 0));
            unsigned tau = (sh0 == 24) ? 0u : (lo_ & (0xFFFFFFFFu << (sh0 + 8)));
            unsigned kk = 256u - chi;
            { IxKeys K; ix_load_keys(K, lst, meta + IXM_SEGC, q, lane);
              if (allsel) tau = 0u; else { for (int sh = sh0; sh >= 0; sh -= 8) tau |= ix_round(K, hist, tau, sh, sh == 24, kk, lane) << sh; }
              LAS unsigned* mt = (LAS unsigned*)(lds + IX_MT) + q * 256; const LAS unsigned short* pl = (const LAS unsigned short*)(lds + IX_POS);
#pragma unroll
              for (int s = 0; s < 8; ++s)
#pragma unroll
                  for (int r = 0; r < 2; ++r) { const bool on = ((unsigned)(r * 64 + lane) < K.n[s]) && (K.e[s][r] >= tau);
                      const unsigned ps = pl[(q * 8 + s) * IX_CAPW + r * 64 + lane];
                      if (on) __hip_atomic_fetch_or(mt + (ps >> 5), 1u << (ps & 31u), __ATOMIC_RELAXED, __HIP_MEMORY_SCOPE_WORKGROUP); } }
            if (lane == 0) meta[IXM_TAU + q] = tau; }
        __syncthreads();
        if (meta[IXM_FAIL] != 0u) {
            __syncthreads();
            if (tid < 16) { meta[IXM_PREF + tid] = 0u; meta[IXM_KREM + tid] = 256u; }
#pragma unroll 1
            for (int pass = 0; pass < 3; ++pass) {
#pragma unroll
                for (int i = 0; i < 16; ++i) *(LAS u32x4*)(lds + (size_t)(i * NTHR + tid) * 16) = zero4_();
                __syncthreads();
                if (pass == 0) ix_pass<3>(KIb, MASKg, lst, meta, af, wv, t0, ntiles, w, lane);
                else if (pass == 1) ix_pass<4>(KIb, MASKg, lst, meta, af, wv, t0, ntiles, w, lane);
                else ix_pass<5>(KIb, MASKg, lst, meta, af, wv, t0, ntiles, w, lane);
                __syncthreads();
#pragma unroll 1
                for (int qq = 0; qq < 2; ++qq) {
                    const int q = 2 * w + qq;
                    if (t0 + q + 1 <= 256) { if (lane == 0 && pass == 2) meta[IXM_TAU + q] = 0u; continue; }
                    const int per = (pass == 2) ? 16 : 32, base = lane * per;
                    unsigned cnt = 0;
                    for (int i = 0; i < per; ++i) cnt += lst[q * 2048 + base + i];
                    unsigned suf = cnt;
#pragma unroll
                    for (int o = 1; o < 64; o <<= 1) { const unsigned t = __shfl_down(suf, o); if (lane + o < 64) suf += t; }
                    const unsigned kr = meta[IXM_KREM + q];
                    const unsigned long long bal = __ballot(suf >= kr);
                    const int L = bal ? (63 - __builtin_clzll(bal)) : 0;
                    unsigned binv = 0, nkr = kr;
                    if (lane == L) { unsigned run = suf - cnt;
                        for (int i = per - 1; i >= 0; --i) { const unsigned c = lst[q * 2048 + base + i]; if (run + c >= kr) { binv = (unsigned)(base + i); nkr = kr - run; break; } run += c; } }
                    binv = __shfl(binv, L); nkr = __shfl(nkr, L);
                    if (lane == 0) { const unsigned pr = meta[IXM_PREF + q];
                        const unsigned npr = (pass == 0) ? binv : ((pass == 1) ? ((pr << 11) | binv) : ((pr << 10) | binv));
                        meta[IXM_PREF + q] = npr; meta[IXM_KREM + q] = nkr; if (pass == 2) meta[IXM_TAU + q] = npr; }
                }
                __syncthreads();
            }
#pragma unroll
            for (int i = 0; i < 2; ++i) *(LAS u32x4*)(lds + IX_MT + (size_t)(i * NTHR + tid) * 16) = zero4_();
            __syncthreads();
            ix_pass<2>(KIb, MASKg, lst, meta, af, wv, t0, ntiles, w, lane);
            __syncthreads();
        }
        { const int last = ((t0 >> 8) << 3) + 7; const int row = tid >> 5, c4 = (tid & 31) * 4;
#pragma unroll
          for (int i = 0; i < 2; ++i) { const int cw = c4 + 128 * i; if (cw <= last) *(GAS u32x4*)(MASKg + (size_t)row * 256 + cw) = *(const LAS u32x4*)(lds + IX_MT + (row * 256 + cw) * 4); } }
        __syncthreads();
    }
}

namespace at {
constexpr float SCALE = 0.08838834764831845f;
constexpr int D = 128, PITCH = 1024;
constexpr int NW = 8, QBLK = 32, KVBLK = 64, QB = NW * QBLK;
constexpr int SHM_V = KVBLK * D * 2, SHM_K = KVBLK * D * 2;
constexpr int OFF_WS = 2 * SHM_V + 2 * SHM_K;
constexpr int OFF_BLUT = OFF_WS + NW * 64 * 4;
constexpr int LDS_NEED = OFF_BLUT + 8 * 132 * 4;
constexpr float THR = 8.f;

#define KSWZ(row, colB) ((row) * 256 + ((colB) ^ (((row) & 7) << 4)))
#define SBAR() __builtin_amdgcn_sched_barrier(0)
__device__ __forceinline__ int v_st(int k, int c) { const int kk = (k & ~0xC) | ((k & 4) << 1) | ((k & 8) >> 1); return ((kk >> 3) * 4 + (c >> 5)) * 512 + ((kk & 7) * 32 + (c & 31)) * 2; }
__device__ __forceinline__ int v_rd_base(int lane) { return ((lane & 3) << 3) | (((lane >> 2) & 3) << 6) | (((lane >> 4) & 1) << 5) | (((lane >> 5) & 1) << 8); }
constexpr int v_rd_off(int d0, int ks, int half) { return d0 * 512 + ks * 4096 + half * 2048; }
__device__ __forceinline__ int crow(int r, int hi) { return (r & 3) + 8 * (r >> 2) + 4 * hi; }
__device__ __forceinline__ bf16x8 load8(const GAS bf16* p) { return *(const GAS bf16x8*)p; }

__device__ __forceinline__ void mask_tile(f32x16& p0, f32x16& p1, int dq) {
    const float NEG = -__builtin_inff();
#pragma unroll
    for (int r = 0; r < 16; ++r) {
        const int c = (r & 3) + 8 * (r >> 2);
        if (dq - c < 0) p0[r] = NEG;
        if (dq - c - 32 < 0) p1[r] = NEG;
    }
}
__device__ __forceinline__ void bias_tile(f32x16& p0, f32x16& p1, int dq, const float* bl) {
#pragma unroll
    for (int r = 0; r < 16; ++r) {
        const int c = (r & 3) + 8 * (r >> 2);
        int d0 = dq - c, d1 = dq - c - 32;
        d0 = d0 < 0 ? 0 : (d0 > 128 ? 128 : d0); d1 = d1 < 0 ? 0 : (d1 > 128 ? 128 : d1);
        p0[r] += bl[d0]; p1[r] += bl[d1];
    }
}
__device__ __forceinline__ void partialSM(f32x16& p0, f32x16& p1, float& m_reg, float& mn, float& alpha, float cb, unsigned mlo) {
    float pmax = p0[0];
#pragma unroll
    for (int r = 1; r < 16; ++r) pmax = fmaxf(pmax, p0[r]);
#pragma unroll
    for (int r = 0; r < 16; ++r) pmax = fmaxf(pmax, p1[r]);
    { auto rr = __builtin_amdgcn_permlane32_swap(__float_as_uint(pmax), __float_as_uint(pmax), false, false);
      pmax = fmaxf(__uint_as_float(rr[0]), __uint_as_float(rr[1])); }
    pmax += cb;
    constexpr float C2 = 1.4426950408889634f * SCALE;
    if (__builtin_expect(__all((pmax - m_reg) * SCALE <= THR), 1)) { mn = m_reg; alpha = 1.f; }
    else { mn = fmaxf(m_reg, pmax); alpha = __builtin_amdgcn_exp2f((m_reg - mn) * C2); m_reg = mn; }
    const float mnL = (cb - mn) * C2;
#pragma unroll
    for (int r = 0; r < 16; ++r) p0[r] = fmaf(p0[r], C2, mnL);
#pragma unroll
    for (int r = 0; r < 16; ++r) p1[r] = fmaf(p1[r], C2, mnL);
#pragma unroll
    for (int r = 0; r < 16; ++r) { const int c = (r & 3) + 8 * (r >> 2);
        int sm_ = __builtin_amdgcn_sbfe((int)mlo, (unsigned)c, 1u); asm volatile("" : "+v"(sm_));
        p0[r] = __uint_as_float(__float_as_uint(__builtin_amdgcn_exp2f(p0[r])) & (unsigned)sm_); }
}
__device__ __forceinline__ void finishSM(f32x16& p0, f32x16& p1, float alpha, float& l_reg, bf16x8& pa0, bf16x8& pa1, bf16x8& pa2, bf16x8& pa3, unsigned mhi) {
#pragma unroll
    for (int r = 0; r < 16; ++r) { const int c = (r & 3) + 8 * (r >> 2);
        int sm_ = __builtin_amdgcn_sbfe((int)mhi, (unsigned)c, 1u); asm volatile("" : "+v"(sm_));
        p1[r] = __uint_as_float(__float_as_uint(__builtin_amdgcn_exp2f(p1[r])) & (unsigned)sm_); }
    float ps = 0;
#pragma unroll
    for (int r = 0; r < 16; ++r) ps += p0[r];
#pragma unroll
    for (int r = 0; r < 16; ++r) ps += p1[r];
    { auto rr = __builtin_amdgcn_permlane32_swap(__float_as_uint(ps), __float_as_uint(ps), false, false);
      ps = __uint_as_float(rr[0]) + __uint_as_float(rr[1]); }
    l_reg = l_reg * alpha + ps;
#define PK4(P, B_, OUT) do { unsigned a0 = pk2(P[B_+0], P[B_+1]), a1 = pk2(P[B_+2], P[B_+3]);                          \
        unsigned b0 = pk2(P[B_+4], P[B_+5]), b1 = pk2(P[B_+6], P[B_+7]);                                             \
        auto r0 = __builtin_amdgcn_permlane32_swap(a0, b0, false, false); auto r1 = __builtin_amdgcn_permlane32_swap(a1, b1, false, false); \
        u32x4 w = {r0[0], r1[0], r0[1], r1[1]}; OUT = *reinterpret_cast<bf16x8*>(&w); } while (0)
    PK4(p0, 0, pa0); PK4(p0, 8, pa1); PK4(p1, 0, pa2); PK4(p1, 8, pa3);
#undef PK4
}
template <int KB>
__device__ __forceinline__ void qkt(f32x16& p0, f32x16& p1, int ka0, const bf16x8* qr) {
#define KRD2(dx, dy, d0) do { int t_; asm volatile("v_xor_b32 %2, %4, %3\n\tds_read_b128 %0, %2 offset:%5\n\tds_read_b128 %1, %2 offset:%6"                       \
        : "=&v"(dx), "=&v"(dy), "=&v"(t_) : "v"(ka0), "i"(((d0) & 3) << 5), "i"(KB * SHM_K + ((d0) >> 2) * 128), "i"(KB * SHM_K + ((d0) >> 2) * 128 + 32 * 256) : "memory"); } while (0)
#define KWAIT(n, x, y) asm volatile("s_waitcnt lgkmcnt(" #n ")" : "+v"(x), "+v"(y) :: "memory")
    bf16x8 a0, a1, b0, b1;
    KRD2(a0, a1, 0); KRD2(b0, b1, 1);
    KWAIT(2, a0, a1);
    p0 = __builtin_amdgcn_mfma_f32_32x32x16_bf16(a0, qr[0], f32x16{}, 0, 0, 0); p1 = __builtin_amdgcn_mfma_f32_32x32x16_bf16(a1, qr[0], f32x16{}, 0, 0, 0);
    KRD2(a0, a1, 2);
    KWAIT(2, b0, b1);
    p0 = __builtin_amdgcn_mfma_f32_32x32x16_bf16(b0, qr[1], p0, 0, 0, 0); p1 = __builtin_amdgcn_mfma_f32_32x32x16_bf16(b1, qr[1], p1, 0, 0, 0);
    KRD2(b0, b1, 3);
#define QK_PAIR(d0, LASTW)                                                                                                        \
    KWAIT(2, a0, a1);                                                                                                            \
    p0 = __builtin_amdgcn_mfma_f32_32x32x16_bf16(a0, qr[d0], p0, 0, 0, 0); p1 = __builtin_amdgcn_mfma_f32_32x32x16_bf16(a1, qr[d0], p1, 0, 0, 0);             \
    if ((d0) + 2 < 8) { KRD2(a0, a1, (d0) + 2); KWAIT(2, b0, b1); } else { KWAIT(0, b0, b1); }                \
    p0 = __builtin_amdgcn_mfma_f32_32x32x16_bf16(b0, qr[(d0) + 1], p0, 0, 0, 0); p1 = __builtin_amdgcn_mfma_f32_32x32x16_bf16(b1, qr[(d0) + 1], p1, 0, 0, 0);   \
    if ((d0) + 3 < 8) { KRD2(b0, b1, (d0) + 3); }
    QK_PAIR(2, 0) QK_PAIR(4, 0) QK_PAIR(6, 1)
#undef QK_PAIR
#undef KRD2
#undef KWAIT
}
template <int VB>
__device__ __forceinline__ void pv_tile(f32x16* o, int vb0, bf16x8 pa0, bf16x8 pa1, bf16x8 pa2, bf16x8 pa3) {
#define TRRDA(dst, off) asm volatile("ds_read_b64_tr_b16 %0, %1 offset:%2" : "=&v"(dst) : "v"(vb0), "i"(off) : "memory")
#define PV_D0(d0) do { s16x4 l0, l1, l2, l3, h0, h1, h2, h3; constexpr int b_ = VB * SHM_V + v_rd_off(d0, 0, 0); \
        TRRDA(l0, b_); TRRDA(h0, b_ + 2048); TRRDA(l1, b_ + 4096); TRRDA(h1, b_ + 6144); TRRDA(l2, b_ + 8192); TRRDA(h2, b_ + 10240); TRRDA(l3, b_ + 12288); TRRDA(h3, b_ + 14336); \
        asm volatile("s_waitcnt lgkmcnt(0)" : "+v"(l0), "+v"(h0), "+v"(l1), "+v"(h1), "+v"(l2), "+v"(h2), "+v"(l3), "+v"(h3) :: "memory"); SBAR();   \
        o[d0] = __builtin_amdgcn_mfma_f32_32x32x16_bf16(pa0, (bf16x8){l0[0], l0[1], l0[2], l0[3], h0[0], h0[1], h0[2], h0[3]}, o[d0], 0, 0, 0);   \
        o[d0] = __builtin_amdgcn_mfma_f32_32x32x16_bf16(pa1, (bf16x8){l1[0], l1[1], l1[2], l1[3], h1[0], h1[1], h1[2], h1[3]}, o[d0], 0, 0, 0);   \
        o[d0] = __builtin_amdgcn_mfma_f32_32x32x16_bf16(pa2, (bf16x8){l2[0], l2[1], l2[2], l2[3], h2[0], h2[1], h2[2], h2[3]}, o[d0], 0, 0, 0);   \
        o[d0] = __builtin_amdgcn_mfma_f32_32x32x16_bf16(pa3, (bf16x8){l3[0], l3[1], l3[2], l3[3], h3[0], h3[1], h3[2], h3[3]}, o[d0], 0, 0, 0); } while (0)
    PV_D0(0); PV_D0(1); PV_D0(2); PV_D0(3);
#undef PV_D0
#undef TRRDA
}

__device__ __forceinline__ int lane_fresh() { int l; asm volatile("v_mbcnt_lo_u32_b32 %0, -1, 0\n\tv_mbcnt_hi_u32_b32 %0, -1, %0" : "=v"(l)); return l; }
struct BlockRef { const GAS bf16* Q; const GAS bf16* K; const GAS bf16* V; GAS bf16* O; const GAS unsigned long long* MW; int P0; int h; };
struct Seam { bf16x8 qr[8]; };
#define VMW() asm volatile("s_waitcnt vmcnt(0)" ::: "memory")
#define DMA16(gp, ldsoff) __builtin_amdgcn_global_load_lds((const GAS unsigned*)(gp), (LAS unsigned*)(ldsw_ + (ldsoff)), 16, 0, 0)
#define KDMA(Kbytes, bf) do { DMA16((Kbytes) + koff0, 2 * SHM_V + (bf) * SHM_K); DMA16((Kbytes) + koff1, 2 * SHM_V + (bf) * SHM_K + 1024); } while (0)
#define VDMA(Vbytes, bf) do { DMA16((Vbytes) + voff0, (bf) * SHM_V); DMA16((Vbytes) + voff1, (bf) * SHM_V + 1024); } while (0)
#define DMA_OFFS()                                                                                                             \
    LAS unsigned char* ldsw_ = (LAS unsigned char*)lds + wid * 2048;                                \
    unsigned koff0, koff1, voff0, voff1;                                                                                       \
    { const int r0 = wid * 8 + (lane >> 4), r1 = r0 + 4, pc = lane & 15;                                                       \
      koff0 = (unsigned)(r0 * PITCH * 2 + ((pc ^ (r0 & 7)) << 4)); koff1 = (unsigned)(r1 * PITCH * 2 + ((pc ^ (r1 & 7)) << 4)); \
      const int kl = (lane & 31) >> 2, c8 = lane & 3;                                                                          \
      const int sub0 = wid * 4 + (lane >> 5), sub1 = sub0 + 2;                                                                 \
      const int kk0 = (sub0 >> 2) * 8 + kl, kk1 = (sub1 >> 2) * 8 + kl;                                                        \
      const int k0_ = (kk0 & ~0xC) | ((kk0 & 4) << 1) | ((kk0 & 8) >> 1), k1_ = (kk1 & ~0xC) | ((kk1 & 4) << 1) | ((kk1 & 8) >> 1); \
      voff0 = (unsigned)(k0_ * PITCH * 2 + ((sub0 & 3) * 32 + c8 * 8) * 2); voff1 = (unsigned)(k1_ * PITCH * 2 + ((sub1 & 3) * 32 + c8 * 8) * 2); }
constexpr unsigned TILE_BYTES = KVBLK * PITCH * 2;
__device__ __forceinline__ void attn_prime(const BlockRef& cur, char* lds, Seam& S) {
    const int tid = ltid(), wid = __builtin_amdgcn_readfirstlane(tid >> 6), lane = tid & 63, r32 = lane & 31, hi = lane >> 5;
    DMA_OFFS();
#pragma unroll
    for (int d0 = 0; d0 < 8; ++d0) S.qr[d0] = load8(cur.Q + (unsigned)((wid * QBLK + r32) * PITCH + d0 * 16 + hi * 8));
    KDMA((const GAS unsigned char*)cur.K, 0); (void)voff0; (void)voff1; VMW();
    __syncthreads();
}
__device__ __forceinline__ void attn_block(const BlockRef& cur, const BlockRef& nxt, char* lds, Seam& S) {
    const int tid = ltid(), wid = __builtin_amdgcn_readfirstlane(tid >> 6), lane = tid & 63, r32 = lane & 31, hi = lane >> 5;
    const int NT = (cur.P0 + QB - 1) / KVBLK + 1;
    const int qlo = cur.P0 + wid * QBLK, qm = qlo + r32 - 4 * hi;
    char* V_lds = lds; char* K_lds = lds + 2 * SHM_V;
    const float* bl = (const float*)(lds + OFF_BLUT) + cur.h * 132;
    const float cb_far = __builtin_bit_cast(float, __builtin_amdgcn_readfirstlane(__builtin_bit_cast(int, bl[128])));
    float m_reg = -1e30f, l_reg = 0; f32x16 o[4] = {};
    DMA_OFFS();
    const int vb0 = (int)(uintptr_t)V_lds + v_rd_base(lane);
    const int ka = (int)(uintptr_t)K_lds + KSWZ(r32, hi * 16);
    const GAS unsigned char* Kh = (const GAS unsigned char*)cur.K; const GAS unsigned char* Vh = (const GAS unsigned char*)cur.V;
    const GAS unsigned char* mbase = (const GAS unsigned char*)cur.MW; const unsigned moff = (unsigned)(qlo + r32) * 1024u;
#define RESC(a) do { if (__any((a) < 1.f)) { const int l_ = lane_fresh(), r_ = l_ & 31, h_ = l_ >> 5; float* al_ = (float*)(lds + OFF_WS) + wid * 64 + 32;   \
                     if (h_ == 0) al_[r_] = (a); asm volatile("s_waitcnt lgkmcnt(0)" ::: "memory");                                     \
                     for (int d_ = 0; d_ < 4; ++d_) for (int r = 0; r < 16; ++r) o[d_][r] *= al_[crow(r, h_)]; } } while (0)
#define KBASE(t) ((t) * KVBLK)
#define PREP(P0_, P1_, t, cbv) do { const int kb_ = KBASE(t);                                                                   \
        if (kb_ > qlo - 191) { bias_tile(P0_, P1_, qm - kb_, bl); cbv = 0.f; } else cbv = cb_far; } while (0)
#define MLOAD(mv, t) do { mv = *(const GAS unsigned long long*)(mbase + moff + (unsigned)(t) * 8u); } while (0)
#define MLO(mv) ((unsigned)(mv) >> (4 * hi))
#define MHI(mv) ((unsigned)((mv) >> 32) >> (4 * hi))
    f32x16 pA0, pA1, pB0, pB1; float mnA, mnB, alA, alB; bf16x8 pa0, pa1, pa2, pa3; unsigned long long mA, mB; float cbA, cbB;
    SBAR(); KDMA(Kh + TILE_BYTES, 1); VDMA(Vh, 0); MLOAD(mA, 0);
    SBAR(); qkt<0>(pA0, pA1, ka, S.qr);
    PREP(pA0, pA1, 0, cbA); partialSM(pA0, pA1, m_reg, mnA, alA, cbA, MLO(mA));
    VMW(); __syncthreads();
#define STEP(PX0, PX1, mnX, alX, mX, cbX, PY0, PY1, alY, mY, t, KB, VB, KSRC) do {                                              \
        SBAR(); KDMA(KSRC, (KB) ^ 1); VDMA(Vh + (unsigned)(t) * TILE_BYTES, (VB) ^ 1); MLOAD(mX, t); SBAR();                    \
        qkt<KB>(PX0, PX1, ka, S.qr); SBAR();                                                                                  \
        finishSM(PY0, PY1, alY, l_reg, pa0, pa1, pa2, pa3, MHI(mY)); SBAR();                                                   \
        pv_tile<VB>(o, vb0, pa0, pa1, pa2, pa3); SBAR();                                                                      \
        PREP(PX0, PX1, (t), cbX); partialSM(PX0, PX1, m_reg, mnX, alX, cbX, MLO(mX)); SBAR();                                  \
        RESC(alX); VMW(); __syncthreads(); } while (0)
    for (int t = 1; t + 1 < NT; t += 2) {
        STEP(pB0, pB1, mnB, alB, mB, cbB, pA0, pA1, alA, mA, t, 1, 0, Kh + (unsigned)(t + 1) * TILE_BYTES);
        STEP(pA0, pA1, mnA, alA, mA, cbA, pB0, pB1, alB, mB, t + 1, 0, 1, Kh + (unsigned)(t + 2) * TILE_BYTES);
    }
    STEP(pB0, pB1, mnB, alB, mB, cbB, pA0, pA1, alA, mA, NT - 1, 1, 0, (const GAS unsigned char*)nxt.K);
    finishSM(pB0, pB1, alB, l_reg, pa0, pa1, pa2, pa3, MHI(mB)); SBAR();
    { const int l_ = lane_fresh(), r_ = l_ & 31, h_ = l_ >> 5;
#pragma unroll
      for (int d0 = 0; d0 < 8; ++d0) S.qr[d0] = load8(nxt.Q + (unsigned)((wid * QBLK + r_) * PITCH + d0 * 16 + h_ * 8)); }
    SBAR(); pv_tile<1>(o, vb0, pa0, pa1, pa2, pa3);
    SBAR();
    { const int l_ = lane_fresh(), r_ = l_ & 31, h_ = l_ >> 5; float* li_ = (float*)(lds + OFF_WS) + wid * 64;
      if (h_ == 0) li_[r_] = l_reg; asm volatile("s_waitcnt lgkmcnt(0)" ::: "memory");
      float rli[16];
#pragma unroll
      for (int r = 0; r < 16; ++r) rli[r] = __builtin_amdgcn_rcpf(li_[crow(r, h_)]);
      GAS bf16* Ow = cur.O + (unsigned)((wid * QBLK) * PITCH);
#pragma unroll
      for (int r = 0; r < 16; ++r) { const int orow = crow(r, h_);
#pragma unroll
        for (int d0 = 0; d0 < 4; ++d0) { const float v = o[d0][r] * rli[r];
            const float vn = __shfl_xor(v, 1);
            if ((r_ & 1) == 0) *(GAS unsigned*)(Ow + (unsigned)(orow * PITCH + d0 * 32 + r_)) = pk2(v, vn); } } }
#undef RESC
#undef KBASE
#undef PREP
#undef MLOAD
#undef MLO
#undef MHI
#undef STEP
}
#undef VMW
#undef DMA16
#undef KDMA
#undef VDMA
#undef DMA_OFFS
}

constexpr int ATT_NQB = SEQ / at::QB, ATT_ITEMS = ATT_NQB * NB * NH;
constexpr size_t WS_QCTR = WS_CTL + 512 * 1024;
__device__ __forceinline__ at::BlockRef attn_mkref(unsigned char* ws, int Li) {
    const int qb = ATT_NQB - 1 - ((Li & 127) >> 2), bh = (Li >> 7) * 4 + (Li & 3), b = bh >> 3, h = bh & 7;
    at::BlockRef r; const size_t rb = (size_t)b * SEQ;
    GAS unsigned char* wg = (GAS unsigned char*)ws;
    r.Q = (const GAS bf16*)(wg + WS_QB) + (rb + (size_t)qb * at::QB) * at::PITCH + h * 128; r.O = (GAS bf16*)(wg + WS_OB) + (rb + (size_t)qb * at::QB) * at::PITCH + h * 128;
    r.K = (const GAS bf16*)(wg + WS_KB) + rb * at::PITCH + h * 128; r.V = (const GAS bf16*)(wg + WS_VB) + rb * at::PITCH + h * 128;
    r.MW = (const GAS unsigned long long*)(wg + WS_MASK) + rb * 128; r.P0 = qb * at::QB; r.h = h; return r;
}
__device__ __forceinline__ int attn_fetch(gu32* ctr, volatile LAS unsigned* slot, int tid) {
    if (tid == 0) {
        unsigned v = 0x7fffffffu, q = slot[1], tries = slot[2];
        while (tries < 8u) {
            const unsigned t = __hip_atomic_fetch_add(ctr + q * 32u, 1u, __ATOMIC_RELAXED, __HIP_MEMORY_SCOPE_AGENT);
            if (t < 128u) { v = q * 128u + t; break; }
            q = (q + 1u) & 7u; ++tries;
        }
        slot[0] = v; slot[1] = q; slot[2] = tries;
    }
    __syncthreads();
    const int v = (int)slot[0];
    return __builtin_amdgcn_readfirstlane(v);
}
__device__ __forceinline__ void phase_attn(const Params& p, LAS unsigned char* ldsl) {
    char* lds = (char*)ldsl;
    unsigned char* ws = p.ws;
    const int tid = ltid();
    { const GAS float* bg = (const GAS float*)((GAS unsigned char*)ws + WS_BLUT); float* bl = (float*)(lds + at::OFF_BLUT); for (int i = tid; i < 8 * 132; i += NTHR) bl[i] = bg[i]; }
    gu32* ctr = (gu32*)(ws + WS_QCTR) + p.layer * 256;

    volatile LAS unsigned* slot = (volatile LAS unsigned*)(ldsl + at::LDS_NEED);
    if (tid == 0) { slot[1] = (unsigned)__builtin_amdgcn_s_getreg((3 << 11) | 20) & 7u; slot[2] = 0; }
    int L = attn_fetch(ctr, slot, tid);
    if (L >= ATT_ITEMS) return;
    at::BlockRef cur = attn_mkref(ws, L);
    at::Seam S;
    at::attn_prime(cur, lds, S);
    for (;;) {
        const int Ln = attn_fetch(ctr, slot, tid);
        const bool last = Ln >= ATT_ITEMS;
        const at::BlockRef nxt = last ? cur : attn_mkref(ws, Ln);
        at::attn_block(cur, nxt, lds, S);
        if (last) break;
        cur = nxt;
    }
}
__device__ __forceinline__ void phase_mix(const Params& p, LAS unsigned char* lds) {
    if (blockIdx.x < NB * NH) gdn_scan_bh(p, lds, (int)blockIdx.x);
    if (p.layer + 1 < DEPTH) {
        if (gridDim.x >= 2 * NB * NH) { if (blockIdx.x >= NB * NH && blockIdx.x < 2 * NB * NH) { convert_weights(p, lds, p.layer + 1, ((int)blockIdx.x - NB * NH) * NWAVES + (ltid() >> 6), NB * NH * NWAVES); __syncthreads(); } }
        else { convert_weights(p, lds, p.layer + 1, (int)blockIdx.x * NWAVES + (ltid() >> 6), (int)gridDim.x * NWAVES); __syncthreads(); }
    }
    phase_attn(p, lds);
}

#define XB_TMO      128
#define XB_XCNT(j)  (256  + 64 * (j))
#define XB_XSUB(j)  (1280 + 64 * (j))
#define XB_XGEN(j)  (2304 + 64 * (j))
#define XB_TOP      3328
#define XB_TOPGEN   3392
#define XCD_BAR_WORDS 3456
#define XB_SPIN_CAP (1u << 18)

__device__ __forceinline__ unsigned xb_ld(unsigned* p)              { return __hip_atomic_load(p, __ATOMIC_RELAXED, __HIP_MEMORY_SCOPE_AGENT); }
__device__ __forceinline__ unsigned xb_add(unsigned* p, unsigned v) { return __hip_atomic_fetch_add(p, v, __ATOMIC_RELAXED, __HIP_MEMORY_SCOPE_AGENT); }
__device__ __forceinline__ unsigned xb_xcc_id() { return (unsigned)__builtin_amdgcn_s_getreg((3 << 11) | 20) & 0xFu; }
#define XB_SPIN(cond, bar) do { unsigned _sp = 0; while (cond) { __builtin_amdgcn_s_sleep(1); \
    if ((++_sp & 255u) == 0u) { if (xb_ld(&(bar)[XB_TMO])) break; if (_sp > XB_SPIN_CAP) { atomicAdd(&(bar)[XB_TMO], 1u); break; } } } } while (0)

struct XcdBarrier {
    unsigned* bar; unsigned x;
    volatile LAS unsigned* st;
};

__device__ __forceinline__ XcdBarrier xcd_barrier_post(unsigned* bar, volatile LAS unsigned* st) {
    XcdBarrier b; b.bar = bar; b.x = xb_xcc_id(); b.st = st;
    if (threadIdx.x == 0) (void)xb_add(&bar[XB_XCNT(b.x)], 1u);
    return b;
}
__device__ __forceinline__ void xcd_barrier_complete(unsigned* bar, unsigned x, unsigned& nloc, unsigned& nx) {
    const unsigned G = gridDim.x * gridDim.y * gridDim.z;
    unsigned sum, cnt, mine, sp = 0u;
    for (;;) {
        sum = 0u; cnt = 0u; mine = 0u;
#pragma unroll
        for (unsigned j = 0; j < 16; ++j) { const unsigned c = xb_ld(&bar[XB_XCNT(j)]); sum += c; cnt += (c > 0u) ? 1u : 0u; mine = (j == x) ? c : mine; }
        if (sum == G) break;
        __builtin_amdgcn_s_sleep(1);
        if ((++sp & 255u) == 0u) { if (xb_ld(&bar[XB_TMO])) break; if (sp > XB_SPIN_CAP) { atomicAdd(&bar[XB_TMO], 1u); break; } }
    }
    nloc = mine > 0u ? mine : 1u; nx = cnt > 0u ? cnt : 1u;
}

__device__ __forceinline__ void xcd_barrier(const XcdBarrier& b) {
    asm volatile("s_waitcnt vmcnt(0)" ::: "memory");
    __syncthreads();
    if (threadIdx.x == 0) {
        unsigned* bar = b.bar;
        __builtin_amdgcn_s_waitcnt(0);
        unsigned nloc = b.st[0], nx = b.st[1];
        if (nloc == 0u) { xcd_barrier_complete(bar, b.x, nloc, nx); b.st[0] = nloc; b.st[1] = nx; }
        const unsigned old = xb_add(&bar[XB_XSUB(b.x)], 1u);
        const unsigned gen = old / nloc;
        if (old + 1u == (gen + 1u) * nloc) {
            __builtin_amdgcn_fence(__ATOMIC_RELEASE, "agent");
            asm volatile("s_waitcnt vmcnt(0)" ::: "memory");
            const unsigned og = xb_add(&bar[XB_TOP], 1u);
            const unsigned tg = og / nx;
            if (og + 1u == (tg + 1u) * nx) xb_add(&bar[XB_TOPGEN], 1u);
            else XB_SPIN(xb_ld(&bar[XB_TOPGEN]) == tg, bar);
            __builtin_amdgcn_fence(__ATOMIC_ACQUIRE, "agent");
            xb_add(&bar[XB_XGEN(b.x)], 1u);
            asm volatile("s_waitcnt vmcnt(0)" ::: "memory");
        } else {
            XB_SPIN(xb_ld(&bar[XB_XGEN(b.x)]) == gen, bar);
            __builtin_amdgcn_fence(__ATOMIC_ACQUIRE, "agent");
            asm volatile("s_waitcnt vmcnt(0)" ::: "memory");
        }
    }
    __syncthreads();
}

enum { PH_CONVERT = 0, PH_INPROJ, PH_GDN_LOCAL, PH_INDEXER, PH_GDN_SCAN, PH_ATTN, PH_GATES, PH_BRANCH_A, PH_BRANCH_B, PH_WOUT, PH_LN1, PH_FFN_IN, PH_FFN_OUT, PH_LN2, PH_COUNT };

template <class Epi>
__device__ __forceinline__ void run_gemm(LAS unsigned char* lds, const void* A, const void* Bt, int N, int K, const Epi& E) {
    pg8::Gemm g{(const pg8::bf16_t*)A, (const pg8::bf16_t*)Bt, M, N, K};
    pg8::StaticOrder S; S.init(M, N, (int)gridDim.x, (int)blockIdx.x);
    pg8::gemm_phase<Epi, pg8::StaticOrder, true, true>(lds, g, S, E);
}

__device__ __forceinline__ const float* ldp(volatile LAS unsigned long long* t, int i) { const unsigned long long v = t[i];
    return (const float*)((unsigned long long)(unsigned)__builtin_amdgcn_readfirstlane((int)(unsigned)v) | ((unsigned long long)(unsigned)__builtin_amdgcn_readfirstlane((int)(unsigned)(v >> 32)) << 32)); }
template <int PH>
__device__ __forceinline__ void run_phase(volatile LAS unsigned long long* t, int layer, int rep, LAS unsigned char* lds) {
    Params p{}; p.layer = layer; p.pad = rep;
    p.ws = (unsigned char*)ldp(t, 17);
    if constexpr (PH == PH_CONVERT) { p.x = ldp(t, 0); p.rel_bias = ldp(t, 1); p.w_in = ldp(t, 2); p.w_a = ldp(t, 7); p.w_b = ldp(t, 8); p.w_out = ldp(t, 9); p.w_ffn_in = ldp(t, 12); p.w_ffn_out = ldp(t, 13); }
    if constexpr (PH == PH_GDN_LOCAL) { p.conv_w = ldp(t, 3); p.a_log = ldp(t, 4); p.dt_bias = ldp(t, 5); }
    if constexpr (PH == PH_WOUT) { p.x = ldp(t, 0); p.out = (float*)ldp(t, 16); p.ln2_g = ldp(t, 14); p.ln2_b = ldp(t, 15); }
    if constexpr (PH == PH_LN1 || PH == PH_FFN_OUT) { p.ln1_g = ldp(t, 10); p.ln1_b = ldp(t, 11); p.out = (float*)ldp(t, 16); }
    if constexpr (PH == PH_LN2) { p.ln2_g = ldp(t, 14); p.ln2_b = ldp(t, 15); p.out = (float*)ldp(t, 16); }
    if constexpr (PH == PH_ATTN) { p.gdn_norm_w = ldp(t, 6); p.w_in = ldp(t, 2); p.w_a = ldp(t, 7); p.w_b = ldp(t, 8); p.w_out = ldp(t, 9); p.w_ffn_in = ldp(t, 12); p.w_ffn_out = ldp(t, 13); }
    unsigned char* ws = p.ws;
    unsigned char* wsw = p.ws + (size_t)(layer & 1) * WSET_STRIDE;
    if constexpr (PH == PH_CONVERT) phase_convert(p, lds);
    else if constexpr (PH == PH_INPROJ) { EpiProj E{ws}; run_gemm(lds, ws + WS_XB, wsw + WS_WIN, NP1, DM, E); }
    else if constexpr (PH == PH_GDN_LOCAL) {
        const int flip = (int)(blockIdx.x >> 3) & 1;
#pragma unroll 1
        for (int s = 0; s < 2; ++s) { if ((s ^ flip) == 0) phase_gdn_local(p, lds); else phase_indexer(p, lds); __syncthreads(); } }
    else if constexpr (PH == PH_INDEXER) { }
    else if constexpr (PH == PH_GDN_SCAN) { }
    else if constexpr (PH == PH_ATTN) phase_mix(p, lds);
    else if constexpr (PH == PH_GATES) { EpiGate E{ws}; run_gemm(lds, ws + WS_XB, wsw + WS_WG, NGT, DM, E); }
    else if constexpr (PH == PH_BRANCH_A) { { EpiBranch<0> E{ws}; run_gemm(lds, ws + WS_OA, wsw + WS_WA, DM, 1024, E); }
        __syncthreads();
        { EpiBranch<1> E{ws}; run_gemm(lds, ws + WS_OB, wsw + WS_WB, DM, 1024, E); } }
    else if constexpr (PH == PH_BRANCH_B) { }
    else if constexpr (PH == PH_WOUT) { EpiResidB E{ws, p.layer == 0 ? p.x : nullptr}; run_gemm(lds, ws + WS_MERGED, wsw + WS_WO, DM, DM, E); }
    else if constexpr (PH == PH_LN1) phase_ln_b(p, p.ln1_g, p.ln1_b, false);
    else if constexpr (PH == PH_FFN_IN) { EpiSwiGLU E{ws}; run_gemm(lds, ws + WS_XB, wsw + WS_W1, 2 * DFF, DM, E); }
    else if constexpr (PH == PH_FFN_OUT) {
        if (p.layer == DEPTH - 1) { EpiResidC E{ws, nullptr, p.ln1_g + (size_t)p.layer * DM, p.ln1_b + (size_t)p.layer * DM, p.out}; run_gemm(lds, ws + WS_HID, wsw + WS_W2, DM, DFF, E); }
        else { EpiResidB E{ws, nullptr}; run_gemm(lds, ws + WS_HID, wsw + WS_W2, DM, DFF, E); } }
    else if constexpr (PH == PH_LN2) { if (p.layer == DEPTH - 1) phase_ln(p, p.ln2_g, p.ln2_b, true); else phase_ln_b(p, p.ln2_g, p.ln2_b, false); }
}


__device__ constexpr int kRep[PH_COUNT] = { 1, 1, 1, 0, 0, 1, 1, 1, 0, 1, 1, 1, 1, 1 };
__global__ void __launch_bounds__(NTHR, 2) fwd_kernel(Params p0) {
    extern __shared__ __attribute__((aligned(16))) unsigned char smem[];
    LAS unsigned char* lds = (LAS unsigned char*)smem;
    if (threadIdx.x < 4) ((LAS unsigned*)(lds + LDS_MISC))[threadIdx.x] = 0u;
    if ((threadIdx.x & 63) == 0) ((LAS int*)(lds + LDS_WTAB))[(unsigned)__builtin_amdgcn_s_getreg(63492) & 63u] = (int)(threadIdx.x >> 6);
    volatile LAS unsigned long long* ptab = (volatile LAS unsigned long long*)(lds + LDS_MISC + 64);
    if (threadIdx.x == 0) { ptab[0] = (unsigned long long)p0.x; ptab[1] = (unsigned long long)p0.rel_bias; ptab[2] = (unsigned long long)p0.w_in; ptab[3] = (unsigned long long)p0.conv_w;
        ptab[4] = (unsigned long long)p0.a_log; ptab[5] = (unsigned long long)p0.dt_bias; ptab[6] = (unsigned long long)p0.gdn_norm_w; ptab[7] = (unsigned long long)p0.w_a;
        ptab[8] = (unsigned long long)p0.w_b; ptab[9] = (unsigned long long)p0.w_out; ptab[10] = (unsigned long long)p0.ln1_g; ptab[11] = (unsigned long long)p0.ln1_b;
        ptab[12] = (unsigned long long)p0.w_ffn_in; ptab[13] = (unsigned long long)p0.w_ffn_out; ptab[14] = (unsigned long long)p0.ln2_g; ptab[15] = (unsigned long long)p0.ln2_b;
        ptab[16] = (unsigned long long)p0.out; ptab[17] = (unsigned long long)p0.ws; }
    __syncthreads();
    XcdBarrier bar = xcd_barrier_post((unsigned*)(p0.ws + WS_CTL) + p0.pad * 4096, (volatile LAS unsigned*)(lds + LDS_MISC));
    const int lo = p0.ph_lo, hi = p0.ph_hi;
#define PHASE(PH) do { const int gi_ = l * PH_COUNT + (PH); if (gi_ >= lo && gi_ < hi) { for (int rep_ = 0; rep_ < kRep[PH]; ++rep_) { run_phase<PH>(ptab, l, rep_, lds); if (gi_ + 1 < hi || rep_ + 1 < kRep[PH]) xcd_barrier(bar); } } } while (0)
    for (int l = 0; l < DEPTH; ++l) {
        if (l == 0) { PHASE(PH_CONVERT); } PHASE(PH_INPROJ); PHASE(PH_GDN_LOCAL); PHASE(PH_INDEXER); PHASE(PH_GDN_SCAN); PHASE(PH_ATTN); PHASE(PH_GATES);
        PHASE(PH_BRANCH_A); PHASE(PH_BRANCH_B); PHASE(PH_WOUT); PHASE(PH_LN1); PHASE(PH_FFN_IN); PHASE(PH_FFN_OUT); PHASE(PH_LN2);
    }
#undef PHASE
}

extern "C" void kernel_launch(void* const* d_in, const int* in_sizes, int n_in, void* d_out, int out_size, void* d_ws, size_t ws_size, hipStream_t stream) {
    if (n_in != 16 || out_size != M * DM || ws_size < WS_END) { fprintf(stderr, "kernel_launch: unexpected shapes (n_in %d, out %d, ws %zu < %zu)\n", n_in, out_size, ws_size, (size_t)WS_END); return; }
    Params p{};
    p.x = (const float*)d_in[0]; p.rel_bias = (const float*)d_in[1]; p.w_in = (const float*)d_in[2]; p.conv_w = (const float*)d_in[3];
    p.a_log = (const float*)d_in[4]; p.dt_bias = (const float*)d_in[5]; p.gdn_norm_w = (const float*)d_in[6]; p.w_a = (const float*)d_in[7];
    p.w_b = (const float*)d_in[8]; p.w_out = (const float*)d_in[9]; p.ln1_g = (const float*)d_in[10]; p.ln1_b = (const float*)d_in[11];
    p.w_ffn_in = (const float*)d_in[12]; p.w_ffn_out = (const float*)d_in[13]; p.ln2_g = (const float*)d_in[14]; p.ln2_b = (const float*)d_in[15];
    p.out = (float*)d_out; p.ws = (unsigned char*)d_ws;
    static int grid = 0;
    if (!grid) {
        int dev = 0, cus = 0, per_cu = 0;
        (void)hipGetDevice(&dev);
        if (hipDeviceGetAttribute(&cus, hipDeviceAttributeMultiprocessorCount, dev) != hipSuccess || cus <= 0) cus = 256;
        (void)hipFuncSetAttribute((const void*)fwd_kernel, hipFuncAttributeMaxDynamicSharedMemorySize, LDS_BYTES);
        if (hipOccupancyMaxActiveBlocksPerMultiprocessor(&per_cu, (const void*)fwd_kernel, NTHR, LDS_BYTES) != hipSuccess || per_cu < 1)
            fprintf(stderr, "kernel_launch: occupancy query reports %d workgroups per CU\n", per_cu);
        grid = cus;
    }
    (void)hipMemsetAsync((char*)d_ws + WS_CTL, 0, 1024 * 1024, stream);
    p.ph_lo = 0; p.ph_hi = DEPTH * PH_COUNT; p.pad = 0;
    fwd_kernel<<<dim3(grid), dim3(NTHR), LDS_BYTES, stream>>>(p);
}
```

```cpp
#include <hip/hip_runtime.h>
#include <cstdio>
#include <cstdint>

#define GAS __attribute__((address_space(1)))
#define LAS __attribute__((address_space(3)))
typedef unsigned short bf16;
typedef GAS unsigned gu32;
typedef short bf16x8 __attribute__((ext_vector_type(8)));
typedef short s16x4 __attribute__((ext_vector_type(4)));
typedef _Float16 f16x8 __attribute__((ext_vector_type(8)));
typedef float f32x2 __attribute__((ext_vector_type(2)));
typedef float f32x4 __attribute__((ext_vector_type(4)));
typedef float f32x16 __attribute__((ext_vector_type(16)));
typedef unsigned u32x2 __attribute__((ext_vector_type(2)));
typedef unsigned u32x4 __attribute__((ext_vector_type(4)));

constexpr int NB = 4, SEQ = 8192, DM = 2048, DEPTH = 4;
constexpr int M = NB * SEQ;
constexpr int NH = 8, HD = 128, CH = 64, NCH = SEQ / CH;
constexpr int DIN = 11864, DFF = 5632;
constexpr int NP1 = 7936;
constexpr int NGT = 4096;
constexpr int SMW = 768;
constexpr float ALPHA = 1.681792830507429f;
constexpr float LN_EPS = 1e-5f, RMS_EPS = 1e-6f;
constexpr int NWAVES = 8, NTHR = 512;

constexpr int C_QKVA = 0, C_A = 3072, C_B = 3080, C_Z = 3088, C_QB = 4112, C_QI = 7184, C_KI = 7696, C_WI = 7760, C_GA = 7768;

constexpr size_t MiB = 1u << 20;
constexpr size_t WS_CTL = 0;
constexpr size_t CTL_BYTES = 1 * MiB;
constexpr size_t WS_WIN = 1 * MiB;
constexpr size_t WS_WG  = WS_WIN + (size_t)NP1 * DM * 2;
constexpr size_t WS_WA  = WS_WG + (size_t)NGT * DM * 2;
constexpr size_t WS_WB  = WS_WA + (size_t)DM * 1024 * 2;
constexpr size_t WS_WO  = WS_WB + (size_t)DM * 1024 * 2;
constexpr size_t WS_W1  = WS_WO + (size_t)DM * DM * 2;
constexpr size_t WS_W2  = WS_W1 + (size_t)2 * DFF * DM * 2;
constexpr size_t WS_WEND = WS_W2 + (size_t)DM * DFF * 2;
constexpr size_t WS_XB  = 131 * MiB;
constexpr size_t WS_GQKV = WS_XB + 128 * MiB;
constexpr size_t WS_ZB  = WS_GQKV + 192 * MiB;
constexpr size_t WS_QB  = WS_ZB + 64 * MiB;
constexpr size_t WS_KB  = WS_QB + 64 * MiB;
constexpr size_t WS_VB  = WS_KB + 64 * MiB;
constexpr size_t WS_SM  = WS_VB + 64 * MiB;
constexpr size_t WS_QN  = WS_SM + 96 * MiB;
constexpr size_t WS_KN  = WS_QN + 64 * MiB;
constexpr size_t WS_VN  = WS_KN + 64 * MiB;
constexpr size_t WS_TT  = WS_VN + 64 * MiB;
constexpr size_t WS_AA  = WS_TT + 32 * MiB;
constexpr size_t WS_GCB = WS_AA + 32 * MiB;
constexpr size_t WS_QI  = WS_GCB + 2 * MiB;
constexpr size_t WS_KI  = WS_QI + 32 * MiB;
constexpr size_t WS_MASK = WS_KI + 4 * MiB;
constexpr size_t WS_OA  = WS_MASK + 32 * MiB;
constexpr size_t WS_BLUT = WS_OA + 64 * MiB;
constexpr size_t WS_OB = WS_BLUT + 1 * MiB;
constexpr size_t WS_STATS = WS_OB + 64 * MiB;
constexpr size_t WS_WSET2 = WS_STATS + 1 * MiB;
constexpr size_t WSET_STRIDE = WS_WSET2 - WS_WIN;
constexpr size_t WS_END = WS_WSET2 + (WS_WEND - WS_WIN);
constexpr size_t WS_YB = WS_QN;
constexpr size_t WS_GATES = WS_GQKV;
constexpr size_t WS_MERGED = WS_KB;
constexpr size_t WS_HID = WS_GQKV;
static_assert(WS_WEND <= WS_XB, "weights fit");
static_assert((size_t)M * DFF * 2 <= 384 * MiB, "hid overlay");

constexpr int LDS_BYTES = 144 * 1024;
constexpr int LDS_MISC = 143 * 1024;

struct Params {
    const float* x; const float* rel_bias; const float* w_in; const float* conv_w; const float* a_log; const float* dt_bias;
    const float* gdn_norm_w; const float* w_a; const float* w_b; const float* w_out; const float* ln1_g; const float* ln1_b;
    const float* w_ffn_in; const float* w_ffn_out; const float* ln2_g; const float* ln2_b;
    float* out; unsigned char* ws;
    int layer, ph_lo, ph_hi, pad;
};

__device__ __forceinline__ unsigned f2bf(float f) { return (unsigned)__builtin_bit_cast(unsigned short, (__bf16)f); }
typedef __bf16 bf16v2_t __attribute__((ext_vector_type(2)));
__device__ __forceinline__ unsigned pk2(float lo, float hi) { const f32x2 v = {lo, hi}; return __builtin_bit_cast(unsigned, __builtin_convertvector(v, bf16v2_t)); }
__device__ __forceinline__ float bf2f(unsigned short h) { return __builtin_bit_cast(float, (unsigned)h << 16); }
__device__ __forceinline__ float bflo(unsigned w) { return __builtin_bit_cast(float, w << 16); }
__device__ __forceinline__ float bfhi(unsigned w) { return __builtin_bit_cast(float, w & 0xffff0000u); }
__device__ __forceinline__ float fast_exp(float x) { return __builtin_amdgcn_exp2f(x * 1.4426950408889634f); }
__device__ __forceinline__ float sigmoidf_(float x) { return __builtin_amdgcn_rcpf(1.0f + fast_exp(-x)); }
__device__ __forceinline__ float siluf_(float x) { return x * sigmoidf_(x); }
__device__ __forceinline__ u32x4 zero4_() { unsigned z; asm volatile("v_mov_b32 %0, 0" : "=v"(z)); return (u32x4){z, z, z, z}; }
constexpr int LDS_WTAB = 143 * 1024 + 256;
__device__ __forceinline__ int ltid() {
    extern __shared__ __attribute__((aligned(16))) unsigned char smem_base_[];
    const unsigned slot = (unsigned)__builtin_amdgcn_s_getreg(63492) & 63u;
    const int w = ((volatile LAS int*)((LAS unsigned char*)smem_base_ + LDS_WTAB))[slot];
    int lane; asm volatile("v_mbcnt_lo_u32_b32 %0, -1, 0\n\tv_mbcnt_hi_u32_b32 %0, -1, %0" : "=v"(lane));
    return __builtin_amdgcn_readfirstlane(w) * 64 + lane;
}
#define LDS_WAIT() asm volatile("s_waitcnt lgkmcnt(0)" ::: "memory")
#define VM_WAIT() asm volatile("s_waitcnt vmcnt(0)" ::: "memory")

__device__ const unsigned char T5_LUT[132] = {0, 1, 2, 3, 4, 5, 6, 7, 8, 9, 10, 11, 12, 13, 14, 15, 16, 16, 16, 17, 17, 18, 18, 18, 19, 19, 19, 20, 20, 20, 20, 21, 21, 21, 21, 22, 22, 22, 22, 22,
    23, 23, 23, 23, 23, 23, 24, 24, 24, 24, 24, 24, 25, 25, 25, 25, 25, 25, 25, 26, 26, 26, 26, 26, 26, 26, 26, 27, 27, 27, 27, 27, 27, 27, 27, 27, 27, 28, 28, 28, 28, 28, 28, 28, 28, 28, 28,
    29, 29, 29, 29, 29, 29, 29, 29, 29, 29, 29, 29, 30, 30, 30, 30, 30, 30, 30, 30, 30, 30, 30, 30, 30, 30, 31, 31, 31, 31, 31, 31, 31, 31, 31, 31, 31, 31, 31, 31, 31, 31, 31, 31, 31};

namespace pg8 {
#define PG8_LAS __attribute__((address_space(3)))
typedef unsigned short bf16_t;
typedef short bf16x8 __attribute__((ext_vector_type(8)));
typedef float f32x4 __attribute__((ext_vector_type(4)));
typedef unsigned u32x4 __attribute__((ext_vector_type(4)));
constexpr int BM = 256, BK = 64, HALF = 128, HTB = HALF * BK * 2  , STAGE_BYTES = 8 * HTB, NXCD = 8, WGM = 4;

__host__ __device__ __forceinline__ int lds_byte(int r, int c) { const int st = (r >> 4) * 2 + (c >> 5), rr = r & 15, cc = c & 31, ob = rr * 64 + cc * 2; return st * 1024 + (ob ^ (((ob >> 9) & 1) << 5)); }
__host__ __device__ __forceinline__ void stage_rc(int b, int& R, int& C) { const int st = b / 1024, sb = b % 1024, swz = sb ^ (((sb >> 9) & 1) << 5); R = (st >> 1) * 16 + swz / 64; C = (st & 1) * 32 + (swz % 64) / 2; }
__host__ __device__ __forceinline__ int perm32(int rho) { const int n = rho >> 4, i = rho & 15; return 8 * (i >> 2) + 4 * n + (i & 3); }

struct Unit { int pm, pn; };
struct Gemm { const bf16_t* A; const bf16_t* Bt; int M, N, K; };

struct StaticOrder {
    int nM, nN, nwg, G, c;
    __host__ __device__ void init(int M, int N, int G_, int c_) { nM = M / BM; nN = N / BM; nwg = nM * nN; G = G_; c = c_; }
    __host__ __device__ bool next(int i, Unit& u) const {
        const long L = (long)i * G + c; if (L >= nwg) return false;
        int wgid = (int)L; { const int q = nwg / NXCD, r = nwg % NXCD, xcd = wgid % NXCD, off = wgid / NXCD; wgid = (xcd < r ? xcd * (q + 1) : r * (q + 1) + (xcd - r) * q) + off; }
        const int nig = WGM * nN, gid = wgid / nig, fm = gid * WGM, gsz = (nM - fm) < WGM ? (nM - fm) : WGM;
        u.pm = fm + ((wgid % nig) % gsz); u.pn = (wgid % nig) / gsz; return true;
    }
    __device__ __forceinline__ void a_ready(const Unit&) const {}
    __device__ __forceinline__ void done(const Unit&) const {}
};
template <class Epi, class Sched, bool ALIGN_EPI = false, bool SP2 = false>
__device__ __forceinline__ void gemm_phase(PG8_LAS unsigned char* lds, const Gemm g, const Sched& S, const Epi& E) {
    const int tid = ltid(), wid = __builtin_amdgcn_readfirstlane(tid >> 6), lane = tid & 63, wr = wid >> 2, wc = wid & 3, fr = lane & 15, fq = lane >> 4;
    const int K = g.K, nt = K / BK;
    unsigned voffA[2], voffB[2];
#pragma unroll
    for (int i = 0; i < 2; ++i) { int R, C; stage_rc(tid * 16 + i * 8192, R, C); const int Rb = Epi::PERM ? ((R & ~31) + perm32(R & 31)) : R;
        voffA[i] = (unsigned)(R * K + C) * 2u; voffB[i] = (unsigned)(Rb * K + C) * 2u; }
    const size_t kstep = (size_t)(BK * 2);
    const size_t hstep = (size_t)HALF * K * 2;
    const size_t tstep = 2 * hstep;
    const unsigned ldsw = (unsigned)wid * 1024u;
    const int aoff = lds_byte(wr * 64 + fr, fq * 8), boff = lds_byte(wc * 32 + fr, fq * 8);
#define PG8_SA(b, h) (((b) * 2 + (h)) * HTB)
#define PG8_SB(b, h) ((4 + (b) * 2 + (h)) * HTB)
#define PG8_STAGE(bufoff, gbase, voff) do { _Pragma("unroll") for (int _i = 0; _i < 2; ++_i) \
        __builtin_amdgcn_global_load_lds((const unsigned*)((const char*)(gbase) + (voff)[_i]), (PG8_LAS unsigned*)(lds + (bufoff) + ldsw + _i * 8192), 16, 0, 0); } while (0)
#define PG8_LDA(dst, b, h) do { _Pragma("unroll") for (int m = 0; m < 4; ++m) _Pragma("unroll") for (int k = 0; k < 2; ++k) dst[m][k] = *(const PG8_LAS bf16x8*)(lds + PG8_SA(b, h) + aoff + m * 2048 + k * 1024); } while (0)
#define PG8_LDB(dst, b, h) do { _Pragma("unroll") for (int n = 0; n < 2; ++n) _Pragma("unroll") for (int k = 0; k < 2; ++k) dst[n][k] = *(const PG8_LAS bf16x8*)(lds + PG8_SB(b, h) + boff + n * 2048 + k * 1024); } while (0)
#define PG8_MMA(ai, bj, At, Bt) do { __builtin_amdgcn_s_setprio(1); _Pragma("unroll") for (int m = 0; m < 4; ++m) _Pragma("unroll") for (int n = 0; n < 2; ++n) _Pragma("unroll") for (int k = 0; k < 2; ++k) \
        acc[ai][bj][m][n] = __builtin_amdgcn_mfma_f32_16x16x32_bf16(Bt[n][k], At[m][k], acc[ai][bj][m][n], 0, 0, 0); __builtin_amdgcn_s_setprio(0); } while (0)
#define PG8_WAIT_V(n) asm volatile("s_waitcnt vmcnt(" #n ")" ::: "memory")
#define PG8_WAIT_L(n) asm volatile("s_waitcnt lgkmcnt(" #n ")" ::: "memory")
#define PG8_BAR __builtin_amdgcn_s_barrier()
#define PG8_SCHED __builtin_amdgcn_sched_barrier(0)
    Unit cur, nxt; int ui = 0;
    if (!S.next(0, cur)) return;
    f32x4 acc[2][2][4][2];
#pragma unroll
    for (int a = 0; a < 2; ++a)
#pragma unroll
        for (int b = 0; b < 2; ++b)
#pragma unroll
            for (int m = 0; m < 4; ++m)
#pragma unroll
                for (int n = 0; n < 2; ++n) acc[a][b][m][n] = (f32x4){0.f, 0.f, 0.f, 0.f};
    bf16x8 At[4][2], B0[2][2], B1[2][2];
    const char* cA = (const char*)g.A + (size_t)cur.pm * tstep; const char* cB = (const char*)g.Bt + (size_t)cur.pn * tstep;
    S.a_ready(cur);
    if constexpr (SP2) {
        PG8_STAGE(PG8_SB(0, 0), cB, voffB); PG8_STAGE(PG8_SB(0, 1), cB + hstep, voffB); PG8_STAGE(PG8_SA(0, 0), cA, voffA); PG8_STAGE(PG8_SA(0, 1), cA + hstep, voffA);
        if (wr == 1) PG8_BAR;
        PG8_WAIT_V(2); PG8_BAR;
        PG8_STAGE(PG8_SB(1, 0), cB + kstep, voffB); PG8_STAGE(PG8_SA(1, 0), cA + kstep, voffA); PG8_STAGE(PG8_SB(1, 1), cB + hstep + kstep, voffB);
        PG8_WAIT_V(6); PG8_BAR;
    } else {
        PG8_STAGE(PG8_SB(0, 0), cB, voffB); PG8_STAGE(PG8_SA(0, 0), cA, voffA); PG8_STAGE(PG8_SB(0, 1), cB + hstep, voffB); PG8_STAGE(PG8_SA(0, 1), cA + hstep, voffA);
        if (wr == 1) PG8_BAR;
        PG8_WAIT_V(4); PG8_BAR;
        PG8_STAGE(PG8_SB(1, 0), cB + kstep, voffB); PG8_STAGE(PG8_SA(1, 0), cA + kstep, voffA); PG8_STAGE(PG8_SB(1, 1), cB + hstep + kstep, voffB);
        PG8_WAIT_V(6); PG8_BAR;
    }
    for (;;) {
        const bool has_next = S.next(ui + 1, nxt);
        const char* nA = has_next ? (const char*)g.A + (size_t)nxt.pm * tstep : cA; const char* nB = has_next ? (const char*)g.Bt + (size_t)nxt.pn * tstep : cB;
        for (int t = 0; t < nt; t += 2) {
            const bool last = (t == nt - 2);
            const char* a1 = cA + (size_t)(t + 1) * kstep;
            const char* a2 = last ? nA : cA + (size_t)(t + 2) * kstep; const char* b2 = last ? nB : cB + (size_t)(t + 2) * kstep;
            const char* a3 = a2 + kstep; const char* b3 = b2 + kstep;
            if (last && has_next) S.a_ready(nxt);
            if constexpr (SP2) {
            PG8_LDB(B0, 0, 0); PG8_LDB(B1, 0, 1); PG8_SCHED; PG8_LDA(At, 0, 0); PG8_STAGE(PG8_SA(1, 1), a1 + hstep, voffA);
            PG8_WAIT_V(8); PG8_WAIT_L(0); PG8_BAR; PG8_MMA(0, 0, At, B0); PG8_MMA(0, 1, At, B1); PG8_BAR; PG8_SCHED;
            PG8_LDA(At, 0, 1); PG8_STAGE(PG8_SB(0, 0), b2, voffB); PG8_STAGE(PG8_SB(0, 1), b2 + hstep, voffB); PG8_STAGE(PG8_SA(0, 0), a2, voffA);
            PG8_WAIT_V(8); PG8_WAIT_L(0); PG8_BAR; PG8_MMA(1, 0, At, B0); PG8_MMA(1, 1, At, B1); PG8_BAR; PG8_SCHED;
            PG8_LDB(B0, 1, 0); PG8_LDB(B1, 1, 1); PG8_SCHED; PG8_LDA(At, 1, 0); PG8_STAGE(PG8_SA(0, 1), a2 + hstep, voffA);
            PG8_WAIT_V(8); PG8_WAIT_L(0); PG8_BAR; PG8_MMA(0, 0, At, B0); PG8_MMA(0, 1, At, B1); PG8_BAR; PG8_SCHED;
            PG8_LDA(At, 1, 1); PG8_STAGE(PG8_SB(1, 0), b3, voffB); PG8_STAGE(PG8_SB(1, 1), b3 + hstep, voffB); PG8_STAGE(PG8_SA(1, 0), a3, voffA);
            PG8_WAIT_V(8); PG8_WAIT_L(0); PG8_BAR; PG8_MMA(1, 0, At, B0); PG8_MMA(1, 1, At, B1); PG8_BAR; PG8_SCHED;
            } else {
            PG8_LDB(B0, 0, 0); PG8_SCHED; PG8_LDA(At, 0, 0); PG8_STAGE(PG8_SA(1, 1), a1 + hstep, voffA);
            PG8_WAIT_L(8); PG8_BAR; PG8_WAIT_L(0); PG8_MMA(0, 0, At, B0); PG8_BAR; PG8_SCHED;
            PG8_LDB(B1, 0, 1); PG8_STAGE(PG8_SB(0, 0), b2, voffB);
            PG8_BAR; PG8_WAIT_L(0); PG8_MMA(0, 1, At, B1); PG8_BAR;
            PG8_LDA(At, 0, 1); PG8_STAGE(PG8_SA(0, 0), a2, voffA);
            PG8_BAR; PG8_WAIT_L(0); PG8_MMA(1, 0, At, B0); PG8_BAR; PG8_SCHED;
            PG8_STAGE(PG8_SB(0, 1), b2 + hstep, voffB);
            PG8_WAIT_V(6); PG8_BAR; PG8_MMA(1, 1, At, B1); PG8_BAR;
            PG8_LDB(B0, 1, 0); PG8_SCHED; PG8_LDA(At, 1, 0); PG8_STAGE(PG8_SA(0, 1), a2 + hstep, voffA);
            PG8_WAIT_L(8); PG8_BAR; PG8_WAIT_L(0); PG8_MMA(0, 0, At, B0); PG8_BAR; PG8_SCHED;
            PG8_LDB(B1, 1, 1); PG8_STAGE(PG8_SB(1, 0), b3, voffB);
            PG8_BAR; PG8_WAIT_L(0); PG8_MMA(0, 1, At, B1); PG8_BAR;
            PG8_LDA(At, 1, 1); PG8_STAGE(PG8_SA(1, 0), a3, voffA);
            PG8_BAR; PG8_WAIT_L(0); PG8_MMA(1, 0, At, B0); PG8_BAR; PG8_SCHED;
            PG8_STAGE(PG8_SB(1, 1), b3 + hstep, voffB);
            PG8_WAIT_V(6); PG8_BAR; PG8_MMA(1, 1, At, B1); PG8_BAR;
            }
        }
        if constexpr (ALIGN_EPI) { if (wr == 0) PG8_BAR; }
        if constexpr (!Epi::AFTER_DRAIN) { E(acc, cur, wr, wc, fr, fq); S.done(cur); }
        if (!has_next) break;
#pragma unroll
        for (int a = 0; a < 2; ++a)
#pragma unroll
            for (int b = 0; b < 2; ++b)
#pragma unroll
                for (int m = 0; m < 4; ++m)
#pragma unroll
                    for (int n = 0; n < 2; ++n) acc[a][b][m][n] = (f32x4){0.f, 0.f, 0.f, 0.f};
        cur = nxt; cA = nA; cB = nB; ++ui;
        if constexpr (ALIGN_EPI) { if (wr == 1) PG8_BAR; }
    }
    PG8_WAIT_V(0);
    if constexpr (!ALIGN_EPI) { if (wr == 0) PG8_BAR; }
    PG8_BAR;
    if constexpr (Epi::AFTER_DRAIN) { E.fused(acc, cur, wr, wc, fr, fq, lds, wid, lane); S.done(cur); }
#undef PG8_SA
#undef PG8_SB
#undef PG8_STAGE
#undef PG8_LDA
#undef PG8_LDB
#undef PG8_MMA
#undef PG8_WAIT_V
#undef PG8_WAIT_L
#undef PG8_BAR
#undef PG8_SCHED
}
}

__device__ __forceinline__ int map_win(int n) {
    if (n < 3072) return n;
    if (n < 4096) return C_Z + (n - 3072);
    if (n < 7168) return C_QB + (n - 4096);
    const int s = n - 7168;
    if (s < 512) return C_QI + s;
    if (s < 576) return C_KI + (s - 512);
    if (s < 584) return C_WI + (s - 576);
    if (s < 592) return C_A + (s - 584);
    if (s < 600) return C_B + (s - 592);
    return -1;
}
struct CvItem { const GAS float* src; GAS bf16* dst; int ldw8, K8, ok; };
template <int MODE>
__device__ __forceinline__ CvItem cv_make(const GAS float* W, int ldw, int K, GAS bf16* WT, int coff, int item, int lane) {
    const int nkh = K / 128, g = item >> 3, w8 = item & 7, nb = 4 * (g / nkh) + (w8 & 3), kb = 2 * (g % nkh) + (w8 >> 2), k0 = 64 * kb, n0 = 32 * nb;
    const int n = n0 + (lane & 7) * 4;
    int sc;
    if (MODE == 0) sc = map_win(n);
    else if (MODE == 1) sc = coff + n;
    else { const int t = n >> 8, r = n & 255; sc = (r < 128) ? (128 * t + r) : (DFF + 128 * t + (r - 128)); }
    CvItem c; c.ok = sc >= 0; c.src = W + (size_t)(k0 + (lane >> 3)) * ldw + (sc >= 0 ? sc : 0); c.dst = WT + (size_t)(n0 + (lane >> 3)) * K + k0 + 8 * (lane & 7);
    c.ldw8 = 8 * ldw; c.K8 = 8 * K; return c;
}
constexpr int CV_NIT = (DM / 64) * (NP1 / 32) + (DM / 64) * (NGT / 32) + 2 * (1024 / 64) * (DM / 32) + (DM / 64) * (DM / 32) + (DM / 64) * (2 * DFF / 32) + (DFF / 64) * (DM / 32);
__device__ __forceinline__ CvItem cv_decode(const Params& p, int l, int it, int lane) {
    GAS unsigned char* ws = (GAS unsigned char*)p.ws + (size_t)(l & 1) * WSET_STRIDE;
    const GAS float* w_in = (const GAS float*)p.w_in + (size_t)l * DM * DIN;
    constexpr int I0 = (DM / 64) * (NP1 / 32), I1 = (DM / 64) * (NGT / 32), I2 = (1024 / 64) * (DM / 32), I3 = I2, I4 = (DM / 64) * (DM / 32), I5 = (DM / 64) * (2 * DFF / 32);
    int r = it;
    if (r < I0) return cv_make<0>(w_in, DIN, DM, (GAS bf16*)(ws + WS_WIN), 0, r, lane); r -= I0;
    if (r < I1) return cv_make<1>(w_in, DIN, DM, (GAS bf16*)(ws + WS_WG), C_GA, r, lane); r -= I1;
    if (r < I2) return cv_make<1>((const GAS float*)p.w_a + (size_t)l * 1024 * DM, DM, 1024, (GAS bf16*)(ws + WS_WA), 0, r, lane); r -= I2;
    if (r < I3) return cv_make<1>((const GAS float*)p.w_b + (size_t)l * 1024 * DM, DM, 1024, (GAS bf16*)(ws + WS_WB), 0, r, lane); r -= I3;
    if (r < I4) return cv_make<1>((const GAS float*)p.w_out + (size_t)l * DM * DM, DM, DM, (GAS bf16*)(ws + WS_WO), 0, r, lane); r -= I4;
    if (r < I5) return cv_make<2>((const GAS float*)p.w_ffn_in + (size_t)l * DM * 2 * DFF, 2 * DFF, DM, (GAS bf16*)(ws + WS_W1), 0, r, lane); r -= I5;
    return cv_make<1>((const GAS float*)p.w_ffn_out + (size_t)l * DFF * DM, DM, DFF, (GAS bf16*)(ws + WS_W2), 0, r, lane);
}
__device__ __forceinline__ void cv_load(const CvItem& c, f32x4 (&wv)[8]) {
#pragma unroll
    for (int i = 0; i < 8; ++i) wv[i] = c.ok ? *(const GAS f32x4*)(c.src + (size_t)i * c.ldw8) : (f32x4){0.f, 0.f, 0.f, 0.f};
}
__device__ __forceinline__ void cv_store(const CvItem& c, const f32x4 (&wv)[8], LAS float* scr, int lane) {
#pragma unroll
    for (int i = 0; i < 8; ++i) { const int kk = 8 * i + (lane >> 3); LAS float* d = scr + kk * 33 + (lane & 7) * 4; d[0] = wv[i].x; d[1] = wv[i].y; d[2] = wv[i].z; d[3] = wv[i].w; }
    LDS_WAIT(); asm volatile("" ::: "memory");
    const int cc = lane & 7;
#pragma unroll
    for (int j = 0; j < 4; ++j) { const int nn = (lane >> 3) + 8 * j; const LAS float* s = scr + (8 * cc) * 33 + nn;
        u32x4 o; o.x = pk2(s[0 * 33], s[1 * 33]); o.y = pk2(s[2 * 33], s[3 * 33]); o.z = pk2(s[4 * 33], s[5 * 33]); o.w = pk2(s[6 * 33], s[7 * 33]);
        *(GAS u32x4*)(c.dst + (size_t)j * c.K8) = o; }
    LDS_WAIT(); asm volatile("" ::: "memory");
}
__device__ __forceinline__ void convert_weights(const Params& p, LAS unsigned char* lds, int l, int cw, int ncw) {
    const int tid = ltid(), lane = tid & 63, wave = tid >> 6;
    LAS float* scr = (LAS float*)(lds + wave * 16384);
    if (cw < CV_NIT) {
        f32x4 wa[8], wb[8];
        CvItem ca = cv_decode(p, l, cw, lane), cb = ca;
        cv_load(ca, wa);
        for (int it = cw;;) {
            const int i1 = it + ncw; const bool h1 = i1 < CV_NIT;
            if (h1) { cb = cv_decode(p, l, i1, lane); cv_load(cb, wb); }
            cv_store(ca, wa, scr, lane);
            if (!h1) break;
            const int i2 = i1 + ncw; const bool h2 = i2 < CV_NIT;
            if (h2) { ca = cv_decode(p, l, i2, lane); cv_load(ca, wa); }
            cv_store(cb, wb, scr, lane);
            if (!h2) break;
            it = i2;
        }
    }
}

__device__ __forceinline__ void phase_convert(const Params& p, LAS unsigned char* lds) {
    const int tid = ltid(), wave = tid >> 6;
    const int l = p.layer;
    GAS unsigned char* ws = (GAS unsigned char*)p.ws;
    convert_weights(p, lds, 0, (int)blockIdx.x * NWAVES + wave, (int)gridDim.x * NWAVES);
    if (l == 0) {
        const GAS f32x4* xs = (const GAS f32x4*)p.x; GAS u32x2* xd = (GAS u32x2*)(ws + WS_XB);
        const unsigned n4 = (unsigned)((size_t)M * DM / 4), st_ = gridDim.x * NTHR;
        for (unsigned i = blockIdx.x * NTHR + tid; i < n4; i += 4 * st_) { f32x4 v[4];
#pragma unroll
            for (int q = 0; q < 4; ++q) v[q] = xs[i + q * st_];
#pragma unroll
            for (int q = 0; q < 4; ++q) { u32x2 o; o.x = pk2(v[q].x, v[q].y); o.y = pk2(v[q].z, v[q].w); xd[i + q * st_] = o; } }
        if (blockIdx.x == 0) {
            GAS float* bl = (GAS float*)(ws + WS_BLUT);
            for (int i = tid; i < 8 * 132; i += NTHR) { const int h = i / 132, d = i % 132; const int dd = d > 128 ? 128 : d;
                bl[i] = ((const GAS float*)p.rel_bias)[(int)T5_LUT[dd] * 8 + h] * 11.313708498984761f; }
        }
    }
}

__device__ __forceinline__ float wave_sum(float v) {
#pragma unroll
    for (int o = 1; o < 64; o <<= 1) v += __shfl_xor(v, o);
    return v;
}
__device__ __forceinline__ float wave_sum_dpp(float v) {
    v += __builtin_bit_cast(float, __builtin_amdgcn_update_dpp(0, __builtin_bit_cast(int, v), 0x111, 0xf, 0xf, false));
    v += __builtin_bit_cast(float, __builtin_amdgcn_update_dpp(0, __builtin_bit_cast(int, v), 0x112, 0xf, 0xf, false));
    v += __builtin_bit_cast(float, __builtin_amdgcn_update_dpp(0, __builtin_bit_cast(int, v), 0x114, 0xf, 0xf, false));
    v += __builtin_bit_cast(float, __builtin_amdgcn_update_dpp(0, __builtin_bit_cast(int, v), 0x118, 0xf, 0xf, false));
    v += __builtin_bit_cast(float, __builtin_amdgcn_update_dpp(0, __builtin_bit_cast(int, v), 0x142, 0xa, 0xf, false));
    v += __builtin_bit_cast(float, __builtin_amdgcn_update_dpp(0, __builtin_bit_cast(int, v), 0x143, 0xc, 0xf, false));
    return __builtin_bit_cast(float, __builtin_amdgcn_readlane(__builtin_bit_cast(int, v), 63));
}
constexpr int LNR = 4;
__device__ __forceinline__ void phase_ln(const Params& p, const float* gptr, const float* bptr, bool final_out) {
    const int tid = ltid(), lane = tid & 63, wave = tid >> 6;
    const int gw = blockIdx.x * NWAVES + wave, NGW = gridDim.x * NWAVES;
    const GAS f32x4* g4 = (const GAS f32x4*)(gptr + (size_t)p.layer * DM) + lane;
    const GAS f32x4* b4 = (const GAS f32x4*)(bptr + (size_t)p.layer * DM) + lane;
    GAS unsigned char* ws = (GAS unsigned char*)p.ws;
    for (int m0 = LNR * gw; m0 < M; m0 += LNR * NGW) {
        f32x4 v[LNR][8]; float s[LNR];
#pragma unroll
        for (int r = 0; r < LNR; ++r) { const GAS f32x4* xr = (const GAS f32x4*)(p.out + (size_t)(m0 + r) * DM) + lane; s[r] = 0.f;
#pragma unroll
            for (int j = 0; j < 8; ++j) { v[r][j] = xr[64 * j]; s[r] += (v[r][j].x + v[r][j].y) + (v[r][j].z + v[r][j].w); } }
        float mean[LNR], rstd[LNR];
#pragma unroll
        for (int r = 0; r < LNR; ++r) mean[r] = wave_sum_dpp(s[r]) * (1.f / DM);
#pragma unroll
        for (int r = 0; r < LNR; ++r) { float s2 = 0.f;
#pragma unroll
            for (int j = 0; j < 8; ++j) { v[r][j] = v[r][j] - mean[r]; s2 += (v[r][j].x * v[r][j].x + v[r][j].y * v[r][j].y) + (v[r][j].z * v[r][j].z + v[r][j].w * v[r][j].w); }
            s[r] = s2; }
#pragma unroll
        for (int r = 0; r < LNR; ++r) rstd[r] = 1.0f / sqrtf(wave_sum_dpp(s[r]) * (1.f / DM) + LN_EPS);
#pragma unroll
        for (int r = 0; r < LNR; ++r) if (lane == r) ((GAS f32x2*)(ws + WS_STATS))[m0 + r] = (f32x2){mean[r], rstd[r]};
#pragma unroll
        for (int j = 0; j < 8; ++j) { const f32x4 g = g4[64 * j], b = b4[64 * j];
#pragma unroll
            for (int r = 0; r < LNR; ++r) { const f32x4 y = v[r][j] * rstd[r] * g + b;
                if (final_out) ((GAS f32x4*)(p.out + (size_t)(m0 + r) * DM) + lane)[64 * j] = y;
                if (!final_out) { u32x2 o; o.x = pk2(y.x, y.y); o.y = pk2(y.z, y.w); ((GAS u32x2*)(ws + WS_XB + (size_t)(m0 + r) * DM * 2) + lane)[64 * j] = o; } } }
    }
}

__device__ __forceinline__ void phase_ln_b(const Params& p, const float* gptr, const float* bptr, bool final_out) {
    const int tid = ltid(), lane = tid & 63, wave = tid >> 6;
    const int gw = blockIdx.x * NWAVES + wave, NGW = gridDim.x * NWAVES;
    const GAS float* gp = (const GAS float*)(gptr + (size_t)p.layer * DM) + lane * 8;
    const GAS float* bp = (const GAS float*)(bptr + (size_t)p.layer * DM) + lane * 8;
    GAS unsigned char* ws = (GAS unsigned char*)p.ws;
    for (int m0 = LNR * gw; m0 < M; m0 += LNR * NGW) {
        float v[LNR][4][8]; float s[LNR];
#pragma unroll
        for (int r = 0; r < LNR; ++r) { const GAS u32x4* yr = (const GAS u32x4*)(ws + WS_YB + (size_t)(m0 + r) * DM * 2) + lane; s[r] = 0.f;
            u32x4 t[4];
#pragma unroll
            for (int j = 0; j < 4; ++j) t[j] = yr[64 * j];
#pragma unroll
            for (int j = 0; j < 4; ++j) { v[r][j][0] = bflo(t[j].x); v[r][j][1] = bfhi(t[j].x); v[r][j][2] = bflo(t[j].y); v[r][j][3] = bfhi(t[j].y);
                v[r][j][4] = bflo(t[j].z); v[r][j][5] = bfhi(t[j].z); v[r][j][6] = bflo(t[j].w); v[r][j][7] = bfhi(t[j].w);
                s[r] += ((v[r][j][0] + v[r][j][1]) + (v[r][j][2] + v[r][j][3])) + ((v[r][j][4] + v[r][j][5]) + (v[r][j][6] + v[r][j][7])); } }
        float mean[LNR], rstd[LNR];
#pragma unroll
        for (int r = 0; r < LNR; ++r) mean[r] = wave_sum_dpp(s[r]) * (1.f / DM);
#pragma unroll
        for (int r = 0; r < LNR; ++r) { float s2 = 0.f;
#pragma unroll
            for (int j = 0; j < 4; ++j)
#pragma unroll
                for (int e = 0; e < 8; ++e) { v[r][j][e] -= mean[r]; s2 += v[r][j][e] * v[r][j][e]; }
            s[r] = s2; }
#pragma unroll
        for (int r = 0; r < LNR; ++r) rstd[r] = 1.0f / sqrtf(wave_sum_dpp(s[r]) * (1.f / DM) + LN_EPS);
#pragma unroll
        for (int r = 0; r < LNR; ++r) if (lane == r) ((GAS f32x2*)(ws + WS_STATS))[m0 + r] = (f32x2){mean[r], rstd[r]};
#pragma unroll
        for (int j = 0; j < 4; ++j) { const f32x4 g0 = *(const GAS f32x4*)(gp + 512 * j), g1 = *(const GAS f32x4*)(gp + 512 * j + 4), b0 = *(const GAS f32x4*)(bp + 512 * j), b1 = *(const GAS f32x4*)(bp + 512 * j + 4);
            const float gg[8] = {g0.x, g0.y, g0.z, g0.w, g1.x, g1.y, g1.z, g1.w}, bb[8] = {b0.x, b0.y, b0.z, b0.w, b1.x, b1.y, b1.z, b1.w};
#pragma unroll
            for (int r = 0; r < LNR; ++r) { float y[8];
#pragma unroll
                for (int e = 0; e < 8; ++e) y[e] = v[r][j][e] * rstd[r] * gg[e] + bb[e];
                if (final_out) { GAS f32x4* op = (GAS f32x4*)(p.out + (size_t)(m0 + r) * DM + 512 * j + lane * 8); op[0] = (f32x4){y[0], y[1], y[2], y[3]}; op[1] = (f32x4){y[4], y[5], y[6], y[7]}; }
                u32x4 o; o.x = pk2(y[0], y[1]); o.y = pk2(y[2], y[3]); o.z = pk2(y[4], y[5]); o.w = pk2(y[6], y[7]);
                ((GAS u32x4*)(ws + WS_XB + (size_t)(m0 + r) * DM * 2) + lane)[64 * j] = o; } }
    }
}

struct EpiProj {
    static constexpr bool PERM = true, AFTER_DRAIN = false;
    unsigned char* ws;
    __device__ __forceinline__ void operator()(const pg8::f32x4 (&acc)[2][2][4][2], const pg8::Unit& u, int wr, int wc, int fr, int fq) const {
        GAS unsigned char* w = (GAS unsigned char*)ws;
        const int row0 = u.pm * 256 + wr * 64 + fr, cin = wc * 32 + 8 * fq, pn = u.pn;
        if (pn < 28) {
            GAS bf16* base; int ld, colt; bool act = false;
            if (pn < 12) { base = (GAS bf16*)(w + WS_GQKV); ld = 3072; colt = pn * 256; }
            else if (pn < 16) { base = (GAS bf16*)(w + WS_ZB); ld = 1024; colt = (pn - 12) * 256; act = true; }
            else { const int t = (pn - 16) >> 2; base = (GAS bf16*)(w + WS_QB + (size_t)t * 64 * MiB); ld = 1024; colt = ((pn - 16) & 3) * 256; }
#pragma unroll
            for (int ai = 0; ai < 2; ++ai)
#pragma unroll
                for (int m = 0; m < 4; ++m) { GAS bf16* rowp = base + (size_t)(row0 + ai * 128 + m * 16) * ld + colt + cin;
#pragma unroll
                    for (int bj = 0; bj < 2; ++bj) { pg8::f32x4 v0 = acc[ai][bj][m][0], v1 = acc[ai][bj][m][1];
                        if (act) {
#pragma unroll
                            for (int j = 0; j < 4; ++j) { v0[j] = siluf_(v0[j]); v1[j] = siluf_(v1[j]); } }
                        u32x4 o; o.x = pk2(v0[0], v0[1]); o.y = pk2(v0[2], v0[3]); o.z = pk2(v1[0], v1[1]); o.w = pk2(v1[2], v1[3]);
                        *(GAS u32x4*)(rowp + bj * 128) = o; } }
        } else {
            typedef _Float16 h8_t __attribute__((ext_vector_type(8)));
#pragma unroll
            for (int ai = 0; ai < 2; ++ai)
#pragma unroll
                for (int m = 0; m < 4; ++m) { const size_t row = (size_t)(row0 + ai * 128 + m * 16);
#pragma unroll
                    for (int bj = 0; bj < 2; ++bj) { const pg8::f32x4 v0 = acc[ai][bj][m][0], v1 = acc[ai][bj][m][1];
                        const int c = (pn - 28) * 256 + bj * 128 + cin;
                        if (c < 576) { const h8_t o = {(_Float16)v0[0], (_Float16)v0[1], (_Float16)v0[2], (_Float16)v0[3], (_Float16)v1[0], (_Float16)v1[1], (_Float16)v1[2], (_Float16)v1[3]};
                            if (c < 512) *(GAS h8_t*)((GAS _Float16*)(w + WS_QI) + row * 512 + c) = o; else *(GAS h8_t*)((GAS _Float16*)(w + WS_KI) + row * 64 + (c - 512)) = o; }
                        else if (c < 600) { GAS float* d = (GAS float*)(w + WS_SM) + row * 32 + (c - 576); *(GAS pg8::f32x4*)d = v0; *(GAS pg8::f32x4*)(d + 4) = v1; } } }
        }
    }
};
struct EpiGate {
    static constexpr bool PERM = true, AFTER_DRAIN = false;
    unsigned char* ws;
    __device__ __forceinline__ void operator()(const pg8::f32x4 (&acc)[2][2][4][2], const pg8::Unit& u, int wr, int wc, int fr, int fq) const {
        GAS bf16* base = (GAS bf16*)((GAS unsigned char*)ws + WS_GATES);
        const int row0 = u.pm * 256 + wr * 64 + fr, col0 = u.pn * 256 + wc * 32 + 8 * fq;
#pragma unroll
        for (int ai = 0; ai < 2; ++ai)
#pragma unroll
            for (int m = 0; m < 4; ++m) { GAS bf16* rowp = base + (size_t)(row0 + ai * 128 + m * 16) * NGT + col0;
#pragma unroll
                for (int bj = 0; bj < 2; ++bj) { pg8::f32x4 v0 = acc[ai][bj][m][0], v1 = acc[ai][bj][m][1];
#pragma unroll
                    for (int j = 0; j < 4; ++j) { v0[j] = sigmoidf_(v0[j]); v1[j] = sigmoidf_(v1[j]); }
                    u32x4 o; o.x = pk2(v0[0], v0[1]); o.y = pk2(v0[2], v0[3]); o.z = pk2(v1[0], v1[1]); o.w = pk2(v1[2], v1[3]);
                    *(GAS u32x4*)(rowp + bj * 128) = o; } }
    }
};
template <int SECOND> struct EpiBranch {
    static constexpr bool PERM = true, AFTER_DRAIN = false;
    unsigned char* ws;
    __device__ __forceinline__ void operator()(const pg8::f32x4 (&acc)[2][2][4][2], const pg8::Unit& u, int wr, int wc, int fr, int fq) const {
        const GAS unsigned char* gates = (const GAS unsigned char*)ws + WS_GATES + (SECOND ? 2048 * 2 : 0);
        GAS unsigned char* mg = (GAS unsigned char*)ws + WS_MERGED;
        const int row0 = u.pm * 256 + wr * 64 + fr, col0 = u.pn * 256 + wc * 32 + 8 * fq;
#pragma unroll
        for (int ai = 0; ai < 2; ++ai) {
            u32x4 gv[4][2];
#pragma unroll
            for (int m = 0; m < 4; ++m)
#pragma unroll
                for (int bj = 0; bj < 2; ++bj) gv[m][bj] = *(const GAS u32x4*)(gates + ((size_t)(row0 + ai * 128 + m * 16) * NGT + col0 + bj * 128) * 2);
#pragma unroll
            for (int m = 0; m < 4; ++m)
#pragma unroll
                for (int bj = 0; bj < 2; ++bj) { const pg8::f32x4 v0 = acc[ai][bj][m][0], v1 = acc[ai][bj][m][1]; const u32x4 g = gv[m][bj];
                    float r[8] = {bflo(g.x) * v0[0], bfhi(g.x) * v0[1], bflo(g.y) * v0[2], bfhi(g.y) * v0[3], bflo(g.z) * v1[0], bfhi(g.z) * v1[1], bflo(g.w) * v1[2], bfhi(g.w) * v1[3]};
                    if (SECOND) { const u32x4 t = *(const GAS u32x4*)(mg + ((size_t)(row0 + ai * 128 + m * 16) * DM + col0 + bj * 128) * 2); r[0] += bflo(t.x); r[1] += bfhi(t.x); r[2] += bflo(t.y); r[3] += bfhi(t.y); r[4] += bflo(t.z); r[5] += bfhi(t.z); r[6] += bflo(t.w); r[7] += bfhi(t.w); }
                    u32x4 o; o.x = pk2(r[0], r[1]); o.y = pk2(r[2], r[3]); o.z = pk2(r[4], r[5]); o.w = pk2(r[6], r[7]);
                    *(GAS u32x4*)(mg + ((size_t)(row0 + ai * 128 + m * 16) * DM + col0 + bj * 128) * 2) = o; }
        }
    }
};
struct EpiResid {
    static constexpr bool PERM = false, AFTER_DRAIN = false;
    const float* yprev; float* out; const float* stats; const float* g; const float* b;
    __device__ __forceinline__ void operator()(const pg8::f32x4 (&acc)[2][2][4][2], const pg8::Unit& u, int wr, int wc, int fr, int fq) const {
        const int row0 = u.pm * 256 + wr * 64 + fr, col0 = u.pn * 256 + wc * 32 + 4 * fq;
        f32x4 gv[2][2], bv[2][2];
        if (g) {
#pragma unroll
            for (int bj = 0; bj < 2; ++bj)
#pragma unroll
                for (int n = 0; n < 2; ++n) { gv[bj][n] = *(const GAS f32x4*)(g + col0 + bj * 128 + n * 16); bv[bj][n] = *(const GAS f32x4*)(b + col0 + bj * 128 + n * 16); }
        }
#pragma unroll
        for (int ai = 0; ai < 2; ++ai)
#pragma unroll
            for (int mp = 0; mp < 2; ++mp) {
                f32x4 rr[2][2][2]; f32x2 ms[2];
#pragma unroll
                for (int mm = 0; mm < 2; ++mm) { const int row = row0 + ai * 128 + (2 * mp + mm) * 16; const size_t off = (size_t)row * DM + col0;
                    if (g) ms[mm] = ((const GAS f32x2*)stats)[row]; else { ms[mm].x = 0.f; ms[mm].y = 0.f; }
#pragma unroll
                    for (int bj = 0; bj < 2; ++bj)
#pragma unroll
                        for (int n = 0; n < 2; ++n) rr[mm][bj][n] = *(const GAS f32x4*)(yprev + off + bj * 128 + n * 16); }
#pragma unroll
                for (int mm = 0; mm < 2; ++mm) { const int m = 2 * mp + mm; const size_t off = (size_t)(row0 + ai * 128 + m * 16) * DM + col0;
#pragma unroll
                    for (int bj = 0; bj < 2; ++bj)
#pragma unroll
                        for (int n = 0; n < 2; ++n) { f32x4 r = rr[mm][bj][n];
                            if (g) r = (r - ms[mm].x) * ms[mm].y * gv[bj][n] + bv[bj][n];
                            *(GAS f32x4*)(out + off + bj * 128 + n * 16) = r * ALPHA + acc[ai][bj][m][n]; } }
            }
    }
};
struct EpiResidB {
    static constexpr bool PERM = true, AFTER_DRAIN = false;
    unsigned char* ws; const float* xf;
    __device__ __forceinline__ void operator()(const pg8::f32x4 (&acc)[2][2][4][2], const pg8::Unit& u, int wr, int wc, int fr, int fq) const {
        const int row0 = u.pm * 256 + wr * 64 + fr, col0 = u.pn * 256 + wc * 32 + 8 * fq;
        GAS unsigned char* yb = (GAS unsigned char*)ws + WS_YB;
#pragma unroll
        for (int ai = 0; ai < 2; ++ai) {
            float x[4][2][8];
            if (xf) {
                f32x4 t[4][2][2];
#pragma unroll
                for (int m = 0; m < 4; ++m)
#pragma unroll
                    for (int bj = 0; bj < 2; ++bj) { const GAS float* xp = (const GAS float*)xf + (size_t)(row0 + ai * 128 + m * 16) * DM + col0 + bj * 128; t[m][bj][0] = *(const GAS f32x4*)xp; t[m][bj][1] = *(const GAS f32x4*)(xp + 4); }
#pragma unroll
                for (int m = 0; m < 4; ++m)
#pragma unroll
                    for (int bj = 0; bj < 2; ++bj)
#pragma unroll
                        for (int e = 0; e < 4; ++e) { x[m][bj][e] = t[m][bj][0][e]; x[m][bj][4 + e] = t[m][bj][1][e]; }
            } else {
                u32x4 t[4][2];
#pragma unroll
                for (int m = 0; m < 4; ++m)
#pragma unroll
                    for (int bj = 0; bj < 2; ++bj) t[m][bj] = *(const GAS u32x4*)((const GAS unsigned char*)ws + WS_XB + ((size_t)(row0 + ai * 128 + m * 16) * DM + col0 + bj * 128) * 2);
#pragma unroll
                for (int m = 0; m < 4; ++m)
#pragma unroll
                    for (int bj = 0; bj < 2; ++bj) { const u32x4 q = t[m][bj]; x[m][bj][0] = bflo(q.x); x[m][bj][1] = bfhi(q.x); x[m][bj][2] = bflo(q.y); x[m][bj][3] = bfhi(q.y);
                        x[m][bj][4] = bflo(q.z); x[m][bj][5] = bfhi(q.z); x[m][bj][6] = bflo(q.w); x[m][bj][7] = bfhi(q.w); }
            }
#pragma unroll
            for (int m = 0; m < 4; ++m)
#pragma unroll
                for (int bj = 0; bj < 2; ++bj) { const pg8::f32x4 v0 = acc[ai][bj][m][0], v1 = acc[ai][bj][m][1];
                    float r[8];
#pragma unroll
                    for (int e = 0; e < 4; ++e) { r[e] = x[m][bj][e] * ALPHA + v0[e]; r[4 + e] = x[m][bj][4 + e] * ALPHA + v1[e]; }
                    u32x4 o; o.x = pk2(r[0], r[1]); o.y = pk2(r[2], r[3]); o.z = pk2(r[4], r[5]); o.w = pk2(r[6], r[7]);
                    *(GAS u32x4*)(yb + ((size_t)(row0 + ai * 128 + m * 16) * DM + col0 + bj * 128) * 2) = o; }
        }
    }
};
struct EpiResidC {
    static constexpr bool PERM = true, AFTER_DRAIN = false;
    unsigned char* ws; const float* xf; const float* g; const float* b; float* yf;
    __device__ __forceinline__ void operator()(const pg8::f32x4 (&acc)[2][2][4][2], const pg8::Unit& u, int wr, int wc, int fr, int fq) const {
        const int row0 = u.pm * 256 + wr * 64 + fr, col0 = u.pn * 256 + wc * 32 + 8 * fq;
        GAS unsigned char* yb = (GAS unsigned char*)ws + WS_YB;
        if (xf) {
#pragma unroll
            for (int ai = 0; ai < 2; ++ai)
#pragma unroll
                for (int mp = 0; mp < 2; ++mp) { f32x4 t[2][2][2];
#pragma unroll
                    for (int mm = 0; mm < 2; ++mm)
#pragma unroll
                        for (int bj = 0; bj < 2; ++bj) { const GAS float* xp = (const GAS float*)xf + (size_t)(row0 + ai * 128 + (2 * mp + mm) * 16) * DM + col0 + bj * 128; t[mm][bj][0] = *(const GAS f32x4*)xp; t[mm][bj][1] = *(const GAS f32x4*)(xp + 4); }
#pragma unroll
                    for (int mm = 0; mm < 2; ++mm)
#pragma unroll
                        for (int bj = 0; bj < 2; ++bj) { const int m = 2 * mp + mm; const pg8::f32x4 r0 = t[mm][bj][0] * ALPHA + acc[ai][bj][m][0], r1 = t[mm][bj][1] * ALPHA + acc[ai][bj][m][1];
                            u32x4 o; o.x = pk2(r0[0], r0[1]); o.y = pk2(r0[2], r0[3]); o.z = pk2(r1[0], r1[1]); o.w = pk2(r1[2], r1[3]);
                            *(GAS u32x4*)(yb + ((size_t)(row0 + ai * 128 + m * 16) * DM + col0 + bj * 128) * 2) = o; } }
            return;
        }
        f32x4 gv[2][2], bv[2][2];
#pragma unroll
        for (int bj = 0; bj < 2; ++bj)
#pragma unroll
            for (int n = 0; n < 2; ++n) { gv[bj][n] = *(const GAS f32x4*)((const GAS float*)g + col0 + bj * 128 + n * 4); bv[bj][n] = *(const GAS f32x4*)((const GAS float*)b + col0 + bj * 128 + n * 4); }
#pragma unroll
        for (int ai = 0; ai < 2; ++ai)
#pragma unroll
            for (int mp = 0; mp < 2; ++mp) {
                u32x4 t[2][2]; f32x2 ms[2];
#pragma unroll
                for (int mm = 0; mm < 2; ++mm) { const int row = row0 + ai * 128 + (2 * mp + mm) * 16; ms[mm] = ((const GAS f32x2*)((const GAS unsigned char*)ws + WS_STATS))[row];
#pragma unroll
                    for (int bj = 0; bj < 2; ++bj) t[mm][bj] = *(const GAS u32x4*)(yb + ((size_t)row * DM + col0 + bj * 128) * 2); }
#pragma unroll
                for (int mm = 0; mm < 2; ++mm)
#pragma unroll
                    for (int bj = 0; bj < 2; ++bj) { const int m = 2 * mp + mm; const u32x4 q = t[mm][bj];
                        pg8::f32x4 y0 = {bflo(q.x), bfhi(q.x), bflo(q.y), bfhi(q.y)}, y1 = {bflo(q.z), bfhi(q.z), bflo(q.w), bfhi(q.w)};
                        y0 = (y0 - ms[mm].x) * ms[mm].y * gv[bj][0] + bv[bj][0]; y1 = (y1 - ms[mm].x) * ms[mm].y * gv[bj][1] + bv[bj][1];
                        const pg8::f32x4 r0 = y0 * ALPHA + acc[ai][bj][m][0], r1 = y1 * ALPHA + acc[ai][bj][m][1];
                        if (yf) { GAS pg8::f32x4* op = (GAS pg8::f32x4*)((GAS float*)yf + (size_t)(row0 + ai * 128 + m * 16) * DM + col0 + bj * 128); op[0] = r0; op[1] = r1; }
                        else { u32x4 o; o.x = pk2(r0[0], r0[1]); o.y = pk2(r0[2], r0[3]); o.z = pk2(r1[0], r1[1]); o.w = pk2(r1[2], r1[3]);
                            *(GAS u32x4*)(yb + ((size_t)(row0 + ai * 128 + m * 16) * DM + col0 + bj * 128) * 2) = o; } }
            }
    }
};
struct EpiSwiGLU {
    static constexpr bool PERM = true, AFTER_DRAIN = false;
    unsigned char* ws;
    __device__ __forceinline__ void operator()(const pg8::f32x4 (&acc)[2][2][4][2], const pg8::Unit& u, int wr, int wc, int fr, int fq) const {
        GAS bf16* base = (GAS bf16*)((GAS unsigned char*)ws + WS_HID);
        const int row0 = u.pm * 256 + wr * 64 + fr, col0 = u.pn * 128 + wc * 32 + 8 * fq;
#pragma unroll
        for (int ai = 0; ai < 2; ++ai)
#pragma unroll
            for (int m = 0; m < 4; ++m) { GAS bf16* rowp = base + (size_t)(row0 + ai * 128 + m * 16) * DFF + col0;
                float r[8];
#pragma unroll
                for (int n = 0; n < 2; ++n)
#pragma unroll
                    for (int j = 0; j < 4; ++j) r[4 * n + j] = siluf_(acc[ai][0][m][n][j]) * acc[ai][1][m][n][j];
                u32x4 o; o.x = pk2(r[0], r[1]); o.y = pk2(r[2], r[3]); o.z = pk2(r[4], r[5]); o.w = pk2(r[6], r[7]);
                *(GAS u32x4*)rowp = o; }
    }
};

__device__ __forceinline__ float softplusf_(float x) { return fmaxf(x, 0.f) + __logf(1.0f + __expf(-fabsf(x))); }
__device__ __forceinline__ f32x4 mfma16(bf16x8 a, bf16x8 b, f32x4 c) { return __builtin_amdgcn_mfma_f32_16x16x32_bf16(a, b, c, 0, 0, 0); }

__device__ __forceinline__ void conv_ld_w(const GAS float* cw, f32x4 (&w)[4][2]) {
#pragma unroll
    for (int j = 0; j < 4; ++j) { w[j][0] = *(const GAS f32x4*)(cw + (size_t)j * 3072); w[j][1] = *(const GAS f32x4*)(cw + (size_t)j * 3072 + 4); }
}
__device__ __forceinline__ bf16x8 pack8s(const float (&y)[8], float sc) {
    u32x4 w; w.x = pk2(y[0] * sc, y[1] * sc); w.y = pk2(y[2] * sc, y[3] * sc); w.z = pk2(y[4] * sc, y[5] * sc); w.w = pk2(y[6] * sc, y[7] * sc);
    return __builtin_bit_cast(bf16x8, w);
}

__device__ __forceinline__ float row16_sum(float v) {
    v += __builtin_bit_cast(float, __builtin_amdgcn_update_dpp(0, __builtin_bit_cast(int, v), 0xB1, 0xF, 0xF, true));
    v += __builtin_bit_cast(float, __builtin_amdgcn_update_dpp(0, __builtin_bit_cast(int, v), 0x4E, 0xF, 0xF, true));
    v += __builtin_bit_cast(float, __builtin_amdgcn_update_dpp(0, __builtin_bit_cast(int, v), 0x141, 0xF, 0xF, true));
    v += __builtin_bit_cast(float, __builtin_amdgcn_update_dpp(0, __builtin_bit_cast(int, v), 0x140, 0xF, 0xF, true));
    return v;
}
__device__ __forceinline__ void phase_gdn_local(const Params& p, LAS unsigned char* lds) {
    const int tid = ltid(), lane0 = tid & 63, wave = __builtin_amdgcn_readfirstlane(tid >> 6);
    const int gw = blockIdx.x * NWAVES + wave, NGW = gridDim.x * NWAVES;
    GAS unsigned char* ws = (GAS unsigned char*)p.ws;
    const int l = p.layer;
    LAS float* Mw = (LAS float*)(lds + wave * 16384);
    const GAS float* cwl = (const GAS float*)p.conv_w + (size_t)l * 4 * 3072;
    for (int u = gw; u < NB * NCH * NH; u += NGW) {
        int lane = lane0; asm volatile("" : "+v"(lane));
        const int rb = lane >> 4, cc = lane & 15;
        const int b = u >> 10, n = (u >> 3) & 127, h = u & 7;
        const int t0 = n * CH; const size_t row0 = (size_t)b * SEQ + t0;
        const size_t hm0 = ((size_t)(b * NH + h) * SEQ + t0) * HD;
        const GAS unsigned char* gqb = ws + WS_GQKV + (row0 * 3072) * 2 - 3 * 6144;
#pragma unroll 1
        for (int tq = 0; tq < 3; ++tq) {
            const int gcol = (tq == 0 ? 2048 : (tq == 1 ? 1024 : 0)) + h * 128 + 8 * cc;
            f32x4 cw[4][2]; conv_ld_w(cwl + gcol, cw);
            u32x4 xr[19];
#pragma unroll
            for (int i = 0; i < 19; ++i) { const int tr = 16 * rb - 3 + i; const bool ok = (t0 + tr) >= 0;
                xr[i] = *(const GAS u32x4*)(gqb + (unsigned)((ok ? tr + 3 : 3) * 6144 + gcol * 2)); if (!ok) xr[i] = (u32x4){0u, 0u, 0u, 0u}; }
            GAS unsigned char* dst = ws + (tq == 0 ? WS_VN : (tq == 1 ? WS_KN : WS_QN)) + hm0 * 2;
            const float qs = (tq == 2) ? 0.08838834764831845f : 1.0f;
            float acc[4][8];
#pragma unroll
            for (int r = 0; r < 19; ++r) { const u32x4 x_ = xr[r];
                const float xv[8] = {bflo(x_.x), bfhi(x_.x), bflo(x_.y), bfhi(x_.y), bflo(x_.z), bfhi(x_.z), bflo(x_.w), bfhi(x_.w)};
#pragma unroll
                for (int j = 0; j < 4; ++j) { const int i = r - j;
                    if (i >= 0 && i < 16) {
                        const float wj[8] = {cw[j][0].x, cw[j][0].y, cw[j][0].z, cw[j][0].w, cw[j][1].x, cw[j][1].y, cw[j][1].z, cw[j][1].w};
#pragma unroll
                        for (int e = 0; e < 8; ++e) acc[i & 3][e] = (j == 0) ? xv[e] * wj[e] : acc[i & 3][e] + xv[e] * wj[e];
                        if (j == 3) {
                            float y[8]; float ss = 0.f;
#pragma unroll
                            for (int e = 0; e < 8; ++e) { y[e] = siluf_(acc[i & 3][e]); ss += y[e] * y[e]; }
                            float sc = 1.0f;
                            if (tq != 0) sc = qs * __builtin_amdgcn_rsqf(row16_sum(ss) + RMS_EPS);
                            *(GAS bf16x8*)(dst + (unsigned)(((16 * rb + i) * HD + 8 * cc) * 2)) = pack8s(y, sc);
                        }
                    }
                }
            }
        }
    }
    VM_WAIT();
    for (int u = gw; u < NB * NCH * NH; u += NGW) {
        int lane = lane0; asm volatile("" : "+v"(lane));
        const int g = lane >> 4, r16 = lane & 15;
        const int b = u >> 10, n = (u >> 3) & 127, h = u & 7;
        const int t0 = n * CH; const size_t row0 = (size_t)b * SEQ + t0;
        const size_t hm0 = ((size_t)(b * NH + h) * SEQ + t0) * HD;
        bf16x8 kf[4][4];
#pragma unroll
        for (int rt = 0; rt < 4; ++rt)
#pragma unroll
            for (int ks = 0; ks < 4; ++ks) kf[rt][ks] = *(const GAS bf16x8*)(ws + WS_KN + hm0 * 2 + (unsigned)(((16 * rt + r16) * HD + 32 * ks + 8 * g) * 2));
        bf16x8 qf[4][4];
#pragma unroll
        for (int rt = 0; rt < 4; ++rt)
#pragma unroll
            for (int ks = 0; ks < 4; ++ks) qf[rt][ks] = *(const GAS bf16x8*)(ws + WS_QN + hm0 * 2 + (unsigned)(((16 * rt + r16) * HD + 32 * ks + 8 * g) * 2));
        float gc, beta;
        { const GAS float* sm = (const GAS float*)(ws + WS_SM) + (row0 + lane) * 32;
          const float a_in = sm[8 + h], b_in = sm[16 + h];
          gc = -__expf(((const GAS float*)p.a_log)[l * NH + h]) * softplusf_(a_in + ((const GAS float*)p.dt_bias)[l * NH + h]);
          beta = 1.0f / (1.0f + __expf(-b_in));
#pragma unroll
          for (int o = 1; o < 64; o <<= 1) { const float t = __shfl_up(gc, o); if (lane >= o) gc += t; }
          GAS f32x2* gb = (GAS f32x2*)(ws + WS_GCB) + ((size_t)(b * NH + h) * SEQ + t0 + lane);
          *gb = (f32x2){gc, beta}; }
        float gi[4], bi[4], gj[4][4];
#pragma unroll
        for (int rt = 0; rt < 4; ++rt) { gi[rt] = __shfl(gc, 16 * rt + r16); bi[rt] = __shfl(beta, 16 * rt + r16); }
#pragma unroll
        for (int ct = 0; ct < 4; ++ct)
#pragma unroll
            for (int r = 0; r < 4; ++r) gj[ct][r] = __shfl(gc, 16 * ct + 4 * g + r);
        f32x4 mvals[10];
        { int ti = 0;
#pragma unroll
          for (int rt = 0; rt < 4; ++rt)
#pragma unroll
            for (int ct = 0; ct <= rt; ++ct) {
                const int i = 16 * rt + r16, j0 = 16 * ct + 4 * g;
                f32x4 kk = (f32x4){0.f, 0.f, 0.f, 0.f};
#pragma unroll
                for (int ks = 0; ks < 4; ++ks) kk = mfma16(kf[ct][ks], kf[rt][ks], kk);
#pragma unroll
                for (int r = 0; r < 4; ++r) { const int j = j0 + r; const float dec = __expf(fminf(gi[rt] - gj[ct][r], 0.f)); mvals[ti][r] = (j < i) ? bi[rt] * kk[r] * dec : 0.f; }
                ++ti; } }
        GAS bf16* Ag = (GAS bf16*)(ws + WS_AA) + (size_t)u * 4096;
        LDS_WAIT(); __builtin_amdgcn_wave_barrier(); asm volatile("" ::: "memory");
#pragma unroll
        for (int rt = 0; rt < 4; ++rt) {
            bf16x8 qfr[4];
#pragma unroll
            for (int ks = 0; ks < 4; ++ks) qfr[ks] = qf[rt][ks];
#pragma unroll
            for (int ct = 0; ct < 4; ++ct) {
                const int i = 16 * rt + r16, j0 = 16 * ct + 4 * g;
                if (ct <= rt) {
                    f32x4 qk = (f32x4){0.f, 0.f, 0.f, 0.f};
#pragma unroll
                    for (int ks = 0; ks < 4; ++ks) qk = mfma16(kf[ct][ks], qfr[ks], qk);
                    f32x4 av;
#pragma unroll
                    for (int r = 0; r < 4; ++r) { const int j = j0 + r; const float dec = __expf(fminf(gi[rt] - gj[ct][r], 0.f)); av[r] = (j <= i) ? qk[r] * dec : 0.f; }
                    u32x2 ao; ao.x = pk2(av[0], av[1]); ao.y = pk2(av[2], av[3]);
                    *(GAS u32x2*)((GAS unsigned char*)Ag + (unsigned)((i * 64 + j0) * 2)) = ao;
                } else {
                    { unsigned zz = 0u; asm volatile("" : "+v"(zz)); *(GAS u32x2*)((GAS unsigned char*)Ag + (unsigned)((i * 64 + j0) * 2)) = (u32x2){zz, zz}; }
                }
            }
            __builtin_amdgcn_sched_barrier(0);
        }
        LDS_WAIT(); __builtin_amdgcn_wave_barrier(); asm volatile("" ::: "memory");
        { int ti = 0;
#pragma unroll
          for (int rt = 0; rt < 4; ++rt)
#pragma unroll
            for (int ct = 0; ct <= rt; ++ct) { *(LAS f32x4*)(Mw + (16 * rt + r16) * 64 + 16 * ct + 4 * g) = mvals[ti]; ++ti; } }
        LDS_WAIT(); __builtin_amdgcn_wave_barrier(); asm volatile("" ::: "memory");
        {
            float x[64];
            GAS bf16* Tg = (GAS bf16*)(ws + WS_TT) + (size_t)u * 4096;
#pragma unroll
            for (int i = 0; i < 64; ++i) {
                float a0 = (i == lane) ? 1.f : 0.f, a1 = 0.f;
#pragma unroll
                for (int j4 = 0; j4 < (i + 3) / 4; ++j4) {
                    const f32x4 m = *(const LAS f32x4*)(Mw + i * 64 + 4 * j4);
#pragma unroll
                    for (int jj = 0; jj < 4; ++jj) { const int j = 4 * j4 + jj; if (j < i) { if (jj & 1) a1 -= m[jj] * x[j]; else a0 -= m[jj] * x[j]; } }
                }
                x[i] = a0 + a1;
                *(GAS bf16*)((GAS unsigned char*)Tg + (unsigned)((i * 64 + lane) * 2)) = (bf16)f2bf(x[i]);
            }
        }
        LDS_WAIT(); __builtin_amdgcn_wave_barrier(); asm volatile("" ::: "memory");
    }
}

#define TRRD(dst, addr, off) asm volatile("ds_read_b64_tr_b16 %0, %1 offset:%2" : "=&v"(dst) : "v"(addr), "i"(off) : "memory")
__device__ __forceinline__ bf16x8 cat4(s16x4 a, s16x4 b) { return (bf16x8){a[0], a[1], a[2], a[3], b[0], b[1], b[2], b[3]}; }
__device__ __forceinline__ bf16x8 pack_cc(f32x4 a, f32x4 b) { u32x4 w; w.x = pk2(a[0], a[1]); w.y = pk2(a[2], a[3]); w.z = pk2(b[0], b[1]); w.w = pk2(b[2], b[3]); return __builtin_bit_cast(bf16x8, w); }

constexpr int SC_K = 0, SC_Q = 17408, SC_V = 34816, SC_O = 52224, SC_T = 69632, SC_A = 78848, SC_GB = 88064, SC_END = 88576;
constexpr int SC_P1 = 272, SC_P2 = 144;

__device__ __forceinline__ void gdn_scan_bh(const Params& p, LAS unsigned char* lds, int bh) {
    const int b = bh >> 3, h = bh & 7;
    const int tid = ltid(), lane = tid & 63, w = tid >> 6, g = lane >> 4, i16 = lane & 15;
    GAS unsigned char* ws = (GAS unsigned char*)p.ws;
    const GAS bf16* KN = (const GAS bf16*)(ws + WS_KN) + (size_t)bh * SEQ * HD;
    const GAS bf16* QN = (const GAS bf16*)(ws + WS_QN) + (size_t)bh * SEQ * HD;
    const GAS bf16* VN = (const GAS bf16*)(ws + WS_VN) + (size_t)bh * SEQ * HD;
    const GAS f32x2* GCB = (const GAS f32x2*)(ws + WS_GCB) + (size_t)bh * SEQ;
    GAS bf16* OA = (GAS bf16*)(ws + WS_OA) + (size_t)b * SEQ * 1024 + h * 128;
    u32x4 st_k[2], st_q[2], st_v[2], st_t, st_a; f32x2 st_gb = (f32x2){0.f, 0.f};
    const int prow = tid >> 4, pch = tid & 15;
    const int trow_ = tid >> 3, tch = tid & 7;
#define SC_LOAD(n_) do { const size_t e0 = (size_t)(n_) * CH * HD; const size_t uu = ((size_t)(b * NCH + (n_)) * NH + h) * 4096; \
        _Pragma("unroll") for (int i_ = 0; i_ < 2; ++i_) { const size_t eo = e0 + (size_t)(prow + 32 * i_) * HD + pch * 8; \
            st_k[i_] = *(const GAS u32x4*)(KN + eo); st_q[i_] = *(const GAS u32x4*)(QN + eo); st_v[i_] = *(const GAS u32x4*)(VN + eo); } \
        st_t = *(const GAS u32x4*)((const GAS bf16*)(ws + WS_TT) + uu + trow_ * 64 + tch * 8); st_a = *(const GAS u32x4*)((const GAS bf16*)(ws + WS_AA) + uu + trow_ * 64 + tch * 8); \
        if (tid < 64) st_gb = GCB[(n_) * CH + tid]; } while (0)
#define SC_WRITE() do { _Pragma("unroll") for (int i_ = 0; i_ < 2; ++i_) { const int o_ = (prow + 32 * i_) * SC_P1 + pch * 16; \
            *(LAS u32x4*)(lds + SC_K + o_) = st_k[i_]; *(LAS u32x4*)(lds + SC_Q + o_) = st_q[i_]; *(LAS u32x4*)(lds + SC_V + o_) = st_v[i_]; } \
        *(LAS u32x4*)(lds + SC_T + trow_ * SC_P2 + tch * 16) = st_t; *(LAS u32x4*)(lds + SC_A + trow_ * SC_P2 + tch * 16) = st_a; \
        if (tid < 64) { ((LAS float*)(lds + SC_GB))[tid] = st_gb.x; ((LAS float*)(lds + SC_GB))[64 + tid] = st_gb.y; } } while (0)
#define SC_LOADZ(n_) do { _Pragma("unroll") for (int i_ = 0; i_ < 2; ++i_) st_z[i_] = *(const GAS u32x4*)(ZBp + (size_t)((n_) * CH + prow + 32 * i_) * 1024 + pch * 8); } while (0)
#define SC_OUT(n_) do { _Pragma("unroll") for (int i_ = 0; i_ < 2; ++i_) { const u32x4 ov_ = *(const LAS u32x4*)(lds + SC_O + (prow + 32 * i_) * SC_P1 + pch * 16); const u32x4 zv_ = st_z[i_]; \
            float o_[8] = {bflo(ov_.x), bfhi(ov_.x), bflo(ov_.y), bfhi(ov_.y), bflo(ov_.z), bfhi(ov_.z), bflo(ov_.w), bfhi(ov_.w)};                          \
            const float z_[8] = {bflo(zv_.x), bfhi(zv_.x), bflo(zv_.y), bfhi(zv_.y), bflo(zv_.z), bfhi(zv_.z), bflo(zv_.w), bfhi(zv_.w)};                    \
            float ss_ = 0.f; _Pragma("unroll") for (int e = 0; e < 8; ++e) ss_ += o_[e] * o_[e];                                                           \
            ss_ = row16_sum(ss_); const float rs_ = __builtin_amdgcn_rsqf(ss_ * (1.0f / HD) + RMS_EPS);                                                     \
            _Pragma("unroll") for (int e = 0; e < 8; ++e) o_[e] = o_[e] * rs_ * nwv[e] * z_[e];                                                            \
            u32x4 r_; r_.x = pk2(o_[0], o_[1]); r_.y = pk2(o_[2], o_[3]); r_.z = pk2(o_[4], o_[5]); r_.w = pk2(o_[6], o_[7]);                               \
            *(GAS u32x4*)(OA + (size_t)((n_) * CH + prow + 32 * i_) * 1024 + pch * 8) = r_; } } while (0)
    u32x4 st_z[2];
    const GAS bf16* ZBp = (const GAS bf16*)(ws + WS_ZB) + (size_t)b * SEQ * 1024 + h * 128;
    float nwv[8];
    { const GAS float* nwp = (const GAS float*)p.gdn_norm_w + (size_t)p.layer * HD + pch * 8; const f32x4 n0 = *(const GAS f32x4*)nwp, n1 = *(const GAS f32x4*)(nwp + 4);
      nwv[0] = n0.x; nwv[1] = n0.y; nwv[2] = n0.z; nwv[3] = n0.w; nwv[4] = n1.x; nwv[5] = n1.y; nwv[6] = n1.z; nwv[7] = n1.w; }
    SC_LOAD(0); SC_WRITE();
    __syncthreads();
    f32x4 Sacc[8];
#pragma unroll
    for (int dt = 0; dt < 8; ++dt) Sacc[dt] = (f32x4){0.f, 0.f, 0.f, 0.f};
    const unsigned rdA = (unsigned)(i16 * SC_P1 + 8 * g);
    const unsigned rdT = (unsigned)(i16 * SC_P2 + 8 * g);
    const unsigned ldsb = (unsigned)(uintptr_t)lds;
    const unsigned trq = (unsigned)((i16 >> 2) * SC_P1 + (i16 & 3) * 8);
    const unsigned trV = ldsb + SC_V + trq + (unsigned)(4 * g * SC_P1 + 32 * w);
    const unsigned trK = ldsb + SC_K + trq + (unsigned)(4 * g * SC_P1);
    for (int n = 0; n < NCH; ++n) {
        if (n > 0) SC_OUT(n - 1);
        SC_LOADZ(n);
        if (n + 1 < NCH) SC_LOAD(n + 1);
        bf16x8 Sb[4];
#pragma unroll
        for (int ks = 0; ks < 4; ++ks) Sb[ks] = pack_cc(Sacc[2 * ks], Sacc[2 * ks + 1]);
        f32x4 KS[4], QS[4];
#pragma unroll
        for (int ct = 0; ct < 4; ++ct) { KS[ct] = (f32x4){0.f, 0.f, 0.f, 0.f}; QS[ct] = (f32x4){0.f, 0.f, 0.f, 0.f};
#pragma unroll
            for (int ks = 0; ks < 4; ++ks) {
                const LAS unsigned char* ka = lds + SC_K + rdA + ct * 16 * SC_P1 + ks * 64; const LAS unsigned char* qa = lds + SC_Q + rdA + ct * 16 * SC_P1 + ks * 64;
                const bf16x8 kfr = cat4(*(const LAS s16x4*)ka, *(const LAS s16x4*)(ka + 32)); const bf16x8 qfr = cat4(*(const LAS s16x4*)qa, *(const LAS s16x4*)(qa + 32));
                KS[ct] = mfma16(kfr, Sb[ks], KS[ct]); QS[ct] = mfma16(qfr, Sb[ks], QS[ct]); } }
        s16x4 vv[4];
#pragma unroll
        for (int ct = 0; ct < 4; ++ct) TRRD(vv[ct], trV, ct * 16 * SC_P1);
        f32x4 gcv[4], btv[4];
#pragma unroll
        for (int ct = 0; ct < 4; ++ct) { gcv[ct] = *(const LAS f32x4*)(lds + SC_GB + (16 * ct + 4 * g) * 4); btv[ct] = *(const LAS f32x4*)(lds + SC_GB + 256 + (16 * ct + 4 * g) * 4); }
        const float gl = ((const LAS float*)(lds + SC_GB))[63];
        asm volatile("s_waitcnt lgkmcnt(0)" : "+v"(vv[0]), "+v"(vv[1]), "+v"(vv[2]), "+v"(vv[3]) :: "memory");
        f32x4 eg[4], tmp[4];
#pragma unroll
        for (int ct = 0; ct < 4; ++ct)
#pragma unroll
            for (int r = 0; r < 4; ++r) { eg[ct][r] = __expf(gcv[ct][r]); tmp[ct][r] = btv[ct][r] * (bf2f((unsigned short)vv[ct][r]) - eg[ct][r] * KS[ct][r]); }
        bf16x8 tb[2]; tb[0] = pack_cc(tmp[0], tmp[1]); tb[1] = pack_cc(tmp[2], tmp[3]);
        f32x4 vn[4];
#pragma unroll
        for (int ct = 0; ct < 4; ++ct) { vn[ct] = (f32x4){0.f, 0.f, 0.f, 0.f};
#pragma unroll
            for (int k2 = 0; k2 < 2; ++k2) { const LAS unsigned char* ta = lds + SC_T + rdT + ct * 16 * SC_P2 + k2 * 64;
                vn[ct] = mfma16(cat4(*(const LAS s16x4*)ta, *(const LAS s16x4*)(ta + 32)), tb[k2], vn[ct]); } }
        bf16x8 vb[2]; vb[0] = pack_cc(vn[0], vn[1]); vb[1] = pack_cc(vn[2], vn[3]);
        f32x4 o[4];
#pragma unroll
        for (int ct = 0; ct < 4; ++ct) { o[ct] = QS[ct] * eg[ct];
#pragma unroll
            for (int k2 = 0; k2 < 2; ++k2) { const LAS unsigned char* aa = lds + SC_A + rdT + ct * 16 * SC_P2 + k2 * 64;
                o[ct] = mfma16(cat4(*(const LAS s16x4*)aa, *(const LAS s16x4*)(aa + 32)), vb[k2], o[ct]); } }
        f32x4 vd[4];
#pragma unroll
        for (int ct = 0; ct < 4; ++ct)
#pragma unroll
            for (int r = 0; r < 4; ++r) vd[ct][r] = vn[ct][r] * __expf(gl - gcv[ct][r]);
        bf16x8 vdb[2]; vdb[0] = pack_cc(vd[0], vd[1]); vdb[1] = pack_cc(vd[2], vd[3]);
        const float gt = __expf(gl);
#pragma unroll
        for (int dt = 0; dt < 8; ++dt) {
            s16x4 a0, a1, a2, a3;
            TRRD(a0, trK, dt * 32); TRRD(a1, trK, dt * 32 + 16 * SC_P1); TRRD(a2, trK, dt * 32 + 32 * SC_P1); TRRD(a3, trK, dt * 32 + 48 * SC_P1);
            asm volatile("s_waitcnt lgkmcnt(0)" : "+v"(a0), "+v"(a1), "+v"(a2), "+v"(a3) :: "memory");
            Sacc[dt] = Sacc[dt] * gt;
            Sacc[dt] = mfma16(cat4(a0, a1), vdb[0], Sacc[dt]);
            Sacc[dt] = mfma16(cat4(a2, a3), vdb[1], Sacc[dt]);
        }
        __syncthreads();
        if (n + 1 < NCH) SC_WRITE();
#pragma unroll
        for (int ct = 0; ct < 4; ++ct)
#pragma unroll
            for (int r = 0; r < 4; ++r) *(LAS bf16*)(lds + SC_O + (16 * ct + 4 * g + r) * SC_P1 + (16 * w + i16) * 2) = (bf16)f2bf(o[ct][r]);
        __syncthreads();
    }
    SC_OUT(NCH - 1);
    __syncthreads();
#undef SC_LOAD
#undef SC_WRITE
#undef SC_OUT
#undef SC_LOADZ
}
__device__ __forceinline__ void phase_gdn_scan(const Params& p, LAS unsigned char* lds) {
    if (blockIdx.x >= NB * NH) return;
    gdn_scan_bh(p, lds, (int)blockIdx.x);
}

__device__ __forceinline__ void finalize_oa(const Params& p) {
    const int tid = ltid(), lane = tid & 63, wave = tid >> 6;
    const int gw = blockIdx.x * NWAVES + wave, NGW = gridDim.x * NWAVES;
    GAS unsigned char* ws = (GAS unsigned char*)p.ws;
    const GAS float* nwp = (const GAS float*)p.gdn_norm_w + (size_t)p.layer * HD + (lane & 15) * 8;
    const f32x4 n0 = *(const GAS f32x4*)nwp, n1 = *(const GAS f32x4*)(nwp + 4);
    for (int m = gw; m < M; m += NGW) {
#pragma unroll
        for (int hf = 0; hf < 2; ++hf) {
            const size_t off = ((size_t)m * 1024 + hf * 512 + lane * 8) * 2;
            const u32x4 ov = *(const GAS u32x4*)(ws + WS_OA + off), zv = *(const GAS u32x4*)(ws + WS_ZB + off);
            float o[8] = {bflo(ov.x), bfhi(ov.x), bflo(ov.y), bfhi(ov.y), bflo(ov.z), bfhi(ov.z), bflo(ov.w), bfhi(ov.w)};
            const float z[8] = {bflo(zv.x), bfhi(zv.x), bflo(zv.y), bfhi(zv.y), bflo(zv.z), bfhi(zv.z), bflo(zv.w), bfhi(zv.w)};
            float ss = 0.f;
#pragma unroll
            for (int e = 0; e < 8; ++e) ss += o[e] * o[e];
            ss = row16_sum(ss);
            const float rs = __builtin_amdgcn_rsqf(ss * (1.0f / HD) + RMS_EPS);
            const float nv[8] = {n0.x, n0.y, n0.z, n0.w, n1.x, n1.y, n1.z, n1.w};
#pragma unroll
            for (int e = 0; e < 8; ++e) o[e] = o[e] * rs * nv[e] * z[e];
            u32x4 r; r.x = pk2(o[0], o[1]); r.y = pk2(o[2], o[3]); r.z = pk2(o[4], o[5]); r.w = pk2(o[6], o[7]);
            *(GAS u32x4*)(ws + WS_OA + off) = r;
        }
    }
}

constexpr int IX_CAPW = 128;
constexpr int IX_POS = 65536;
constexpr int IX_MT = 98304;
constexpr int IX_META = 131072;
constexpr int IXM_SEGC = 0, IXM_CHI = 128, IXM_LO = 256, IXM_HI = 272, IXM_TAU = 288, IXM_FAIL = 304, IXM_PREF = 320, IXM_KREM = 336;
typedef _Float16 h2_t __attribute__((ext_vector_type(2)));
__device__ __forceinline__ float relu_i(float x) { const int b = __builtin_bit_cast(int, x); return __builtin_bit_cast(float, b > 0 ? b : 0); }
__device__ __forceinline__ unsigned fkey(float s) { const unsigned u = __builtin_bit_cast(unsigned, s); return u ^ ((u >> 31) ? 0xFFFFFFFFu : 0x80000000u); }

constexpr int IX_HIST = IX_META + 4096;
__device__ __forceinline__ unsigned wave_incl_scan(unsigned v) {
    v += (unsigned)__builtin_amdgcn_update_dpp(0, (int)v, 0x111, 0xf, 0xf, false);
    v += (unsigned)__builtin_amdgcn_update_dpp(0, (int)v, 0x112, 0xf, 0xf, false);
    v += (unsigned)__builtin_amdgcn_update_dpp(0, (int)v, 0x114, 0xf, 0xf, false);
    v += (unsigned)__builtin_amdgcn_update_dpp(0, (int)v, 0x118, 0xf, 0xf, false);
    v += (unsigned)__builtin_amdgcn_update_dpp(0, (int)v, 0x142, 0xa, 0xf, false);
    v += (unsigned)__builtin_amdgcn_update_dpp(0, (int)v, 0x143, 0xc, 0xf, false);
    return v;
}
struct IxKeys { unsigned n[8]; unsigned e[8][2]; };
__device__ __forceinline__ void ix_load_keys(IxKeys& K, const LAS unsigned* list, const LAS unsigned* segc, int q, int lane) {
#pragma unroll
    for (int s = 0; s < 8; ++s) { const unsigned c = (unsigned)__builtin_amdgcn_readfirstlane((int)segc[q * 8 + s]); K.n[s] = c < (unsigned)IX_CAPW ? c : (unsigned)IX_CAPW; }
#pragma unroll
    for (int s = 0; s < 8; ++s) { K.e[s][0] = list[(q * 8 + s) * IX_CAPW + lane]; K.e[s][1] = list[(q * 8 + s) * IX_CAPW + 64 + lane]; }
}
__device__ __forceinline__ unsigned ix_round(const IxKeys& K, LAS unsigned* hist, unsigned prefix, int shift, bool first, unsigned& k, int lane) {
    *(LAS u32x4*)(hist + 4 * lane) = zero4_();
    const unsigned dumpw = 256u + (unsigned)lane;
#pragma unroll
    for (int s = 0; s < 8; ++s) {
#pragma unroll
        for (int r = 0; r < 2; ++r) { const unsigned e = K.e[s][r]; const bool ok = ((unsigned)(r * 64 + lane) < K.n[s]) && (first || ((e >> (shift + 8)) == (prefix >> (shift + 8))));
            __hip_atomic_fetch_add(hist + (ok ? ((e >> shift) & 255u) : dumpw), 1u, __ATOMIC_RELAXED, __HIP_MEMORY_SCOPE_WORKGROUP); }
    }
    LDS_WAIT(); __builtin_amdgcn_wave_barrier(); asm volatile("" ::: "memory");
    const u32x4 c4 = *(const LAS u32x4*)(hist + 4 * lane);
    const unsigned tot = c4.x + c4.y + c4.z + c4.w;
    const unsigned pre = wave_incl_scan(tot);
    const unsigned all = (unsigned)__builtin_amdgcn_readlane((int)pre, 63);
    const unsigned suf = all - pre + tot;
    const unsigned long long bal = __ballot(suf >= k);
    const int L = bal ? (63 - __builtin_clzll(bal)) : 0;
    unsigned d = 0u, nk = k;
    { unsigned run = suf - tot;
      if (run + c4.w >= k) { d = 3u; nk = k - run; } else { run += c4.w;
      if (run + c4.z >= k) { d = 2u; nk = k - run; } else { run += c4.z;
      if (run + c4.y >= k) { d = 1u; nk = k - run; } else { run += c4.y; d = 0u; nk = k - run; } } } }
    d = (unsigned)__builtin_amdgcn_readlane((int)d, L); k = (unsigned)__builtin_amdgcn_readlane((int)nk, L);
    __builtin_amdgcn_wave_barrier(); asm volatile("" ::: "memory");
    return (unsigned)(4 * L) + d;
}

template <int MODE>
__device__ __forceinline__ void ix_pass(const GAS _Float16* KIb, GAS unsigned* MASKg, LAS unsigned* lst, LAS unsigned* meta, const f16x8 (&af)[4][4], const unsigned (&wv)[4][2][4],
                                        int t0, int ntiles, int w_in, int lane_in) {
    int lane = lane_in; asm volatile("" : "+v"(lane));
    int w = w_in; asm volatile("" : "+s"(w));
    const int c32 = lane & 31, hh = lane >> 5;
    const unsigned ltm = (1u << c32) - 1u;
    const unsigned dump = (unsigned)((IX_META + 2048) / 4 + w * 64 + lane);
    const unsigned dumpp = (unsigned)((IX_META + 2048 - IX_POS) / 2 + w * 64 + lane);
    unsigned thr_a[4][2], thr_b[4][2];
#pragma unroll
    for (int T4 = 0; T4 < 4; ++T4)
#pragma unroll
        for (int qs = 0; qs < 2; ++qs) { const int ql = 4 * T4 + 2 * hh + qs;
            thr_a[T4][qs] = (MODE == 1) ? meta[IXM_LO + ql] : (MODE == 2) ? meta[IXM_TAU + ql] : (MODE >= 4) ? meta[IXM_PREF + ql] : 0u;
            thr_b[T4][qs] = (MODE == 1) ? meta[IXM_HI + ql] : 0u; }
    unsigned cntA[8], cntB[8], chiA[8], chiB[8];
#pragma unroll
    for (int i = 0; i < 8; ++i) { cntA[i] = 0u; cntB[i] = 0u; chiA[i] = 0u; chiB[i] = 0u; }
    const int kstep = (MODE == 0) ? 64 : 8, kfirst = (MODE == 0) ? (8 * w + 3) : w;
    f16x8 bnx[4];
    if (kfirst < ntiles) {
#pragma unroll
        for (int s = 0; s < 4; ++s) bnx[s] = *(const GAS f16x8*)(KIb + (size_t)(kfirst * 32 + c32) * 64 + 16 * s + 8 * hh);
    }
    for (int kt = kfirst; kt < ntiles; kt += kstep) {
        const int key = kt * 32 + c32;
        f16x8 bfr[4];
#pragma unroll
        for (int s = 0; s < 4; ++s) bfr[s] = bnx[s];
        if (kt + kstep < ntiles) {
#pragma unroll
            for (int s = 0; s < 4; ++s) bnx[s] = *(const GAS f16x8*)(KIb + (size_t)((kt + kstep) * 32 + c32) * 64 + 16 * s + 8 * hh);
        }
        unsigned mwv = 0u;
#pragma unroll
        for (int T4 = 0; T4 < 4; ++T4) {
            f32x16 acc = {};
#pragma unroll
            for (int s = 0; s < 4; ++s) acc = __builtin_amdgcn_mfma_f32_32x32x16_f16(af[T4][s], bfr[s], acc, 0, 0, 0);
#pragma unroll
            for (int qs = 0; qs < 2; ++qs) {
                float sc = 0.f;
#pragma unroll
                for (int h = 0; h < 4; ++h) {
                    const float r0 = relu_i(acc[8 * qs + 2 * h]), r1 = relu_i(acc[8 * qs + 2 * h + 1]);
                    asm volatile("v_fma_mix_f32 %0, %1, %2, %0 op_sel:[0,0,0] op_sel_hi:[1,0,0]" : "+v"(sc) : "v"(wv[T4][qs][h]), "v"(r0));
                    asm volatile("v_fma_mix_f32 %0, %1, %2, %0 op_sel:[1,0,0] op_sel_hi:[1,0,0]" : "+v"(sc) : "v"(wv[T4][qs][h]), "v"(r1)); }
                const int ql = 4 * T4 + 2 * hh + qs, idx = 2 * T4 + qs;
                const bool valid = key <= t0 + ql;
                const unsigned uk = fkey(sc);
                if constexpr (MODE == 0 || MODE == 1) {
                    bool pred = valid;
                    if constexpr (MODE == 1) {
                        const bool ge = valid && (uk >= thr_b[T4][qs]);
                        const unsigned long long bg = __ballot(ge);
                        mwv = (lane == 4 * T4 + qs) ? (unsigned)bg : mwv; mwv = (lane == 4 * T4 + 2 + qs) ? (unsigned)(bg >> 32) : mwv;
                        chiA[idx] = (unsigned)__builtin_amdgcn_readfirstlane((int)(chiA[idx] + (unsigned)__builtin_popcount((unsigned)bg))); chiB[idx] = (unsigned)__builtin_amdgcn_readfirstlane((int)(chiB[idx] + (unsigned)__builtin_popcount((unsigned)(bg >> 32))));
                        pred = valid && !ge && (uk >= thr_a[T4][qs]);
                    }
                    const unsigned long long bal = __ballot(pred);
                    const unsigned blo = (unsigned)bal, bhi = (unsigned)(bal >> 32);
                    const unsigned slot = (hh ? cntB[idx] : cntA[idx]) + (unsigned)__builtin_popcount((hh ? bhi : blo) & ltm);
                    const bool okw = pred && slot < (unsigned)IX_CAPW;
                    const unsigned addr = okw ? (unsigned)((ql * 8 + w) * IX_CAPW) + slot : dump;
                    lst[addr] = uk;
                    if constexpr (MODE == 1) ((LAS unsigned short*)((LAS unsigned char*)lst + IX_POS))[okw ? addr : dumpp] = (unsigned short)key;
                    cntA[idx] = (unsigned)__builtin_amdgcn_readfirstlane((int)(cntA[idx] + (unsigned)__builtin_popcount(blo))); cntB[idx] = (unsigned)__builtin_amdgcn_readfirstlane((int)(cntB[idx] + (unsigned)__builtin_popcount(bhi)));
                } else if constexpr (MODE == 2) {
                    const bool sel = valid && (uk >= thr_a[T4][qs]);
                    const unsigned long long bal = __ballot(sel);
                    mwv = (lane == 4 * T4 + qs) ? (unsigned)bal : mwv; mwv = (lane == 4 * T4 + 2 + qs) ? (unsigned)(bal >> 32) : mwv;
                } else if constexpr (MODE == 3) { if (valid) __hip_atomic_fetch_add(&lst[ql * 2048 + (uk >> 21)], 1u, __ATOMIC_RELAXED, __HIP_MEMORY_SCOPE_WORKGROUP); }
                else if constexpr (MODE == 4) { if (valid && (uk >> 21) == thr_a[T4][qs]) __hip_atomic_fetch_add(&lst[ql * 2048 + ((uk >> 10) & 2047u)], 1u, __ATOMIC_RELAXED, __HIP_MEMORY_SCOPE_WORKGROUP); }
                else { if (valid && (uk >> 10) == thr_a[T4][qs]) __hip_atomic_fetch_add(&lst[ql * 2048 + (uk & 1023u)], 1u, __ATOMIC_RELAXED, __HIP_MEMORY_SCOPE_WORKGROUP); }
            }
        }
        if constexpr (MODE == 1 || MODE == 2) { if (lane < 16) ((LAS unsigned*)((LAS unsigned char*)lst + IX_MT))[lane * 256 + kt] = mwv; }
    }
    if constexpr (MODE == 0 || MODE == 1) {
        if (lane == 0) {
#pragma unroll
            for (int T4 = 0; T4 < 4; ++T4)
#pragma unroll
                for (int qs = 0; qs < 2; ++qs) { const int idx = 2 * T4 + qs, qa = 4 * T4 + qs, qb = qa + 2;
                    meta[IXM_SEGC + qa * 8 + w] = cntA[idx]; meta[IXM_SEGC + qb * 8 + w] = cntB[idx];
                    if constexpr (MODE == 1) { meta[IXM_CHI + qa * 8 + w] = chiA[idx]; meta[IXM_CHI + qb * 8 + w] = chiB[idx]; } }
        }
    }
}

__device__ __forceinline__ void phase_indexer(const Params& p, LAS unsigned char* lds) {
    const int tid = ltid(), lane0 = tid & 63, w = __builtin_amdgcn_readfirstlane(tid >> 6);
    GAS unsigned char* ws = (GAS unsigned char*)p.ws;
    const GAS _Float16* QI = (const GAS _Float16*)(ws + WS_QI);
    const GAS _Float16* KI = (const GAS _Float16*)(ws + WS_KI);
    const GAS float* SM = (const GAS float*)(ws + WS_SM);
    GAS unsigned* MASK = (GAS unsigned*)(ws + WS_MASK);
    LAS unsigned* lst = (LAS unsigned*)lds;
    LAS unsigned* meta = (LAS unsigned*)(lds + IX_META);
    LAS unsigned* hist = (LAS unsigned*)(lds + IX_HIST) + w * 320;
    const int G = gridDim.x, bid = blockIdx.x;
    constexpr int NGRP = NB * SEQ / 16;
    for (int it = 0;; ++it) {
        const int pos = it * G + ((it & 1) ? (G - 1 - bid) : bid);
        if (pos >= NGRP) break;
        int lane = lane0; asm volatile("" : "+v"(lane));
        const int c32 = lane & 31, hh = lane >> 5;
        const int tq = pos >> 2, b = pos & 3, t0 = tq * 16;
        const size_t rowbase = (size_t)b * SEQ + t0;
        f16x8 af[4][4]; unsigned wv[4][2][4];
        { const int a = c32 >> 3, bb = (c32 >> 2) & 1, c = c32 & 3, hd = c + 4 * (a & 1), qsub = a >> 1;
#pragma unroll
          for (int T4 = 0; T4 < 4; ++T4) { const int ql = 4 * T4 + 2 * bb + qsub;
#pragma unroll
              for (int s = 0; s < 4; ++s) af[T4][s] = *(const GAS f16x8*)(QI + (rowbase + ql) * 512 + hd * 64 + 16 * s + 8 * hh); }
#pragma unroll
          for (int T4 = 0; T4 < 4; ++T4)
#pragma unroll
              for (int qs = 0; qs < 2; ++qs) { const GAS float* wp = SM + (rowbase + 4 * T4 + 2 * hh + qs) * 32;
                  const f32x4 w0 = *(const GAS f32x4*)wp, w1 = *(const GAS f32x4*)(wp + 4);
                  wv[T4][qs][0] = __builtin_bit_cast(unsigned, (h2_t){(_Float16)w0.x, (_Float16)w0.y}); wv[T4][qs][1] = __builtin_bit_cast(unsigned, (h2_t){(_Float16)w0.z, (_Float16)w0.w});
                  wv[T4][qs][2] = __builtin_bit_cast(unsigned, (h2_t){(_Float16)w1.x, (_Float16)w1.y}); wv[T4][qs][3] = __builtin_bit_cast(unsigned, (h2_t){(_Float16)w1.z, (_Float16)w1.w}); } }
        const int ntiles = (t0 + 15) / 32 + 1;
        const GAS _Float16* KIb = KI + (size_t)b * SEQ * 64;
        GAS unsigned* MASKg = MASK + rowbase * 256;
        const bool small = (t0 + 16 <= 8 * IX_CAPW);
        if (tid < 16) { meta[IXM_LO + tid] = 0u; meta[IXM_HI + tid] = 0xFFFFFFFFu; meta[IXM_TAU + tid] = 0u; }
        if (tid == 0) meta[IXM_FAIL] = 0u;
#pragma unroll
        for (int i = 0; i < 2; ++i) *(LAS u32x4*)(lds + IX_MT + (size_t)(i * NTHR + tid) * 16) = zero4_();
        __syncthreads();
        if (!small) {
            ix_pass<0>(KIb, MASKg, lst, meta, af, wv, t0, ntiles, w, lane);
            __syncthreads();
#pragma unroll 1
            for (int qq = 0; qq < 2; ++qq) { const int q = 2 * w + qq;
                unsigned ns = 0u;
                for (int s = 0; s < 8; ++s) ns += meta[IXM_SEGC + q * 8 + s];
                ns = (unsigned)__builtin_amdgcn_readfirstlane((int)ns);
                unsigned lo = 0u, hi = 0xFFFFFFFFu;
                if (ns >= 72u) { IxKeys K; ix_load_keys(K, lst, meta + IXM_SEGC, q, lane);
                    unsigned k1 = 72u; const unsigned d1 = ix_round(K, hist, 0u, 24, true, k1, lane); const unsigned d2 = ix_round(K, hist, d1 << 24, 16, false, k1, lane); lo = (d1 << 24) | (d2 << 16);
                    unsigned k2 = 12u; const unsigned g1 = ix_round(K, hist, 0u, 24, true, k2, lane); const unsigned g2 = ix_round(K, hist, g1 << 24, 16, false, k2, lane); const unsigned ph = (g1 << 24) | (g2 << 16);
                    hi = (ph >= 0xFFFF0000u) ? 0xFFFFFFFFu : ph + 0x10000u; }
                if (lane == 0) { meta[IXM_LO + q] = lo; meta[IXM_HI + q] = hi; } }
            __syncthreads();
        }
        ix_pass<1>(KIb, MASKg, lst, meta, af, wv, t0, ntiles, w, lane);
        __syncthreads();
#pragma unroll 1
        for (int qq = 0; qq < 2; ++qq) { const int q = 2 * w + qq;
            const bool allsel = (t0 + q + 1 <= 256);
            unsigned n = 0u, chi = 0u, over = 0u;
            for (int s = 0; s < 8; ++s) { const unsigned c = meta[IXM_SEGC + q * 8 + s]; n += c; over |= (c > (unsigned)IX_CAPW) ? 1u : 0u; chi += meta[IXM_CHI + q * 8 + s]; }
            n = (unsigned)__builtin_amdgcn_readfirstlane((int)n); chi = (unsigned)__builtin_amdgcn_readfirstlane((int)chi); over = (unsigned)__builtin_amdgcn_readfirstlane((int)over);
            if (!allsel && (over || chi >= 256u || chi + n < 256u)) { if (lane == 0) meta[IXM_FAIL] = 1u; continue; }
            const unsigned lo_ = (unsigned)__builtin_amdgcn_readfirstlane((int)meta[IXM_LO + q]), hi_ = (unsigned)__builtin_amdgcn_readfirstlane((int)meta[IXM_HI + q]);
            const unsigned df = lo_ ^ (hi_ - 1u);
            const int sh0 = (df >> 24) ? 24 : ((df >> 16) ? 16 : ((df >> 8) ? 8 : 0));
            unsigned tau = (sh0 == 24) ? 0u : (lo_ & (0xFFFFFFFFu << (sh0 + 8)));
            unsigned kk = 256u - chi;
            { IxKeys K; ix_load_keys(K, lst, meta + IXM_SEGC, q, lane);
              if (allsel) tau = 0u; else { for (int sh = sh0; sh >= 0; sh -= 8) tau |= ix_round(K, hist, tau, sh, sh == 24, kk, lane) << sh; }
              LAS unsigned* mt = (LAS unsigned*)(lds + IX_MT) + q * 256; const LAS unsigned short* pl = (const LAS unsigned short*)(lds + IX_POS);
#pragma unroll
              for (int s = 0; s < 8; ++s)
#pragma unroll
                  for (int r = 0; r < 2; ++r) { const bool on = ((unsigned)(r * 64 + lane) < K.n[s]) && (K.e[s][r] >= tau);
                      const unsigned ps = pl[(q * 8 + s) * IX_CAPW + r * 64 + lane];
                      if (on) __hip_atomic_fetch_or(mt + (ps >> 5), 1u << (ps & 31u), __ATOMIC_RELAXED, __HIP_MEMORY_SCOPE_WORKGROUP); } }
            if (lane == 0) meta[IXM_TAU + q] = tau; }
        __syncthreads();
        if (meta[IXM_FAIL] != 0u) {
            __syncthreads();
            if (tid < 16) { meta[IXM_PREF + tid] = 0u; meta[IXM_KREM + tid] = 256u; }
#pragma unroll 1
            for (int pass = 0; pass < 3; ++pass) {
#pragma unroll
                for (int i = 0; i < 16; ++i) *(LAS u32x4*)(lds + (size_t)(i * NTHR + tid) * 16) = zero4_();
                __syncthreads();
                if (pass == 0) ix_pass<3>(KIb, MASKg, lst, meta, af, wv, t0, ntiles, w, lane);
                else if (pass == 1) ix_pass<4>(KIb, MASKg, lst, meta, af, wv, t0, ntiles, w, lane);
                else ix_pass<5>(KIb, MASKg, lst, meta, af, wv, t0, ntiles, w, lane);
                __syncthreads();
#pragma unroll 1
                for (int qq = 0; qq < 2; ++qq) {
                    const int q = 2 * w + qq;
                    if (t0 + q + 1 <= 256) { if (lane == 0 && pass == 2) meta[IXM_TAU + q] = 0u; continue; }
                    const int per = (pass == 2) ? 16 : 32, base = lane * per;
                    unsigned cnt = 0;
                    for (int i = 0; i < per; ++i) cnt += lst[q * 2048 + base + i];
                    unsigned suf = cnt;
#pragma unroll
                    for (int o = 1; o < 64; o <<= 1) { const unsigned t = __shfl_down(suf, o); if (lane + o < 64) suf += t; }
                    const unsigned kr = meta[IXM_KREM + q];
                    const unsigned long long bal = __ballot(suf >= kr);
                    const int L = bal ? (63 - __builtin_clzll(bal)) : 0;
                    unsigned binv = 0, nkr = kr;
                    if (lane == L) { unsigned run = suf - cnt;
                        for (int i = per - 1; i >= 0; --i) { const unsigned c = lst[q * 2048 + base + i]; if (run + c >= kr) { binv = (unsigned)(base + i); nkr = kr - run; break; } run += c; } }
                    binv = __shfl(binv, L); nkr = __shfl(nkr, L);
                    if (lane == 0) { const unsigned pr = meta[IXM_PREF + q];
                        const unsigned npr = (pass == 0) ? binv : ((pass == 1) ? ((pr << 11) | binv) : ((pr << 10) | binv));
                        meta[IXM_PREF + q] = npr; meta[IXM_KREM + q] = nkr; if (pass == 2) meta[IXM_TAU + q] = npr; }
                }
                __syncthreads();
            }
#pragma unroll
            for (int i = 0; i < 2; ++i) *(LAS u32x4*)(lds + IX_MT + (size_t)(i * NTHR + tid) * 16) = zero4_();
            __syncthreads();
            ix_pass<2>(KIb, MASKg, lst, meta, af, wv, t0, ntiles, w, lane);
            __syncthreads();
        }
        { const int last = ((t0 >> 8) << 3) + 7; const int row = tid >> 5, c4 = (tid & 31) * 4;
#pragma unroll
          for (int i = 0; i < 2; ++i) { const int cw = c4 + 128 * i; if (cw <= last) *(GAS u32x4*)(MASKg + (size_t)row * 256 + cw) = *(const LAS u32x4*)(lds + IX_MT + (row * 256 + cw) * 4); } }
        __syncthreads();
    }
}

namespace at {
constexpr float SCALE = 0.08838834764831845f;
constexpr int D = 128, PITCH = 1024;
constexpr int NW = 8, QBLK = 32, KVBLK = 64, QB = NW * QBLK;
constexpr int SHM_V = KVBLK * D * 2, SHM_K = KVBLK * D * 2;
constexpr int OFF_WS = 2 * SHM_V + 2 * SHM_K;
constexpr int OFF_BLUT = OFF_WS + NW * 64 * 4;
constexpr int LDS_NEED = OFF_BLUT + 8 * 132 * 4;
constexpr float THR = 8.f;

#define KSWZ(row, colB) ((row) * 256 + ((colB) ^ (((row) & 7) << 4)))
#define SBAR() __builtin_amdgcn_sched_barrier(0)
__device__ __forceinline__ int v_st(int k, int c) { const int kk = (k & ~0xC) | ((k & 4) << 1) | ((k & 8) >> 1); return ((kk >> 3) * 4 + (c >> 5)) * 512 + ((kk & 7) * 32 + (c & 31)) * 2; }
__device__ __forceinline__ int v_rd_base(int lane) { return ((lane & 3) << 3) | (((lane >> 2) & 3) << 6) | (((lane >> 4) & 1) << 5) | (((lane >> 5) & 1) << 8); }
constexpr int v_rd_off(int d0, int ks, int half) { return d0 * 512 + ks * 4096 + half * 2048; }
__device__ __forceinline__ int crow(int r, int hi) { return (r & 3) + 8 * (r >> 2) + 4 * hi; }
__device__ __forceinline__ bf16x8 load8(const GAS bf16* p) { return *(const GAS bf16x8*)p; }

__device__ __forceinline__ void mask_tile(f32x16& p0, f32x16& p1, int dq) {
    const float NEG = -__builtin_inff();
#pragma unroll
    for (int r = 0; r < 16; ++r) {
        const int c = (r & 3) + 8 * (r >> 2);
        if (dq - c < 0) p0[r] = NEG;
        if (dq - c - 32 < 0) p1[r] = NEG;
    }
}
__device__ __forceinline__ void bias_tile(f32x16& p0, f32x16& p1, int dq, const float* bl) {
#pragma unroll
    for (int r = 0; r < 16; ++r) {
        const int c = (r & 3) + 8 * (r >> 2);
        int d0 = dq - c, d1 = dq - c - 32;
        d0 = d0 < 0 ? 0 : (d0 > 128 ? 128 : d0); d1 = d1 < 0 ? 0 : (d1 > 128 ? 128 : d1);
        p0[r] += bl[d0]; p1[r] += bl[d1];
    }
}
__device__ __forceinline__ void partialSM(f32x16& p0, f32x16& p1, float& m_reg, float& mn, float& alpha, float cb, unsigned mlo) {
    float pmax = p0[0];
#pragma unroll
    for (int r = 1; r < 16; ++r) pmax = fmaxf(pmax, p0[r]);
#pragma unroll
    for (int r = 0; r < 16; ++r) pmax = fmaxf(pmax, p1[r]);
    { auto rr = __builtin_amdgcn_permlane32_swap(__float_as_uint(pmax), __float_as_uint(pmax), false, false);
      pmax = fmaxf(__uint_as_float(rr[0]), __uint_as_float(rr[1])); }
    pmax += cb;
    constexpr float C2 = 1.4426950408889634f * SCALE;
    if (__builtin_expect(__all((pmax - m_reg) * SCALE <= THR), 1)) { mn = m_reg; alpha = 1.f; }
    else { mn = fmaxf(m_reg, pmax); alpha = __builtin_amdgcn_exp2f((m_reg - mn) * C2); m_reg = mn; }
    const float mnL = (cb - mn) * C2;
#pragma unroll
    for (int r = 0; r < 16; ++r) p0[r] = fmaf(p0[r], C2, mnL);
#pragma unroll
    for (int r = 0; r < 16; ++r) p1[r] = fmaf(p1[r], C2, mnL);
#pragma unroll
    for (int r = 0; r < 16; ++r) { const int c = (r & 3) + 8 * (r >> 2);
        int sm_ = __builtin_amdgcn_sbfe((int)mlo, (unsigned)c, 1u); asm volatile("" : "+v"(sm_));
        p0[r] = __uint_as_float(__float_as_uint(__builtin_amdgcn_exp2f(p0[r])) & (unsigned)sm_); }
}
__device__ __forceinline__ void finishSM(f32x16& p0, f32x16& p1, float alpha, float& l_reg, bf16x8& pa0, bf16x8& pa1, bf16x8& pa2, bf16x8& pa3, unsigned mhi) {
#pragma unroll
    for (int r = 0; r < 16; ++r) { const int c = (r & 3) + 8 * (r >> 2);
        int sm_ = __builtin_amdgcn_sbfe((int)mhi, (unsigned)c, 1u); asm volatile("" : "+v"(sm_));
        p1[r] = __uint_as_float(__float_as_uint(__builtin_amdgcn_exp2f(p1[r])) & (unsigned)sm_); }
    float ps = 0;
#pragma unroll
    for (int r = 0; r < 16; ++r) ps += p0[r];
#pragma unroll
    for (int r = 0; r < 16; ++r) ps += p1[r];
    { auto rr = __builtin_amdgcn_permlane32_swap(__float_as_uint(ps), __float_as_uint(ps), false, false);
      ps = __uint_as_float(rr[0]) + __uint_as_float(rr[1]); }
    l_reg = l_reg * alpha + ps;
#define PK4(P, B_, OUT) do { unsigned a0 = pk2(P[B_+0], P[B_+1]), a1 = pk2(P[B_+2], P[B_+3]);                          \
        unsigned b0 = pk2(P[B_+4], P[B_+5]), b1 = pk2(P[B_+6], P[B_+7]);                                             \
        auto r0 = __builtin_amdgcn_permlane32_swap(a0, b0, false, false); auto r1 = __builtin_amdgcn_permlane32_swap(a1, b1, false, false); \
        u32x4 w = {r0[0], r1[0], r0[1], r1[1]}; OUT = *reinterpret_cast<bf16x8*>(&w); } while (0)
    PK4(p0, 0, pa0); PK4(p0, 8, pa1); PK4(p1, 0, pa2); PK4(p1, 8, pa3);
#undef PK4
}
template <int KB>
__device__ __forceinline__ void qkt(f32x16& p0, f32x16& p1, int ka0, const bf16x8* qr) {
#define KRD2(dx, dy, d0) do { int t_; asm volatile("v_xor_b32 %2, %4, %3\n\tds_read_b128 %0, %2 offset:%5\n\tds_read_b128 %1, %2 offset:%6"                       \
        : "=&v"(dx), "=&v"(dy), "=&v"(t_) : "v"(ka0), "i"(((d0) & 3) << 5), "i"(KB * SHM_K + ((d0) >> 2) * 128), "i"(KB * SHM_K + ((d0) >> 2) * 128 + 32 * 256) : "memory"); } while (0)
#define KWAIT(n, x, y) asm volatile("s_waitcnt lgkmcnt(" #n ")" : "+v"(x), "+v"(y) :: "memory")
    bf16x8 a0, a1, b0, b1;
    KRD2(a0, a1, 0); KRD2(b0, b1, 1);
    KWAIT(2, a0, a1);
    p0 = __builtin_amdgcn_mfma_f32_32x32x16_bf16(a0, qr[0], f32x16{}, 0, 0, 0); p1 = __builtin_amdgcn_mfma_f32_32x32x16_bf16(a1, qr[0], f32x16{}, 0, 0, 0);
    KRD2(a0, a1, 2);
    KWAIT(2, b0, b1);
    p0 = __builtin_amdgcn_mfma_f32_32x32x16_bf16(b0, qr[1], p0, 0, 0, 0); p1 = __builtin_amdgcn_mfma_f32_32x32x16_bf16(b1, qr[1], p1, 0, 0, 0);
    KRD2(b0, b1, 3);
#define QK_PAIR(d0, LASTW)                                                                                                        \
    KWAIT(2, a0, a1);                                                                                                            \
    p0 = __builtin_amdgcn_mfma_f32_32x32x16_bf16(a0, qr[d0], p0, 0, 0, 0); p1 = __builtin_amdgcn_mfma_f32_32x32x16_bf16(a1, qr[d0], p1, 0, 0, 0);             \
    if ((d0) + 2 < 8) { KRD2(a0, a1, (d0) + 2); KWAIT(2, b0, b1); } else { KWAIT(0, b0, b1); }                \
    p0 = __builtin_amdgcn_mfma_f32_32x32x16_bf16(b0, qr[(d0) + 1], p0, 0, 0, 0); p1 = __builtin_amdgcn_mfma_f32_32x32x16_bf16(b1, qr[(d0) + 1], p1, 0, 0, 0);   \
    if ((d0) + 3 < 8) { KRD2(b0, b1, (d0) + 3); }
    QK_PAIR(2, 0) QK_PAIR(4, 0) QK_PAIR(6, 1)
#undef QK_PAIR
#undef KRD2
#undef KWAIT
}
template <int VB>
__device__ __forceinline__ void pv_tile(f32x16* o, int vb0, bf16x8 pa0, bf16x8 pa1, bf16x8 pa2, bf16x8 pa3) {
#define TRRDA(dst, off) asm volatile("ds_read_b64_tr_b16 %0, %1 offset:%2" : "=&v"(dst) : "v"(vb0), "i"(off) : "memory")
#define PV_D0(d0) do { s16x4 l0, l1, l2, l3, h0, h1, h2, h3; constexpr int b_ = VB * SHM_V + v_rd_off(d0, 0, 0); \
        TRRDA(l0, b_); TRRDA(h0, b_ + 2048); TRRDA(l1, b_ + 4096); TRRDA(h1, b_ + 6144); TRRDA(l2, b_ + 8192); TRRDA(h2, b_ + 10240); TRRDA(l3, b_ + 12288); TRRDA(h3, b_ + 14336); \
        asm volatile("s_waitcnt lgkmcnt(0)" : "+v"(l0), "+v"(h0), "+v"(l1), "+v"(h1), "+v"(l2), "+v"(h2), "+v"(l3), "+v"(h3) :: "memory"); SBAR();   \
        o[d0] = __builtin_amdgcn_mfma_f32_32x32x16_bf16(pa0, (bf16x8){l0[0], l0[1], l0[2], l0[3], h0[0], h0[1], h0[2], h0[3]}, o[d0], 0, 0, 0);   \
        o[d0] = __builtin_amdgcn_mfma_f32_32x32x16_bf16(pa1, (bf16x8){l1[0], l1[1], l1[2], l1[3], h1[0], h1[1], h1[2], h1[3]}, o[d0], 0, 0, 0);   \
        o[d0] = __builtin_amdgcn_mfma_f32_32x32x16_bf16(pa2, (bf16x8){l2[0], l2[1], l2[2], l2[3], h2[0], h2[1], h2[2], h2[3]}, o[d0], 0, 0, 0);   \
        o[d0] = __builtin_amdgcn_mfma_f32_32x32x16_bf16(pa3, (bf16x8){l3[0], l3[1], l3[2], l3[3], h3[0], h3[1], h3[2], h3[3]}, o[d0], 0, 0, 0); } while (0)
    PV_D0(0); PV_D0(1); PV_D0(2); PV_D0(3);
#undef PV_D0
#undef TRRDA
}

__device__ __forceinline__ int lane_fresh() { int l; asm volatile("v_mbcnt_lo_u32_b32 %0, -1, 0\n\tv_mbcnt_hi_u32_b32 %0, -1, %0" : "=v"(l)); return l; }
struct BlockRef { const GAS bf16* Q; const GAS bf16* K; const GAS bf16* V; GAS bf16* O; const GAS unsigned long long* MW; int P0; int h; };
struct Seam { bf16x8 qr[8]; };
#define VMW() asm volatile("s_waitcnt vmcnt(0)" ::: "memory")
#define DMA16(gp, ldsoff) __builtin_amdgcn_global_load_lds((const GAS unsigned*)(gp), (LAS unsigned*)(ldsw_ + (ldsoff)), 16, 0, 0)
#define KDMA(Kbytes, bf) do { DMA16((Kbytes) + koff0, 2 * SHM_V + (bf) * SHM_K); DMA16((Kbytes) + koff1, 2 * SHM_V + (bf) * SHM_K + 1024); } while (0)
#define VDMA(Vbytes, bf) do { DMA16((Vbytes) + voff0, (bf) * SHM_V); DMA16((Vbytes) + voff1, (bf) * SHM_V + 1024); } while (0)
#define DMA_OFFS()                                                                                                             \
    LAS unsigned char* ldsw_ = (LAS unsigned char*)lds + wid * 2048;                                \
    unsigned koff0, koff1, voff0, voff1;                                                                                       \
    { const int r0 = wid * 8 + (lane >> 4), r1 = r0 + 4, pc = lane & 15;                                                       \
      koff0 = (unsigned)(r0 * PITCH * 2 + ((pc ^ (r0 & 7)) << 4)); koff1 = (unsigned)(r1 * PITCH * 2 + ((pc ^ (r1 & 7)) << 4)); \
      const int kl = (lane & 31) >> 2, c8 = lane & 3;                                                                          \
      const int sub0 = wid * 4 + (lane >> 5), sub1 = sub0 + 2;                                                                 \
      const int kk0 = (sub0 >> 2) * 8 + kl, kk1 = (sub1 >> 2) * 8 + kl;                                                        \
      const int k0_ = (kk0 & ~0xC) | ((kk0 & 4) << 1) | ((kk0 & 8) >> 1), k1_ = (kk1 & ~0xC) | ((kk1 & 4) << 1) | ((kk1 & 8) >> 1); \
      voff0 = (unsigned)(k0_ * PITCH * 2 + ((sub0 & 3) * 32 + c8 * 8) * 2); voff1 = (unsigned)(k1_ * PITCH * 2 + ((sub1 & 3) * 32 + c8 * 8) * 2); }
constexpr unsigned TILE_BYTES = KVBLK * PITCH * 2;
__device__ __forceinline__ void attn_prime(const BlockRef& cur, char* lds, Seam& S) {
    const int tid = ltid(), wid = __builtin_amdgcn_readfirstlane(tid >> 6), lane = tid & 63, r32 = lane & 31, hi = lane >> 5;
    DMA_OFFS();
#pragma unroll
    for (int d0 = 0; d0 < 8; ++d0) S.qr[d0] = load8(cur.Q + (unsigned)((wid * QBLK + r32) * PITCH + d0 * 16 + hi * 8));
    KDMA((const GAS unsigned char*)cur.K, 0); (void)voff0; (void)voff1; VMW();
    __syncthreads();
}
__device__ __forceinline__ void attn_block(const BlockRef& cur, const BlockRef& nxt, char* lds, Seam& S) {
    const int tid = ltid(), wid = __builtin_amdgcn_readfirstlane(tid >> 6), lane = tid & 63, r32 = lane & 31, hi = lane >> 5;
    const int NT = (cur.P0 + QB - 1) / KVBLK + 1;
    const int qlo = cur.P0 + wid * QBLK, qm = qlo + r32 - 4 * hi;
    char* V_lds = lds; char* K_lds = lds + 2 * SHM_V;
    const float* bl = (const float*)(lds + OFF_BLUT) + cur.h * 132;
    const float cb_far = __builtin_bit_cast(float, __builtin_amdgcn_readfirstlane(__builtin_bit_cast(int, bl[128])));
    float m_reg = -1e30f, l_reg = 0; f32x16 o[4] = {};
    DMA_OFFS();
    const int vb0 = (int)(uintptr_t)V_lds + v_rd_base(lane);
    const int ka = (int)(uintptr_t)K_lds + KSWZ(r32, hi * 16);
    const GAS unsigned char* Kh = (const GAS unsigned char*)cur.K; const GAS unsigned char* Vh = (const GAS unsigned char*)cur.V;
    const GAS unsigned char* mbase = (const GAS unsigned char*)cur.MW; const unsigned moff = (unsigned)(qlo + r32) * 1024u;
#define RESC(a) do { if (__any((a) < 1.f)) { const int l_ = lane_fresh(), r_ = l_ & 31, h_ = l_ >> 5; float* al_ = (float*)(lds + OFF_WS) + wid * 64 + 32;   \
                     if (h_ == 0) al_[r_] = (a); asm volatile("s_waitcnt lgkmcnt(0)" ::: "memory");                                     \
                     for (int d_ = 0; d_ < 4; ++d_) for (int r = 0; r < 16; ++r) o[d_][r] *= al_[crow(r, h_)]; } } while (0)
#define KBASE(t) ((t) * KVBLK)
#define PREP(P0_, P1_, t, cbv) do { const int kb_ = KBASE(t);                                                                   \
        if (kb_ > qlo - 191) { bias_tile(P0_, P1_, qm - kb_, bl); cbv = 0.f; } else cbv = cb_far; } while (0)
#define MLOAD(mv, t) do { mv = *(const GAS unsigned long long*)(mbase + moff + (unsigned)(t) * 8u); } while (0)
#define MLO(mv) ((unsigned)(mv) >> (4 * hi))
#define MHI(mv) ((unsigned)((mv) >> 32) >> (4 * hi))
    f32x16 pA0, pA1, pB0, pB1; float mnA, mnB, alA, alB; bf16x8 pa0, pa1, pa2, pa3; unsigned long long mA, mB; float cbA, cbB;
    SBAR(); KDMA(Kh + TILE_BYTES, 1); VDMA(Vh, 0); MLOAD(mA, 0);
    SBAR(); qkt<0>(pA0, pA1, ka, S.qr);
    PREP(pA0, pA1, 0, cbA); partialSM(pA0, pA1, m_reg, mnA, alA, cbA, MLO(mA));
    VMW(); __syncthreads();
#define STEP(PX0, PX1, mnX, alX, mX, cbX, PY0, PY1, alY, mY, t, KB, VB, KSRC) do {                                              \
        SBAR(); KDMA(KSRC, (KB) ^ 1); VDMA(Vh + (unsigned)(t) * TILE_BYTES, (VB) ^ 1); MLOAD(mX, t); SBAR();                    \
        qkt<KB>(PX0, PX1, ka, S.qr); SBAR();                                                                                  \
        finishSM(PY0, PY1, alY, l_reg, pa0, pa1, pa2, pa3, MHI(mY)); SBAR();                                                   \
        pv_tile<VB>(o, vb0, pa0, pa1, pa2, pa3); SBAR();                                                                      \
        PREP(PX0, PX1, (t), cbX); partialSM(PX0, PX1, m_reg, mnX, alX, cbX, MLO(mX)); SBAR();                                  \
        RESC(alX); VMW(); __syncthreads(); } while (0)
    for (int t = 1; t + 1 < NT; t += 2) {
        STEP(pB0, pB1, mnB, alB, mB, cbB, pA0, pA1, alA, mA, t, 1, 0, Kh + (unsigned)(t + 1) * TILE_BYTES);
        STEP(pA0, pA1, mnA, alA, mA, cbA, pB0, pB1, alB, mB, t + 1, 0, 1, Kh + (unsigned)(t + 2) * TILE_BYTES);
    }
    STEP(pB0, pB1, mnB, alB, mB, cbB, pA0, pA1, alA, mA, NT - 1, 1, 0, (const GAS unsigned char*)nxt.K);
    finishSM(pB0, pB1, alB, l_reg, pa0, pa1, pa2, pa3, MHI(mB)); SBAR();
    { const int l_ = lane_fresh(), r_ = l_ & 31, h_ = l_ >> 5;
#pragma unroll
      for (int d0 = 0; d0 < 8; ++d0) S.qr[d0] = load8(nxt.Q + (unsigned)((wid * QBLK + r_) * PITCH + d0 * 16 + h_ * 8)); }
    SBAR(); pv_tile<1>(o, vb0, pa0, pa1, pa2, pa3);
    SBAR();
    { const int l_ = lane_fresh(), r_ = l_ & 31, h_ = l_ >> 5; float* li_ = (float*)(lds + OFF_WS) + wid * 64;
      if (h_ == 0) li_[r_] = l_reg; asm volatile("s_waitcnt lgkmcnt(0)" ::: "memory");
      float rli[16];
#pragma unroll
      for (int r = 0; r < 16; ++r) rli[r] = __builtin_amdgcn_rcpf(li_[crow(r, h_)]);
      GAS bf16* Ow = cur.O + (unsigned)((wid * QBLK) * PITCH);
#pragma unroll
      for (int r = 0; r < 16; ++r) { const int orow = crow(r, h_);
#pragma unroll
        for (int d0 = 0; d0 < 4; ++d0) { const float v = o[d0][r] * rli[r];
            const float vn = __shfl_xor(v, 1);
            if ((r_ & 1) == 0) *(GAS unsigned*)(Ow + (unsigned)(orow * PITCH + d0 * 32 + r_)) = pk2(v, vn); } } }
#undef RESC
#undef KBASE
#undef PREP
#undef MLOAD
#undef MLO
#undef MHI
#undef STEP
}
#undef VMW
#undef DMA16
#undef KDMA
#undef VDMA
#undef DMA_OFFS
}

constexpr int ATT_NQB = SEQ / at::QB, ATT_ITEMS = ATT_NQB * NB * NH;
constexpr size_t WS_QCTR = WS_CTL + 512 * 1024;
__device__ __forceinline__ at::BlockRef attn_mkref(unsigned char* ws, int Li) {
    const int qb = ATT_NQB - 1 - ((Li & 127) >> 2), bh = (Li >> 7) * 4 + (Li & 3), b = bh >> 3, h = bh & 7;
    at::BlockRef r; const size_t rb = (size_t)b * SEQ;
    GAS unsigned char* wg = (GAS unsigned char*)ws;
    r.Q = (const GAS bf16*)(wg + WS_QB) + (rb + (size_t)qb * at::QB) * at::PITCH + h * 128; r.O = (GAS bf16*)(wg + WS_OB) + (rb + (size_t)qb * at::QB) * at::PITCH + h * 128;
    r.K = (const GAS bf16*)(wg + WS_KB) + rb * at::PITCH + h * 128; r.V = (const GAS bf16*)(wg + WS_VB) + rb * at::PITCH + h * 128;
    r.MW = (const GAS unsigned long long*)(wg + WS_MASK) + rb * 128; r.P0 = qb * at::QB; r.h = h; return r;
}
__device__ __forceinline__ int attn_fetch(gu32* ctr, volatile LAS unsigned* slot, int tid) {
    if (tid == 0) {
        unsigned v = 0x7fffffffu, q = slot[1], tries = slot[2];
        while (tries < 8u) {
            const unsigned t = __hip_atomic_fetch_add(ctr + q * 32u, 1u, __ATOMIC_RELAXED, __HIP_MEMORY_SCOPE_AGENT);
            if (t < 128u) { v = q * 128u + t; break; }
            q = (q + 1u) & 7u; ++tries;
        }
        slot[0] = v; slot[1] = q; slot[2] = tries;
    }
    __syncthreads();
    const int v = (int)slot[0];
    return __builtin_amdgcn_readfirstlane(v);
}
__device__ __forceinline__ void phase_attn(const Params& p, LAS unsigned char* ldsl) {
    char* lds = (char*)ldsl;
    unsigned char* ws = p.ws;
    const int tid = ltid();
    { const GAS float* bg = (const GAS float*)((GAS unsigned char*)ws + WS_BLUT); float* bl = (float*)(lds + at::OFF_BLUT); for (int i = tid; i < 8 * 132; i += NTHR) bl[i] = bg[i]; }
    gu32* ctr = (gu32*)(ws + WS_QCTR) + p.layer * 256;

    volatile LAS unsigned* slot = (volatile LAS unsigned*)(ldsl + at::LDS_NEED);
    if (tid == 0) { slot[1] = (unsigned)__builtin_amdgcn_s_getreg((3 << 11) | 20) & 7u; slot[2] = 0; }
    int L = attn_fetch(ctr, slot, tid);
    if (L >= ATT_ITEMS) return;
    at::BlockRef cur = attn_mkref(ws, L);
    at::Seam S;
    at::attn_prime(cur, lds, S);
    for (;;) {
        const int Ln = attn_fetch(ctr, slot, tid);
        const bool last = Ln >= ATT_ITEMS;
        const at::BlockRef nxt = last ? cur : attn_mkref(ws, Ln);
        at::attn_block(cur, nxt, lds, S);
        if (last) break;
        cur = nxt;
    }
}
__device__ __forceinline__ void phase_mix(const Params& p, LAS unsigned char* lds) {
    if (blockIdx.x < NB * NH) gdn_scan_bh(p, lds, (int)blockIdx.x);
    if (p.layer + 1 < DEPTH) {
        if (gridDim.x >= 2 * NB * NH) { if (blockIdx.x >= NB * NH && blockIdx.x < 2 * NB * NH) { convert_weights(p, lds, p.layer + 1, ((int)blockIdx.x - NB * NH) * NWAVES + (ltid() >> 6), NB * NH * NWAVES); __syncthreads(); } }
        else { convert_weights(p, lds, p.layer + 1, (int)blockIdx.x * NWAVES + (ltid() >> 6), (int)gridDim.x * NWAVES); __syncthreads(); }
    }
    phase_attn(p, lds);
}

#define XB_TMO      128
#define XB_XCNT(j)  (256  + 64 * (j))
#define XB_XSUB(j)  (1280 + 64 * (j))
#define XB_XGEN(j)  (2304 + 64 * (j))
#define XB_TOP      3328
#define XB_TOPGEN   3392
#define XCD_BAR_WORDS 3456
#define XB_SPIN_CAP (1u << 18)

__device__ __forceinline__ unsigned xb_ld(unsigned* p)              { return __hip_atomic_load(p, __ATOMIC_RELAXED, __HIP_MEMORY_SCOPE_AGENT); }
__device__ __forceinline__ unsigned xb_add(unsigned* p, unsigned v) { return __hip_atomic_fetch_add(p, v, __ATOMIC_RELAXED, __HIP_MEMORY_SCOPE_AGENT); }
__device__ __forceinline__ unsigned xb_xcc_id() { return (unsigned)__builtin_amdgcn_s_getreg((3 << 11) | 20) & 0xFu; }
#define XB_SPIN(cond, bar) do { unsigned _sp = 0; while (cond) { __builtin_amdgcn_s_sleep(1); \
    if ((++_sp & 255u) == 0u) { if (xb_ld(&(bar)[XB_TMO])) break; if (_sp > XB_SPIN_CAP) { atomicAdd(&(bar)[XB_TMO], 1u); break; } } } } while (0)

struct XcdBarrier {
    unsigned* bar; unsigned x;
    volatile LAS unsigned* st;
};

__device__ __forceinline__ XcdBarrier xcd_barrier_post(unsigned* bar, volatile LAS unsigned* st) {
    XcdBarrier b; b.bar = bar; b.x = xb_xcc_id(); b.st = st;
    if (threadIdx.x == 0) (void)xb_add(&bar[XB_XCNT(b.x)], 1u);
    return b;
}
__device__ __forceinline__ void xcd_barrier_complete(unsigned* bar, unsigned x, unsigned& nloc, unsigned& nx) {
    const unsigned G = gridDim.x * gridDim.y * gridDim.z;
    unsigned sum, cnt, mine, sp = 0u;
    for (;;) {
        sum = 0u; cnt = 0u; mine = 0u;
#pragma unroll
        for (unsigned j = 0; j < 16; ++j) { const unsigned c = xb_ld(&bar[XB_XCNT(j)]); sum += c; cnt += (c > 0u) ? 1u : 0u; mine = (j == x) ? c : mine; }
        if (sum == G) break;
        __builtin_amdgcn_s_sleep(1);
        if ((++sp & 255u) == 0u) { if (xb_ld(&bar[XB_TMO])) break; if (sp > XB_SPIN_CAP) { atomicAdd(&bar[XB_TMO], 1u); break; } }
    }
    nloc = mine > 0u ? mine : 1u; nx = cnt > 0u ? cnt : 1u;
}

__device__ __forceinline__ void xcd_barrier(const XcdBarrier& b) {
    asm volatile("s_waitcnt vmcnt(0)" ::: "memory");
    __syncthreads();
    if (threadIdx.x == 0) {
        unsigned* bar = b.bar;
        __builtin_amdgcn_s_waitcnt(0);
        unsigned nloc = b.st[0], nx = b.st[1];
        if (nloc == 0u) { xcd_barrier_complete(bar, b.x, nloc, nx); b.st[0] = nloc; b.st[1] = nx; }
        const unsigned old = xb_add(&bar[XB_XSUB(b.x)], 1u);
        const unsigned gen = old / nloc;
        if (old + 1u == (gen + 1u) * nloc) {
            __builtin_amdgcn_fence(__ATOMIC_RELEASE, "agent");
            asm volatile("s_waitcnt vmcnt(0)" ::: "memory");
            const unsigned og = xb_add(&bar[XB_TOP], 1u);
            const unsigned tg = og / nx;
            if (og + 1u == (tg + 1u) * nx) xb_add(&bar[XB_TOPGEN], 1u);
            else XB_SPIN(xb_ld(&bar[XB_TOPGEN]) == tg, bar);
            __builtin_amdgcn_fence(__ATOMIC_ACQUIRE, "agent");
            xb_add(&bar[XB_XGEN(b.x)], 1u);
            asm volatile("s_waitcnt vmcnt(0)" ::: "memory");
        } else {
            XB_SPIN(xb_ld(&bar[XB_XGEN(b.x)]) == gen, bar);
            __builtin_amdgcn_fence(__ATOMIC_ACQUIRE, "agent");
            asm volatile("s_waitcnt vmcnt(0)" ::: "memory");
        }
    }
    __syncthreads();
}

enum { PH_CONVERT = 0, PH_INPROJ, PH_GDN_LOCAL, PH_INDEXER, PH_GDN_SCAN, PH_ATTN, PH_GATES, PH_BRANCH_A, PH_BRANCH_B, PH_WOUT, PH_LN1, PH_FFN_IN, PH_FFN_OUT, PH_LN2, PH_COUNT };

template <class Epi>
__device__ __forceinline__ void run_gemm(LAS unsigned char* lds, const void* A, const void* Bt, int N, int K, const Epi& E) {
    pg8::Gemm g{(const pg8::bf16_t*)A, (const pg8::bf16_t*)Bt, M, N, K};
    pg8::StaticOrder S; S.init(M, N, (int)gridDim.x, (int)blockIdx.x);
    pg8::gemm_phase<Epi, pg8::StaticOrder, true, true>(lds, g, S, E);
}

__device__ __forceinline__ const float* ldp(volatile LAS unsigned long long* t, int i) { const unsigned long long v = t[i];
    return (const float*)((unsigned long long)(unsigned)__builtin_amdgcn_readfirstlane((int)(unsigned)v) | ((unsigned long long)(unsigned)__builtin_amdgcn_readfirstlane((int)(unsigned)(v >> 32)) << 32)); }
template <int PH>
__device__ __forceinline__ void run_phase(volatile LAS unsigned long long* t, int layer, int rep, LAS unsigned char* lds) {
    Params p{}; p.layer = layer; p.pad = rep;
    p.ws = (unsigned char*)ldp(t, 17);
    if constexpr (PH == PH_CONVERT) { p.x = ldp(t, 0); p.rel_bias = ldp(t, 1); p.w_in = ldp(t, 2); p.w_a = ldp(t, 7); p.w_b = ldp(t, 8); p.w_out = ldp(t, 9); p.w_ffn_in = ldp(t, 12); p.w_ffn_out = ldp(t, 13); }
    if constexpr (PH == PH_GDN_LOCAL) { p.conv_w = ldp(t, 3); p.a_log = ldp(t, 4); p.dt_bias = ldp(t, 5); }
    if constexpr (PH == PH_WOUT) { p.x = ldp(t, 0); p.out = (float*)ldp(t, 16); p.ln2_g = ldp(t, 14); p.ln2_b = ldp(t, 15); }
    if constexpr (PH == PH_LN1 || PH == PH_FFN_OUT) { p.ln1_g = ldp(t, 10); p.ln1_b = ldp(t, 11); p.out = (float*)ldp(t, 16); }
    if constexpr (PH == PH_LN2) { p.ln2_g = ldp(t, 14); p.ln2_b = ldp(t, 15); p.out = (float*)ldp(t, 16); }
    if constexpr (PH == PH_ATTN) { p.gdn_norm_w = ldp(t, 6); p.w_in = ldp(t, 2); p.w_a = ldp(t, 7); p.w_b = ldp(t, 8); p.w_out = ldp(t, 9); p.w_ffn_in = ldp(t, 12); p.w_ffn_out = ldp(t, 13); }
    unsigned char* ws = p.ws;
    unsigned char* wsw = p.ws + (size_t)(layer & 1) * WSET_STRIDE;
    if constexpr (PH == PH_CONVERT) phase_convert(p, lds);
    else if constexpr (PH == PH_INPROJ) { EpiProj E{ws}; run_gemm(lds, ws + WS_XB, wsw + WS_WIN, NP1, DM, E); }
    else if constexpr (PH == PH_GDN_LOCAL) { phase_gdn_local(p, lds); __syncthreads(); phase_indexer(p, lds); }
    else if constexpr (PH == PH_INDEXER) { }
    else if constexpr (PH == PH_GDN_SCAN) { }
    else if constexpr (PH == PH_ATTN) phase_mix(p, lds);
    else if constexpr (PH == PH_GATES) { EpiGate E{ws}; run_gemm(lds, ws + WS_XB, wsw + WS_WG, NGT, DM, E); }
    else if constexpr (PH == PH_BRANCH_A) { { EpiBranch<0> E{ws}; run_gemm(lds, ws + WS_OA, wsw + WS_WA, DM, 1024, E); }
        __syncthreads();
        { EpiBranch<1> E{ws}; run_gemm(lds, ws + WS_OB, wsw + WS_WB, DM, 1024, E); } }
    else if constexpr (PH == PH_BRANCH_B) { }
    else if constexpr (PH == PH_WOUT) { EpiResidB E{ws, p.layer == 0 ? p.x : nullptr}; run_gemm(lds, ws + WS_MERGED, wsw + WS_WO, DM, DM, E); }
    else if constexpr (PH == PH_LN1) phase_ln_b(p, p.ln1_g, p.ln1_b, false);
    else if constexpr (PH == PH_FFN_IN) { EpiSwiGLU E{ws}; run_gemm(lds, ws + WS_XB, wsw + WS_W1, 2 * DFF, DM, E); }
    else if constexpr (PH == PH_FFN_OUT) {
        if (p.layer == DEPTH - 1) { EpiResidC E{ws, nullptr, p.ln1_g + (size_t)p.layer * DM, p.ln1_b + (size_t)p.layer * DM, p.out}; run_gemm(lds, ws + WS_HID, wsw + WS_W2, DM, DFF, E); }
        else { EpiResidB E{ws, nullptr}; run_gemm(lds, ws + WS_HID, wsw + WS_W2, DM, DFF, E); } }
    else if constexpr (PH == PH_LN2) { if (p.layer == DEPTH - 1) phase_ln(p, p.ln2_g, p.ln2_b, true); else phase_ln_b(p, p.ln2_g, p.ln2_b, false); }
}


__device__ constexpr int kRep[PH_COUNT] = { 1, 1, 1, 0, 0, 1, 1, 1, 0, 1, 1, 1, 1, 1 };
__global__ void __launch_bounds__(NTHR, 2) fwd_kernel(Params p0) {
    extern __shared__ __attribute__((aligned(16))) unsigned char smem[];
    LAS unsigned char* lds = (LAS unsigned char*)smem;
    if (threadIdx.x < 4) ((LAS unsigned*)(lds + LDS_MISC))[threadIdx.x] = 0u;
    if ((threadIdx.x & 63) == 0) ((LAS int*)(lds + LDS_WTAB))[(unsigned)__builtin_amdgcn_s_getreg(63492) & 63u] = (int)(threadIdx.x >> 6);
    volatile LAS unsigned long long* ptab = (volatile LAS unsigned long long*)(lds + LDS_MISC + 64);
    if (threadIdx.x == 0) { ptab[0] = (unsigned long long)p0.x; ptab[1] = (unsigned long long)p0.rel_bias; ptab[2] = (unsigned long long)p0.w_in; ptab[3] = (unsigned long long)p0.conv_w;
        ptab[4] = (unsigned long long)p0.a_log; ptab[5] = (unsigned long long)p0.dt_bias; ptab[6] = (unsigned long long)p0.gdn_norm_w; ptab[7] = (unsigned long long)p0.w_a;
        ptab[8] = (unsigned long long)p0.w_b; ptab[9] = (unsigned long long)p0.w_out; ptab[10] = (unsigned long long)p0.ln1_g; ptab[11] = (unsigned long long)p0.ln1_b;
        ptab[12] = (unsigned long long)p0.w_ffn_in; ptab[13] = (unsigned long long)p0.w_ffn_out; ptab[14] = (unsigned long long)p0.ln2_g; ptab[15] = (unsigned long long)p0.ln2_b;
        ptab[16] = (unsigned long long)p0.out; ptab[17] = (unsigned long long)p0.ws; }
    __syncthreads();
    XcdBarrier bar = xcd_barrier_post((unsigned*)(p0.ws + WS_CTL) + p0.pad * 4096, (volatile LAS unsigned*)(lds + LDS_MISC));
    const int lo = p0.ph_lo, hi = p0.ph_hi;
#define PHASE(PH) do { const int gi_ = l * PH_COUNT + (PH); if (gi_ >= lo && gi_ < hi) { for (int rep_ = 0; rep_ < kRep[PH]; ++rep_) { run_phase<PH>(ptab, l, rep_, lds); if (gi_ + 1 < hi || rep_ + 1 < kRep[PH]) xcd_barrier(bar); } } } while (0)
    for (int l = 0; l < DEPTH; ++l) {
        if (l == 0) { PHASE(PH_CONVERT); } PHASE(PH_INPROJ); PHASE(PH_GDN_LOCAL); PHASE(PH_INDEXER); PHASE(PH_GDN_SCAN); PHASE(PH_ATTN); PHASE(PH_GATES);
        PHASE(PH_BRANCH_A); PHASE(PH_BRANCH_B); PHASE(PH_WOUT); PHASE(PH_LN1); PHASE(PH_FFN_IN); PHASE(PH_FFN_OUT); PHASE(PH_LN2);
    }
#undef PHASE
}

extern "C" void kernel_launch(void* const* d_in, const int* in_sizes, int n_in, void* d_out, int out_size, void* d_ws, size_t ws_size, hipStream_t stream) {
    if (n_in != 16 || out_size != M * DM || ws_size < WS_END) { fprintf(stderr, "kernel_launch: unexpected shapes (n_in %d, out %d, ws %zu < %zu)\n", n_in, out_size, ws_size, (size_t)WS_END); return; }
    Params p{};
    p.x = (const float*)d_in[0]; p.rel_bias = (const float*)d_in[1]; p.w_in = (const float*)d_in[2]; p.conv_w = (const float*)d_in[3];
    p.a_log = (const float*)d_in[4]; p.dt_bias = (const float*)d_in[5]; p.gdn_norm_w = (const float*)d_in[6]; p.w_a = (const float*)d_in[7];
    p.w_b = (const float*)d_in[8]; p.w_out = (const float*)d_in[9]; p.ln1_g = (const float*)d_in[10]; p.ln1_b = (const float*)d_in[11];
    p.w_ffn_in = (const float*)d_in[12]; p.w_ffn_out = (const float*)d_in[13]; p.ln2_g = (const float*)d_in[14]; p.ln2_b = (const float*)d_in[15];
    p.out = (float*)d_out; p.ws = (unsigned char*)d_ws;
    static int grid = 0;
    if (!grid) {
        int dev = 0, cus = 0, per_cu = 0;
        (void)hipGetDevice(&dev);
        if (hipDeviceGetAttribute(&cus, hipDeviceAttributeMultiprocessorCount, dev) != hipSuccess || cus <= 0) cus = 256;
        (void)hipFuncSetAttribute((const void*)fwd_kernel, hipFuncAttributeMaxDynamicSharedMemorySize, LDS_BYTES);
        if (hipOccupancyMaxActiveBlocksPerMultiprocessor(&per_cu, (const void*)fwd_kernel, NTHR, LDS_BYTES) != hipSuccess || per_cu < 1)
            fprintf(stderr, "kernel_launch: occupancy query reports %d workgroups per CU\n", per_cu);
        grid = cus;
    }
    (void)hipMemsetAsync((char*)d_ws + WS_CTL, 0, 1024 * 1024, stream);
    p.ph_lo = 0; p.ph_hi = DEPTH * PH_COUNT; p.pad = 0;
    fwd_kernel<<<dim3(grid), dim3(NTHR), LDS_BYTES, stream>>>(p);
}
```
